# Optimizing an MI355X kernel written in HIP

```python
import math
import jax
import jax.numpy as jnp
from jax import lax
import numpy as np

D_MODEL = 1024
BATCH = 8
SEQ = 2048
DEPTH = 2

HEAD_DIM = 64
ROPE_THETA = 10000.0
RMS_EPS = 1e-6
NEG_INF = -1e30
BLOCK = 128

A_Q_HEADS = 8
A_KV_HEADS = 2
A_GROUP = A_Q_HEADS // A_KV_HEADS
WINDOW = 128
A_Q_WIDTH = A_Q_HEADS * HEAD_DIM
A_KV_WIDTH = A_KV_HEADS * HEAD_DIM

HY_WIDTH = D_MODEL // 2
HY_ORDER = 2
HY_DIRS = 2
HY_SHORT = 3
HY_BANDS = 16
HY_POS_DIM = 1 + 2 * HY_BANDS
HY_FILTER_HIDDEN = 64
HY_DECAY_TARGET = 1e-2
HY_FAST_PCT = 0.3
HY_SLOW_PCT = 1.5

C_HEADS = 4
C_WIDTH = C_HEADS * 2 * HEAD_DIM

N_BRANCH = 3
IN_SIZES = (A_Q_WIDTH, A_KV_WIDTH, A_KV_WIDTH, (HY_ORDER + 1) * HY_WIDTH, C_WIDTH, C_WIDTH, C_WIDTH, N_BRANCH * D_MODEL)
IN_COLS = sum(IN_SIZES)
IN_SPLITS = tuple(sum(IN_SIZES[:i + 1]) for i in range(len(IN_SIZES) - 1))

D_FF = -(-8 * D_MODEL // (3 * 256)) * 256

kernel_name = 'hybrid_gated_window_hyena_diffattn_encoder'


def rms_norm(x, g):
    xf = x.astype(jnp.float32)
    y = xf * lax.rsqrt(jnp.mean(xf * xf, axis=-1, keepdims=True) + RMS_EPS)
    return (y * g.astype(jnp.float32)).astype(x.dtype)


def rope_tables(seq):
    pos = jnp.arange(seq, dtype=jnp.float32)
    inv = ROPE_THETA ** (-jnp.arange(0, HEAD_DIM, 2, dtype=jnp.float32) / HEAD_DIM)
    ang = pos[:, None] * inv[None, :]
    return jnp.cos(ang), jnp.sin(ang)


def apply_rope(x, cos, sin):
    c = cos[None, :, None, :].astype(x.dtype)
    s = sin[None, :, None, :].astype(x.dtype)
    x1, x2 = jnp.split(x, 2, axis=-1)
    return jnp.concatenate([x1 * c - x2 * s, x2 * c + x1 * s], axis=-1)


def window_attention(q, k, v, sink):
    B, S = q.shape[0], q.shape[1]
    nb = S // BLOCK
    span = BLOCK + 2 * WINDOW
    qb = q.reshape(B, nb, BLOCK, A_KV_HEADS, A_GROUP, HEAD_DIM)
    pad = ((0, 0), (WINDOW, WINDOW), (0, 0), (0, 0))
    kp = jnp.pad(k, pad)
    vp = jnp.pad(v, pad)
    idx = jnp.arange(nb)[:, None] * BLOCK + jnp.arange(span)[None, :]
    kb = kp[:, idx]
    vb = vp[:, idx]
    s = jnp.einsum('bnqhgd,bnkhd->bnhgqk', qb, kb).astype(jnp.float32) / math.sqrt(HEAD_DIM)
    q_pos = jnp.arange(nb)[:, None] * BLOCK + jnp.arange(BLOCK)[None, :]
    k_pos = idx - WINDOW
    dist = k_pos[:, None, :] - q_pos[:, :, None]
    valid = (jnp.abs(dist) <= WINDOW) & (k_pos[:, None, :] >= 0) & (k_pos[:, None, :] < S)
    s = jnp.where(valid[None, :, None, None], s, NEG_INF)
    sink_b = jnp.broadcast_to(sink.astype(jnp.float32).reshape(A_KV_HEADS, A_GROUP)[None, None, :, :, None, None], s.shape[:-1] + (1,))
    p = jax.nn.softmax(jnp.concatenate([s, sink_b], axis=-1), axis=-1)[..., :-1]
    o = jnp.einsum('bnhgqk,bnkhd->bnqhgd', p.astype(v.dtype), vb)
    return o.reshape(B, S, A_Q_HEADS * HEAD_DIM)


def diff_attention(q, k, v, lam):
    B, S = q.shape[0], q.shape[1]
    nb = S // BLOCK
    qb = q.reshape(B, nb, BLOCK, C_HEADS, 2, HEAD_DIM).transpose(1, 0, 3, 4, 2, 5)
    kt = k.transpose(0, 2, 3, 1, 4)
    vt = v.transpose(0, 2, 1, 3)

    def one_block(qblk):
        s = jnp.einsum('bhcqd,bhckd->bhcqk', qblk, kt).astype(jnp.float32) / math.sqrt(HEAD_DIM)
        p = jax.nn.softmax(s, axis=-1)
        a = p[:, :, 0] - lam * p[:, :, 1]
        return jnp.einsum('bhqk,bhkd->bhqd', a.astype(v.dtype), vt)

    o = lax.map(one_block, qb)
    return o.transpose(1, 0, 3, 2, 4).reshape(B, S, C_HEADS, 2 * HEAD_DIM)


def short_conv(u, w, b):
    L = u.shape[1]
    up = jnp.pad(u, ((0, 0), (1, 1), (0, 0)))
    return up[:, :L] * w[0] + up[:, 1:L + 1] * w[1] + up[:, 2:] * w[2] + b


def hyena_filters(L, w1, b1, f1, w2, b2, f2, w3):
    f32 = jnp.float32
    pos = jnp.arange(L, dtype=f32)
    t = pos / max(L - 1, 1)
    bands = jnp.arange(1, HY_BANDS + 1, dtype=f32)
    ang = 2.0 * math.pi * pos[:, None] * bands[None, :] / L
    z = jnp.concatenate([t[:, None], jnp.cos(ang), jnp.sin(ang)], axis=-1)
    h = jnp.sin(f1.astype(f32) * (z @ w1.astype(f32) + b1.astype(f32)))
    h = jnp.sin(f2.astype(f32) * (h @ w2.astype(f32) + b2.astype(f32)))
    h = (h @ w3.astype(f32)).reshape(L, HY_ORDER, HY_DIRS, HY_WIDTH)
    min_decay = math.log(HY_DECAY_TARGET) / HY_SLOW_PCT
    max_decay = math.log(HY_DECAY_TARGET) / HY_FAST_PCT
    deltas = jnp.abs(jnp.linspace(min_decay, max_decay, HY_WIDTH, dtype=f32))
    decay = jnp.exp(-t[:, None] * deltas[None, :])
    h = h * decay[:, None, None, :]
    fwd, bwd = h[:, :, 0], h[:, :, 1]
    c = jnp.concatenate([fwd[:1] + bwd[:1], fwd[1:], jnp.zeros_like(fwd[:1]), bwd[1:][::-1]], axis=0)
    return c * lax.rsqrt(jnp.sum(c * c, axis=0, keepdims=True) + RMS_EPS)


def fft_conv(u, cf):
    L = u.shape[1]
    U = jnp.fft.rfft(u.astype(jnp.float32), n=2 * L, axis=1)
    y = jnp.fft.irfft(U * cf[None], n=2 * L, axis=1)[:, :L]
    return y.astype(u.dtype)


def hyena_branch(u, conv_w, conv_b, w1, b1, f1, w2, b2, f2, w3, hy_d):
    L = u.shape[1]
    u = short_conv(u, conv_w, conv_b)
    v, x1, x2 = jnp.split(u, 3, axis=-1)
    cf = jnp.fft.rfft(hyena_filters(L, w1, b1, f1, w2, b2, f2, w3), axis=0)
    z = x1 * (fft_conv(v, cf[:, 0]) + hy_d[0] * v)
    z = x2 * (fft_conv(z, cf[:, 1]) + hy_d[1] * z)
    return z


def setup_inputs(seed: int = 0) -> dict:
    key = jax.random.key(seed)
    ks = jax.random.split(key, 40)

    def nrm(i, shape, scale):
        return jax.random.normal(ks[i], shape, dtype=jnp.float32) * scale

    def gain(i, shape):
        return 1.0 + nrm(i, shape, 0.05)

    L = DEPTH
    return {
        'x': nrm(0, (BATCH, SEQ, D_MODEL), 1.0),
        'norm1_g': gain(1, (L, D_MODEL)),
        'w_in': nrm(2, (L, D_MODEL, IN_COLS), D_MODEL ** -0.5),
        'sink_a': nrm(3, (L, A_Q_HEADS), 0.5),
        'qn_a': gain(4, (L, HEAD_DIM)),
        'kn_a': gain(5, (L, HEAD_DIM)),
        'conv_w': nrm(6, (L, HY_SHORT, (HY_ORDER + 1) * HY_WIDTH), 0.6),
        'conv_b': nrm(7, (L, (HY_ORDER + 1) * HY_WIDTH), 0.01),
        'filt_w1': nrm(8, (L, HY_POS_DIM, HY_FILTER_HIDDEN), HY_POS_DIM ** -0.5),
        'filt_b1': nrm(9, (L, HY_FILTER_HIDDEN), 0.1),
        'filt_f1': gain(10, (L, HY_FILTER_HIDDEN)),
        'filt_w2': nrm(11, (L, HY_FILTER_HIDDEN, HY_FILTER_HIDDEN), HY_FILTER_HIDDEN ** -0.5),
        'filt_b2': nrm(12, (L, HY_FILTER_HIDDEN), 0.1),
        'filt_f2': gain(13, (L, HY_FILTER_HIDDEN)),
        'filt_w3': nrm(14, (L, HY_FILTER_HIDDEN, HY_ORDER * HY_DIRS * HY_WIDTH), HY_FILTER_HIDDEN ** -0.5),
        'hy_d': nrm(15, (L, HY_ORDER, HY_WIDTH), 0.1),
        'qn_c': gain(16, (L, HEAD_DIM)),
        'kn_c': gain(17, (L, HEAD_DIM)),
        'lam_q1': nrm(18, (L, HEAD_DIM), 0.1),
        'lam_k1': nrm(19, (L, HEAD_DIM), 0.1),
        'lam_q2': nrm(20, (L, HEAD_DIM), 0.1),
        'lam_k2': nrm(21, (L, HEAD_DIM), 0.1),
        'subln_c': gain(22, (L, 2 * HEAD_DIM)),
        'w_oa': nrm(23, (L, A_Q_WIDTH, D_MODEL), A_Q_WIDTH ** -0.5),
        'w_ob': nrm(24, (L, HY_WIDTH, D_MODEL), HY_WIDTH ** -0.5),
        'w_oc': nrm(25, (L, C_WIDTH, D_MODEL), C_WIDTH ** -0.5),
        'w_out': nrm(26, (L, D_MODEL, D_MODEL), D_MODEL ** -0.5),
        'norm2_g': gain(27, (L, D_MODEL)),
        'ffn_w1': nrm(28, (L, D_MODEL, D_FF), D_MODEL ** -0.5),
        'ffn_w3': nrm(29, (L, D_MODEL, D_FF), D_MODEL ** -0.5),
        'ffn_w2': nrm(30, (L, D_FF, D_MODEL), D_FF ** -0.5),
    }


def reference(x, norm1_g, w_in, sink_a, qn_a, kn_a, conv_w, conv_b, filt_w1, filt_b1, filt_f1, filt_w2, filt_b2, filt_f2, filt_w3, hy_d, qn_c, kn_c, lam_q1, lam_k1, lam_q2, lam_k2, subln_c, w_oa, w_ob, w_oc, w_out, norm2_g, ffn_w1, ffn_w3, ffn_w2):
    B, S = x.shape[0], x.shape[1]
    cos, sin = rope_tables(S)
    for l in range(DEPTH):
        h = rms_norm(x, norm1_g[l])
        proj = h @ w_in[l]
        qa, ka, va, hy_in, qc, kc, vc, gate_logits = jnp.split(proj, IN_SPLITS, axis=-1)

        qa = apply_rope(rms_norm(qa.reshape(B, S, A_Q_HEADS, HEAD_DIM), qn_a[l]), cos, sin)
        ka = apply_rope(rms_norm(ka.reshape(B, S, A_KV_HEADS, HEAD_DIM), kn_a[l]), cos, sin)
        va = va.reshape(B, S, A_KV_HEADS, HEAD_DIM)
        out_a = window_attention(qa, ka, va, sink_a[l])

        out_b = hyena_branch(hy_in, conv_w[l], conv_b[l], filt_w1[l], filt_b1[l], filt_f1[l], filt_w2[l], filt_b2[l], filt_f2[l], filt_w3[l], hy_d[l])

        lambda_init = 0.8 - 0.6 * math.exp(-0.3 * l)
        lam = (jnp.exp(jnp.sum(lam_q1[l].astype(jnp.float32) * lam_k1[l].astype(jnp.float32)))
               - jnp.exp(jnp.sum(lam_q2[l].astype(jnp.float32) * lam_k2[l].astype(jnp.float32)))
               + lambda_init)
        qc = apply_rope(rms_norm(qc.reshape(B, S, 2 * C_HEADS, HEAD_DIM), qn_c[l]), cos, sin).reshape(B, S, C_HEADS, 2, HEAD_DIM)
        kc = apply_rope(rms_norm(kc.reshape(B, S, 2 * C_HEADS, HEAD_DIM), kn_c[l]), cos, sin).reshape(B, S, C_HEADS, 2, HEAD_DIM)
        vc = vc.reshape(B, S, C_HEADS, 2 * HEAD_DIM)
        out_c = diff_attention(qc, kc, vc, lam)
        out_c = (rms_norm(out_c, subln_c[l]) * (1.0 - lambda_init)).reshape(B, S, C_WIDTH)

        g = jax.nn.sigmoid(gate_logits.astype(jnp.float32)).reshape(B, S, N_BRANCH, D_MODEL).astype(x.dtype)
        merged = (g[:, :, 0] * (out_a @ w_oa[l])
                  + g[:, :, 1] * (out_b @ w_ob[l])
                  + g[:, :, 2] * (out_c @ w_oc[l]))
        x = x + merged @ w_out[l]

        h2 = rms_norm(x, norm2_g[l])
        x = x + (jax.nn.silu(h2 @ ffn_w1[l]) * (h2 @ ffn_w3[l])) @ ffn_w2[l]
    return x
```

```cpp
#include <hip/hip_runtime.h>
#include <hip/hip_cooperative_groups.h>
#include <cstdint>
#include <cstdio>
namespace cg = cooperative_groups;

#define LAS __attribute__((address_space(3)))
typedef unsigned short bf16_t;
typedef short bf16x8 __attribute__((ext_vector_type(8)));
typedef short s16x4 __attribute__((ext_vector_type(4)));
typedef float f32x2 __attribute__((ext_vector_type(2)));
typedef float f32x4 __attribute__((ext_vector_type(4)));
typedef float f32x16 __attribute__((ext_vector_type(16)));
typedef unsigned u32x2 __attribute__((ext_vector_type(2)));
typedef unsigned u32x4 __attribute__((ext_vector_type(4)));
typedef __bf16 bf16x2_t __attribute__((ext_vector_type(2)));

constexpr int DM = 1024, NBATCH = 8, SEQ = 2048, MTOK = NBATCH * SEQ, DEPTH = 2;
constexpr int INC = 6912, NMAIN = 3840, DFF = 2816;
constexpr float RMS_EPS = 1e-6f;
constexpr float LOG2E = 1.4426950408889634f;
constexpr float QSCALE = 0.125f * LOG2E;
constexpr int NTHREADS = 512;
constexpr int LDS_BYTES = 147456;

constexpr size_t MiB = 1u << 20;
constexpr size_t WS_CTL = 0;
constexpr size_t CTL_ROWSSA = 0;
constexpr size_t CTL_ROWSSB = 128 * 1024;
constexpr size_t CTL_COS = 256 * 1024;
constexpr size_t CTL_SIN = 512 * 1024;
constexpr size_t CTL_LAM = 768 * 1024;
constexpr size_t CTL_TW = 768 * 1024 + 256;
constexpr size_t CTL_H2 = 1 * MiB;
constexpr size_t CTL_BAR = 2 * MiB;
constexpr size_t CTL_BAR_BYTES = 32768;
constexpr int LDS_BARST = LDS_BYTES - 64;
constexpr size_t WS_W = 4 * MiB;
constexpr size_t W_IN = WS_W;
constexpr size_t W_OA = W_IN + (size_t)INC * DM * 2;
constexpr size_t W_OUT = W_OA + 3 * (size_t)DM * 512 * 2;
constexpr size_t W_13 = W_OUT + (size_t)DM * DM * 2;
constexpr size_t W_2 = W_13 + (size_t)2 * DFF * DM * 2;
constexpr size_t WS_XB = 39 * MiB;
constexpr size_t WS_QA = 71 * MiB;
constexpr size_t WS_OB = 87 * MiB;
constexpr size_t WS_QC = 103 * MiB;
constexpr size_t WS_G = 119 * MiB;
constexpr size_t G_KA = WS_G, G_VA = WS_G + 4 * MiB, G_HY = WS_G + 8 * MiB, G_KC = WS_G + 56 * MiB, G_VC = WS_G + 72 * MiB;
constexpr size_t WS_S = 207 * MiB;
constexpr size_t WS_XB8 = 239 * MiB;
constexpr size_t CTL_FCTA = 3 * MiB + 512 * 1024;
constexpr size_t WS_ROWSSA = 2 * MiB + 512 * 1024;
constexpr size_t WS_ROWSSB = 3 * MiB;
constexpr size_t WS_END = 255 * MiB;
constexpr int CTLW_GWMAX = 4096;
static_assert(W_2 + (size_t)DM * DFF * 2 <= WS_XB, "weights fit");

struct Params {
    const float* in[31];
    float* out;
    unsigned char* ws;
    int lo, hi, coop, pad;
};
enum { I_X = 0, I_N1G, I_WIN, I_SINK, I_QNA, I_KNA, I_CONVW, I_CONVB, I_FW1, I_FB1, I_FF1, I_FW2, I_FB2, I_FF2, I_FW3, I_HYD, I_QNC, I_KNC, I_LQ1, I_LK1, I_LQ2, I_LK2, I_SUBLN,
       I_WOA, I_WOB, I_WOC, I_WOUT, I_N2G, I_FFW1, I_FFW3, I_FFW2 };

__device__ __forceinline__ unsigned pk2(float lo, float hi) { f32x2 v = {lo, hi}; bf16x2_t b = __builtin_convertvector(v, bf16x2_t); return __builtin_bit_cast(unsigned, b); }
__device__ __forceinline__ float bf2f(unsigned short b) { return __uint_as_float(((unsigned)b) << 16); }
__device__ __forceinline__ float bflo(unsigned w) { return __uint_as_float(w << 16); }
__device__ __forceinline__ float bfhi(unsigned w) { return __uint_as_float(w & 0xffff0000u); }
__device__ __forceinline__ unsigned short f2bf(float f) { return (unsigned short)(pk2(f, 0.f) & 0xffffu); }
__device__ __forceinline__ size_t opaque_zero() { unsigned z = 0; asm volatile("" : "+s"(z)); return (size_t)z; }
__device__ __forceinline__ float wave_sum(float v) {
#pragma unroll
    for (int o = 1; o < 64; o <<= 1) v += __shfl_xor(v, o);
    return v;
}
__device__ __forceinline__ void rows_rstd8(const float* rowss, int row0, float (&rs)[8]) {
    f32x4 q[8];
#pragma unroll
    for (int k = 0; k < 8; ++k) q[k] = *(const f32x4*)(rowss + (size_t)(row0 + (k >> 2) * 128 + (k & 3) * 16) * 4);
#pragma unroll
    for (int k = 0; k < 8; ++k) rs[k] = rsqrtf(((q[k][0] + q[k][1]) + (q[k][2] + q[k][3])) * (1.f / DM) + RMS_EPS);
}
__device__ __forceinline__ void rows_rstd8_lds(LAS const float* p, int fr, float (&rs)[8]) {
    f32x4 q[8];
#pragma unroll
    for (int k = 0; k < 8; ++k) q[k] = *(LAS const f32x4*)(p + (k >> 2) * 256 + ((k & 3) * 16 + fr) * 4);
#pragma unroll
    for (int k = 0; k < 8; ++k) rs[k] = rsqrtf(((q[k][0] + q[k][1]) + (q[k][2] + q[k][3])) * (1.f / DM) + RMS_EPS);
}
__device__ __forceinline__ int crow(int r, int hi) { return (r & 3) + 8 * (r >> 2) + 4 * hi; }

namespace pg8 {
constexpr int BM = 256, BK = 64, HALF = 128, HTB = HALF * BK * 2, STAGE_BYTES = 8 * HTB, NXCD = 8, WGM = 8;
constexpr int RS_OFF = STAGE_BYTES + 4096;
__host__ __device__ __forceinline__ int lds_byte(int r, int c) { const int st = (r >> 4) * 2 + (c >> 5), rr = r & 15, cc = c & 31, ob = rr * 64 + cc * 2; return st * 1024 + (ob ^ (((ob >> 9) & 1) << 5)); }
__host__ __device__ __forceinline__ void stage_rc(int b, int& R, int& C) { const int st = b / 1024, sb = b % 1024, swz = sb ^ (((sb >> 9) & 1) << 5); R = (st >> 1) * 16 + swz / 64; C = (st & 1) * 32 + (swz % 64) / 2; }
__host__ __device__ __forceinline__ int perm32(int rho) { const int n = rho >> 4, i = rho & 15; return 8 * (i >> 2) + 4 * n + (i & 3); }

struct Unit { int pm, pn, sub, half; };
struct Gemm { const bf16_t* A; const bf16_t* Bt; int M, N, K; size_t sA, sB; };

struct StaticOrder {
    int nM, nN, nwg, G, c;
    __host__ __device__ void init(int M, int N, int G_, int c_) { nM = M / BM; nN = N / BM; nwg = nM * nN; G = G_; c = c_; }
    __host__ __device__ void map(int L, Unit& u) const {
        int wgid = L; { const int q = nwg / NXCD, r = nwg % NXCD, xcd = wgid % NXCD, off = wgid / NXCD; wgid = (xcd < r ? xcd * (q + 1) : r * (q + 1) + (xcd - r) * q) + off; }
        const int nig = WGM * nN, gid = wgid / nig, fm = gid * WGM, gsz = (nM - fm) < WGM ? (nM - fm) : WGM;
        u.pm = fm + ((wgid % nig) % gsz); u.pn = (wgid % nig) / gsz; u.sub = 0; u.half = 0;
    }
    __host__ __device__ bool next(int i, Unit& u) const {
        const long L = (long)i * G + c; if (L >= nwg) return false;
        map((int)L, u); return true;
    }
};
struct TailSplitOrder {
    StaticOrder S; int full, rem;
    __device__ __forceinline__ void init(int M, int N, int G_, int c_) { S.init(M, N, G_, c_); full = (S.nwg / G_) * G_; rem = S.nwg - full; }
    __device__ __forceinline__ bool next(int i, Unit& u) const {
        const long L = (long)i * S.G + S.c;
        if (2 * rem != S.G || L < full) return S.next(i, u);
        if (i != full / S.G) return false;
        S.map(full + (S.c >> 1), u); u.half = 1 + (S.c & 1); return true;
    }
};
struct ChainOrder3 {
    StaticOrder S;
    __device__ __forceinline__ bool next(int i, Unit& u) const { const int q = i / 3; if (!S.next(q, u)) return false; u.sub = i - 3 * q; return true; }
};

typedef f32x4 Acc[2][2][4][2];
typedef int i32x4v __attribute__((ext_vector_type(4)));

template <class Epi, class Sched, bool ALIGN_EPI, bool SP2, bool ZERO, bool HALF_OK = false, bool I8 = false>
__device__ __forceinline__ void gemm_phase(LAS unsigned char* lds, const int tid, const Gemm g, const Sched& S, Epi& E, Acc& acc) {
    const int wid = __builtin_amdgcn_readfirstlane(tid >> 6), lane = tid & 63, wr = wid >> 2, wc = wid & 3, fr = lane & 15, fq = lane >> 4;
    constexpr int ES = I8 ? 1 : 2;
    const int K = g.K, nt = K * ES / (BK * 2);
    unsigned voffA[2], voffB[2];
#pragma unroll
    for (int i = 0; i < 2; ++i) { int R, C; stage_rc(tid * 16 + i * 8192, R, C); const int Rb = Epi::PERM ? ((R & ~31) + perm32(R & 31)) : R;
        voffA[i] = (unsigned)(R * K * ES + C * 2); voffB[i] = (unsigned)(Rb * K * ES + C * 2); }
    const size_t kstep = (size_t)(BK * 2);
    const size_t hstep = (size_t)HALF * K * ES;
    const size_t tstep = 2 * hstep;
    const unsigned ldsw = (unsigned)wid * 1024u;
    const int aoff = lds_byte(wr * 64 + fr, fq * 8), boff = lds_byte(wc * 32 + fr, fq * 8);
#define PG8_SA(b, h) (((b) * 2 + (h)) * HTB)
#define PG8_SB(b, h) ((4 + (b) * 2 + (h)) * HTB)
#define PG8_STAGE(bufoff, gbase, voff) do { _Pragma("unroll") for (int _i = 0; _i < 2; ++_i) \
        __builtin_amdgcn_global_load_lds((const unsigned*)((const char*)(gbase) + (voff)[_i]), (LAS unsigned*)(lds + (bufoff) + ldsw + _i * 8192), 16, 0, 0); } while (0)
#define PG8_LDA(dst, b, h) do { _Pragma("unroll") for (int m = 0; m < 4; ++m) _Pragma("unroll") for (int k = 0; k < 2; ++k) dst[m][k] = *(const LAS bf16x8*)(lds + PG8_SA(b, h) + aoff + m * 2048 + k * 1024); } while (0)
#define PG8_LDB(dst, b, h) do { _Pragma("unroll") for (int n = 0; n < 2; ++n) _Pragma("unroll") for (int k = 0; k < 2; ++k) dst[n][k] = *(const LAS bf16x8*)(lds + PG8_SB(b, h) + boff + n * 2048 + k * 1024); } while (0)
#define PG8_MMA(ai, bj, At, Bt) do { __builtin_amdgcn_s_setprio(1); _Pragma("unroll") for (int m = 0; m < 4; ++m) _Pragma("unroll") for (int n = 0; n < 2; ++n) { \
        _Pragma("unroll") for (int k = 0; k < 2; ++k) { \
        if constexpr (I8) acc[ai][bj][m][n] = __builtin_bit_cast(f32x4, __builtin_amdgcn_mfma_i32_16x16x64_i8(__builtin_bit_cast(i32x4v, Bt[n][k]), __builtin_bit_cast(i32x4v, At[m][k]), __builtin_bit_cast(i32x4v, acc[ai][bj][m][n]), 0, 0, 0)); \
        else acc[ai][bj][m][n] = __builtin_amdgcn_mfma_f32_16x16x32_bf16(Bt[n][k], At[m][k], acc[ai][bj][m][n], 0, 0, 0); } } \
        __builtin_amdgcn_s_setprio(0); } while (0)
#define PG8_WAIT_V(n) asm volatile("s_waitcnt vmcnt(" #n ")" ::: "memory")
#define PG8_WAIT_L(n) asm volatile("s_waitcnt lgkmcnt(" #n ")" ::: "memory")
#define PG8_BAR __builtin_amdgcn_s_barrier()
#define PG8_SCHED __builtin_amdgcn_sched_barrier(0)
#define PG8_ZERO_ACC() do { _Pragma("unroll") for (int a = 0; a < 2; ++a) _Pragma("unroll") for (int b = 0; b < 2; ++b) _Pragma("unroll") for (int m = 0; m < 4; ++m) _Pragma("unroll") for (int n = 0; n < 2; ++n) acc[a][b][m][n] = (f32x4){0.f, 0.f, 0.f, 0.f}; } while (0)
#define PG8_RS_LOAD(un, par) do { if constexpr (Epi::RS_LDS) { if (wc == 0) { _Pragma("unroll") for (int _a = 0; _a < 2; ++_a) \
        __builtin_amdgcn_global_load_lds((const unsigned*)(E.rowss + (size_t)((un).pm * 256 + _a * 128 + wr * 64 + lane) * 4), (LAS unsigned*)(lds + RS_OFF + (par) * 4096 + wr * 2048 + _a * 1024), 16, 0, 0); } } } while (0)
    Unit cur, nxt; int ui = 0;
    if (!S.next(0, cur)) return;
    if (ZERO) PG8_ZERO_ACC();
    PG8_RS_LOAD(cur, 0);
    bf16x8 At[4][2], B0[2][2], B1[2][2];
    const char* cA = (const char*)g.A + (size_t)cur.sub * g.sA + (size_t)cur.pm * tstep; const char* cB = (const char*)g.Bt + (size_t)cur.sub * g.sB + (size_t)cur.pn * tstep;
    if constexpr (SP2) {
        PG8_STAGE(PG8_SB(0, 0), cB, voffB); PG8_STAGE(PG8_SB(0, 1), cB + hstep, voffB); PG8_STAGE(PG8_SA(0, 0), cA, voffA); PG8_STAGE(PG8_SA(0, 1), cA + hstep, voffA);
        if (wr == 1) PG8_BAR;
        PG8_WAIT_V(2); PG8_BAR;
        PG8_STAGE(PG8_SB(1, 0), cB + kstep, voffB); PG8_STAGE(PG8_SA(1, 0), cA + kstep, voffA); PG8_STAGE(PG8_SB(1, 1), cB + hstep + kstep, voffB);
        PG8_WAIT_V(6); PG8_BAR;
    } else {
        PG8_STAGE(PG8_SB(0, 0), cB, voffB); PG8_STAGE(PG8_SA(0, 0), cA, voffA); PG8_STAGE(PG8_SB(0, 1), cB + hstep, voffB); PG8_STAGE(PG8_SA(0, 1), cA + hstep, voffA);
        if (wr == 1) PG8_BAR;
        PG8_WAIT_V(4); PG8_BAR;
        PG8_STAGE(PG8_SB(1, 0), cB + kstep, voffB); PG8_STAGE(PG8_SA(1, 0), cA + kstep, voffA); PG8_STAGE(PG8_SB(1, 1), cB + hstep + kstep, voffB);
        PG8_WAIT_V(6); PG8_BAR;
    }
    for (;;) {
        const bool has_next = S.next(ui + 1, nxt);
        const char* nA = has_next ? (const char*)g.A + (size_t)nxt.sub * g.sA + (size_t)nxt.pm * tstep : cA; const char* nB = has_next ? (const char*)g.Bt + (size_t)nxt.sub * g.sB + (size_t)nxt.pn * tstep : cB;
        const bool do0 = !HALF_OK || cur.half != 2, do1 = !HALF_OK || cur.half != 1;
#pragma unroll 1
        for (int t = 0; t < nt; t += 2) {
            const bool last = (t == nt - 2);
            const char* a1 = cA + (size_t)(t + 1) * kstep;
            const char* a2 = last ? nA : cA + (size_t)(t + 2) * kstep; const char* b2 = last ? nB : cB + (size_t)(t + 2) * kstep;
            const char* a3 = a2 + kstep; const char* b3 = b2 + kstep;
            if constexpr (SP2) {
            PG8_LDB(B0, 0, 0); PG8_LDB(B1, 0, 1); PG8_SCHED; if (do0) PG8_LDA(At, 0, 0); PG8_STAGE(PG8_SA(1, 1), a1 + hstep, voffA);
            PG8_WAIT_V(8); PG8_WAIT_L(0); PG8_BAR; if (do0) { PG8_MMA(0, 0, At, B0); PG8_MMA(0, 1, At, B1); } PG8_BAR; PG8_SCHED;
            if (do1) PG8_LDA(At, 0, 1); PG8_STAGE(PG8_SB(0, 0), b2, voffB); PG8_STAGE(PG8_SB(0, 1), b2 + hstep, voffB); PG8_STAGE(PG8_SA(0, 0), a2, voffA);
            PG8_WAIT_V(8); PG8_WAIT_L(0); PG8_BAR; if (do1) { PG8_MMA(1, 0, At, B0); PG8_MMA(1, 1, At, B1); } PG8_BAR; PG8_SCHED;
            PG8_LDB(B0, 1, 0); PG8_LDB(B1, 1, 1); PG8_SCHED; if (do0) PG8_LDA(At, 1, 0); PG8_STAGE(PG8_SA(0, 1), a2 + hstep, voffA);
            PG8_WAIT_V(8); PG8_WAIT_L(0); PG8_BAR; if (do0) { PG8_MMA(0, 0, At, B0); PG8_MMA(0, 1, At, B1); } PG8_BAR; PG8_SCHED;
            if (do1) PG8_LDA(At, 1, 1); PG8_STAGE(PG8_SB(1, 0), b3, voffB); PG8_STAGE(PG8_SB(1, 1), b3 + hstep, voffB); PG8_STAGE(PG8_SA(1, 0), a3, voffA);
            PG8_WAIT_V(8); PG8_WAIT_L(0); PG8_BAR; if (do1) { PG8_MMA(1, 0, At, B0); PG8_MMA(1, 1, At, B1); } PG8_BAR; PG8_SCHED;
            } else {
            PG8_LDB(B0, 0, 0); PG8_SCHED; PG8_LDA(At, 0, 0); PG8_STAGE(PG8_SA(1, 1), a1 + hstep, voffA);
            PG8_WAIT_L(8); PG8_BAR; PG8_WAIT_L(0); PG8_MMA(0, 0, At, B0); PG8_BAR; PG8_SCHED;
            PG8_LDB(B1, 0, 1); PG8_STAGE(PG8_SB(0, 0), b2, voffB);
            PG8_BAR; PG8_WAIT_L(0); PG8_MMA(0, 1, At, B1); PG8_BAR;
            PG8_LDA(At, 0, 1); PG8_STAGE(PG8_SA(0, 0), a2, voffA);
            PG8_BAR; PG8_WAIT_L(0); PG8_MMA(1, 0, At, B0); PG8_BAR; PG8_SCHED;
            PG8_STAGE(PG8_SB(0, 1), b2 + hstep, voffB);
            PG8_WAIT_V(6); PG8_BAR; PG8_MMA(1, 1, At, B1); PG8_BAR;
            PG8_LDB(B0, 1, 0); PG8_SCHED; PG8_LDA(At, 1, 0); PG8_STAGE(PG8_SA(0, 1), a2 + hstep, voffA);
            PG8_WAIT_L(8); PG8_BAR; PG8_WAIT_L(0); PG8_MMA(0, 0, At, B0); PG8_BAR; PG8_SCHED;
            PG8_LDB(B1, 1, 1); PG8_STAGE(PG8_SB(1, 0), b3, voffB);
            PG8_BAR; PG8_WAIT_L(0); PG8_MMA(0, 1, At, B1); PG8_BAR;
            PG8_LDA(At, 1, 1); PG8_STAGE(PG8_SA(1, 0), a3, voffA);
            PG8_BAR; PG8_WAIT_L(0); PG8_MMA(1, 0, At, B0); PG8_BAR; PG8_SCHED;
            PG8_STAGE(PG8_SB(1, 1), b3 + hstep, voffB);
            PG8_WAIT_V(6); PG8_BAR; PG8_MMA(1, 1, At, B1); PG8_BAR;
            }
        }
        if constexpr (ALIGN_EPI) { if (wr == 0) PG8_BAR; }
        if constexpr (Epi::RS_LDS) E.rsl = (LAS const float*)(lds + RS_OFF + (ui & 1) * 4096 + wr * 2048);
        const bool keep = E(acc, cur, wr, wc, fr, fq);
        if (!has_next) break;
        if (!keep) PG8_ZERO_ACC();
        cur = nxt; cA = nA; cB = nB; ++ui;
        PG8_RS_LOAD(cur, ui & 1);
        if constexpr (ALIGN_EPI) { if (wr == 1) PG8_BAR; }
    }
    PG8_WAIT_V(0);
    if constexpr (!ALIGN_EPI) { if (wr == 0) PG8_BAR; }
    PG8_BAR;
#undef PG8_SA
#undef PG8_SB
#undef PG8_STAGE
#undef PG8_LDA
#undef PG8_LDB
#undef PG8_MMA
#undef PG8_WAIT_V
#undef PG8_WAIT_L
#undef PG8_BAR
#undef PG8_SCHED
#undef PG8_ZERO_ACC
#undef PG8_RS_LOAD
}
}

struct EpiInProj {
    static constexpr bool PERM = true, RS_LDS = true;
    LAS const float* rsl;
    const float* rowss; const unsigned* csT; const unsigned* gp;
    bf16_t *QA, *KA, *VA, *QC, *KC, *VC, *HY;
    __device__ __forceinline__ bool operator()(pg8::Acc& acc, const pg8::Unit& u, int wr, int wc, int fr, int fq) const {
        const int g = 4 * u.pn + wc;
        int kind, ld, hd, gty = 0; bf16_t* dst;
        if (g < 8)       { kind = 2; dst = QA; ld = 512; hd = g; gty = 0; }
        else if (g < 10) { kind = 1; dst = KA; ld = 128; hd = g - 8; gty = 1; }
        else if (g < 12) { kind = 0; dst = VA; ld = 128; hd = g - 10; }
        else if (g < 20) { kind = 2; dst = QC; ld = 512; hd = g - 12; gty = 2; }
        else if (g < 28) { kind = 1; dst = KC; ld = 512; hd = g - 20; gty = 3; }
        else if (g < 36) { kind = 0; dst = VC; ld = 512; hd = g - 28; }
        else             { kind = 0; dst = HY; ld = 1536; hd = g - 36; }
        const int col0 = 64 * hd + 8 * fq;
        const float qs = (kind == 2) ? QSCALE : 1.f;
        float rs8[8]; rows_rstd8_lds(rsl, fr, rs8);
        const int rowb = u.pm * 256 + wr * 64 + fr;
        if (kind == 0) {
#pragma unroll
            for (int ai = 0; ai < 2; ++ai)
#pragma unroll
                for (int m = 0; m < 4; ++m) {
                    const int row = rowb + ai * 128 + m * 16;
                    const float rstd = rs8[ai * 4 + m];
                    const f32x4 a0 = acc[ai][0][m][0] * rstd, a1 = acc[ai][0][m][1] * rstd, b0 = acc[ai][1][m][0] * rstd, b1 = acc[ai][1][m][1] * rstd;
                    u32x4 wa, wb;
                    wa.x = pk2(a0[0], a0[1]); wa.y = pk2(a0[2], a0[3]); wa.z = pk2(a1[0], a1[1]); wa.w = pk2(a1[2], a1[3]);
                    wb.x = pk2(b0[0], b0[1]); wb.y = pk2(b0[2], b0[3]); wb.z = pk2(b1[0], b1[1]); wb.w = pk2(b1[2], b1[3]);
                    if (g >= 36) {
                        bf16_t* rp = dst + ((size_t)(8 * hd + fq) * MTOK + row) * 8;
                        *(u32x4*)rp = wa; *(u32x4*)(rp + (size_t)4 * MTOK * 8) = wb;
                    } else {
                        bf16_t* rp = dst + (size_t)row * ld + col0;
                        *(u32x4*)rp = wa; *(u32x4*)(rp + 32) = wb;
                    }
                }
        } else {
            const u32x4 gq0 = *(const u32x4*)(gp + gty * 32 + 8 * fq), gq1 = *(const u32x4*)(gp + gty * 32 + 8 * fq + 4);
            u32x4 cs[2][2];
            { const unsigned* cp = csT + (rowb & (SEQ - 1)) * 32 + 8 * fq; cs[0][0] = *(const u32x4*)cp; cs[0][1] = *(const u32x4*)(cp + 4); }
#pragma unroll
            for (int it = 0; it < 8; ++it) {
                const int ai = it >> 2, m = it & 3;
                const int row = rowb + ai * 128 + m * 16;
                if (it + 1 < 8) { const int nrow = rowb + ((it + 1) >> 2) * 128 + ((it + 1) & 3) * 16; const unsigned* cp = csT + (nrow & (SEQ - 1)) * 32 + 8 * fq;
                    cs[(it + 1) & 1][0] = *(const u32x4*)cp; cs[(it + 1) & 1][1] = *(const u32x4*)(cp + 4); }
                const float rstd = rs8[it];
                float ss = 0.f;
#pragma unroll
                for (int n = 0; n < 2; ++n)
#pragma unroll
                    for (int i = 0; i < 4; ++i) { const float x = acc[ai][0][m][n][i], y = acc[ai][1][m][n][i]; ss += x * x + y * y; }
                ss += __shfl_xor(ss, 16); ss += __shfl_xor(ss, 32);
                const float f = rstd * rsqrtf(ss * rstd * rstd * (1.f / 64.f) + RMS_EPS) * qs;
                u32x4 wa, wb;
#pragma unroll
                for (int n = 0; n < 2; ++n) {
                    const u32x4 gq = n ? gq1 : gq0, cq = cs[it & 1][n];
                    float ra[4], rb[4];
#pragma unroll
                    for (int i = 0; i < 4; ++i) {
                        const float ga = (float)__builtin_bit_cast(_Float16, (unsigned short)(gq[i] & 0xffffu)), gb = (float)__builtin_bit_cast(_Float16, (unsigned short)(gq[i] >> 16));
                        const float c = (float)__builtin_bit_cast(_Float16, (unsigned short)(cq[i] & 0xffffu)), sn = (float)__builtin_bit_cast(_Float16, (unsigned short)(cq[i] >> 16));
                        const float x = acc[ai][0][m][n][i] * (f * ga), y = acc[ai][1][m][n][i] * (f * gb);
                        ra[i] = x * c - y * sn; rb[i] = y * c + x * sn;
                    }
                    if (n == 0) { wa.x = pk2(ra[0], ra[1]); wa.y = pk2(ra[2], ra[3]); wb.x = pk2(rb[0], rb[1]); wb.y = pk2(rb[2], rb[3]); }
                    else        { wa.z = pk2(ra[0], ra[1]); wa.w = pk2(ra[2], ra[3]); wb.z = pk2(rb[0], rb[1]); wb.w = pk2(rb[2], rb[3]); }
                }
                bf16_t* rp = dst + (size_t)row * ld + col0;
                *(u32x4*)rp = wa; *(u32x4*)(rp + 32) = wb;
                asm volatile("" ::: "memory");
            }
        }
        return false;
    }
};

#ifndef MERGE_PD
#define MERGE_PD 2
#endif
__device__ __forceinline__ unsigned gate_q(float a) {
    const float t = __builtin_amdgcn_fmed3f(__builtin_fmaf(__builtin_amdgcn_exp2f(a), 1.f / 255.f, 1.f / 255.f), 0.f, 1.f);
    return __builtin_bit_cast(unsigned, __builtin_amdgcn_rcpf(t) + 8388608.f);
}
__device__ __forceinline__ unsigned pack_b0(unsigned u0, unsigned u1, unsigned u2, unsigned u3) {
    return __builtin_amdgcn_perm(__builtin_amdgcn_perm(u3, u2, 0x0c0c0400u), __builtin_amdgcn_perm(u1, u0, 0x0c0c0400u), 0x05040100u);
}
struct EpiGate {
    static constexpr bool PERM = true, RS_LDS = true;
    LAS const float* rsl;
    int tid; const float* rowss; float wk; u32x4* scr0;
    __device__ __forceinline__ bool operator()(pg8::Acc& acc, const pg8::Unit& u, int wr, int wc, int fr, int fq) const {
        u32x4* scr = scr0 + ((size_t)(u.pm * 4 + u.pn) * 3 + u.sub) * 8 * 512 + tid;
        float rs8[8];
#pragma unroll
        for (int k = 0; k < 8; ++k) rs8[k] = rsl[(k >> 2) * 256 + ((k & 3) * 16 + fr) * 4];
#pragma unroll
        for (int ai = 0; ai < 2; ++ai)
#pragma unroll
            for (int m = 0; m < 4; ++m) {
                const float rs = rs8[ai * 4 + m] * (-LOG2E * wk);
                unsigned pw[4];
#pragma unroll
                for (int bj = 0; bj < 2; ++bj) {
                    const pg8::i32x4v i0 = __builtin_bit_cast(pg8::i32x4v, acc[ai][bj][m][0]), i1 = __builtin_bit_cast(pg8::i32x4v, acc[ai][bj][m][1]);
                    const f32x4 v0 = {(float)i0[0], (float)i0[1], (float)i0[2], (float)i0[3]}, v1 = {(float)i1[0], (float)i1[1], (float)i1[2], (float)i1[3]};
                    pw[bj * 2] = pack_b0(gate_q(v0[0] * rs), gate_q(v0[1] * rs), gate_q(v0[2] * rs), gate_q(v0[3] * rs));
                    pw[bj * 2 + 1] = pack_b0(gate_q(v1[0] * rs), gate_q(v1[1] * rs), gate_q(v1[2] * rs), gate_q(v1[3] * rs));
                }
                u32x4 w; w.x = pw[0]; w.y = pw[1]; w.z = pw[2]; w.w = pw[3];
                scr[(size_t)(ai * 4 + m) * 512] = w;
            }
        return false;
    }
};
__device__ __forceinline__ float ub(unsigned w, int k) { return (float)((w >> (8 * k)) & 0xffu); }
struct EpiMerge {
    static constexpr bool PERM = true, RS_LDS = false;
    static constexpr int PD = MERGE_PD;
    int tid; const u32x4* scr0; bf16_t* merged;
    __device__ __forceinline__ bool operator()(pg8::Acc& acc, const pg8::Unit& u, int wr, int wc, int fr, int fq) const {
        const int sub = u.sub;
        const u32x4* sa_p = scr0 + ((size_t)(u.pm * 4 + u.pn) * 3 + sub) * 8 * 512 + tid;
        u32x4 wa[8], wb[8];
#pragma unroll
        for (int it = 0; it < PD; ++it) { wa[it] = sa_p[(size_t)it * 512]; if (sub < 2) wb[it] = sa_p[(size_t)(8 + it) * 512]; }
#pragma unroll
        for (int it = 0; it < 8; ++it) {
            const int ai = it >> 2, m = it & 3;
            const int row = u.pm * 256 + ai * 128 + wr * 64 + m * 16 + fr;
            if (it + PD < 8) { wa[it + PD] = sa_p[(size_t)(it + PD) * 512]; if (sub < 2) wb[it + PD] = sa_p[(size_t)(8 + it + PD) * 512]; }
#pragma unroll
            for (int bj = 0; bj < 2; ++bj) {
                f32x4& v0 = acc[ai][bj][m][0]; f32x4& v1 = acc[ai][bj][m][1];
                const unsigned a0 = bj ? wa[it].z : wa[it].x, a1 = bj ? wa[it].w : wa[it].y;
                if (sub < 2) {
                    const unsigned b0 = bj ? wb[it].z : wb[it].x, b1 = bj ? wb[it].w : wb[it].y;
#pragma unroll
                    for (int i = 0; i < 4; ++i) { v0[i] *= ub(a0, i) * __builtin_amdgcn_rcpf(ub(b0, i)); v1[i] *= ub(a1, i) * __builtin_amdgcn_rcpf(ub(b1, i)); }
                } else {
                    constexpr float C = 1.f / 255.f;
                    u32x4 w; w.x = pk2(v0[0] * (ub(a0, 0) * C), v0[1] * (ub(a0, 1) * C)); w.y = pk2(v0[2] * (ub(a0, 2) * C), v0[3] * (ub(a0, 3) * C));
                    w.z = pk2(v1[0] * (ub(a1, 0) * C), v1[1] * (ub(a1, 1) * C)); w.w = pk2(v1[2] * (ub(a1, 2) * C), v1[3] * (ub(a1, 3) * C));
                    *(u32x4*)(merged + (size_t)row * DM + u.pn * 256 + bj * 128 + wc * 32 + 8 * fq) = w;
                }
            }
            asm volatile("" ::: "memory");
        }
        return sub < 2;
    }
};

template <bool FINAL> struct EpiResid {
    static constexpr bool PERM = true, RS_LDS = false;
    bf16_t* xb; float* xout; float* rowss; bool dry; LAS float* red; int tid;
    __device__ __forceinline__ bool operator()(pg8::Acc& acc, const pg8::Unit& u, int wr, int wc, int fr, int fq) const {
        if (dry) return false;
#pragma unroll
        for (int ai = 0; ai < 2; ++ai)
#pragma unroll
            for (int m = 0; m < 4; ++m) {
                const int row = u.pm * 256 + ai * 128 + wr * 64 + m * 16 + fr;
                float ss = 0.f;
#pragma unroll
                for (int bj = 0; bj < 2; ++bj) {
                    const size_t off = (size_t)row * DM + u.pn * 256 + bj * 128 + wc * 32 + 8 * fq;
                    const u32x4 xo = *(const u32x4*)(xb + off);
                    const f32x4 a0 = acc[ai][bj][m][0], a1 = acc[ai][bj][m][1];
                    float xn[8] = {bflo(xo.x) + a0[0], bfhi(xo.x) + a0[1], bflo(xo.y) + a0[2], bfhi(xo.y) + a0[3], bflo(xo.z) + a1[0], bfhi(xo.z) + a1[1], bflo(xo.w) + a1[2], bfhi(xo.w) + a1[3]};
                    if (FINAL) {
                        *(f32x4*)(xout + off) = (f32x4){xn[0], xn[1], xn[2], xn[3]}; *(f32x4*)(xout + off + 4) = (f32x4){xn[4], xn[5], xn[6], xn[7]};
                    } else {
                        u32x4 w; w.x = pk2(xn[0], xn[1]); w.y = pk2(xn[2], xn[3]); w.z = pk2(xn[4], xn[5]); w.w = pk2(xn[6], xn[7]);
                        *(u32x4*)(xb + off) = w;
                        const float r[8] = {bflo(w.x), bfhi(w.x), bflo(w.y), bfhi(w.y), bflo(w.z), bfhi(w.z), bflo(w.w), bfhi(w.w)};
#pragma unroll
                        for (int i = 0; i < 8; ++i) ss += r[i] * r[i];
                    }
                }
                if (!FINAL) { ss += __shfl_xor(ss, 16); ss += __shfl_xor(ss, 32); if (fq == 0) red[(ai * 128 + wr * 64 + m * 16 + fr) * 4 + wc] = ss; }
            }
        if (!FINAL) {
            asm volatile("s_waitcnt lgkmcnt(0)" ::: "memory"); __builtin_amdgcn_s_barrier(); asm volatile("" ::: "memory");
            if (tid < 256) { const f32x4 p = *(const LAS f32x4*)(red + tid * 4); rowss[(size_t)(u.pm * 256 + tid) * 4 + u.pn] = (p[0] + p[1]) + (p[2] + p[3]); }
            asm volatile("s_waitcnt lgkmcnt(0)" ::: "memory"); __builtin_amdgcn_s_barrier(); asm volatile("" ::: "memory");
        }
        return false;
    }
};

struct EpiSwiGLU {
    static constexpr bool PERM = true, RS_LDS = true;
    LAS const float* rsl;
    const float* rowss; bf16_t* act; bool dry;
    __device__ __forceinline__ bool operator()(pg8::Acc& acc, const pg8::Unit& u, int wr, int wc, int fr, int fq) const {
        if (dry) return false;
        float rs8[8]; rows_rstd8_lds(rsl, fr, rs8);
#pragma unroll
        for (int ai = 0; ai < 2; ++ai) {
            if (u.half == 2 - ai) continue;
#pragma unroll
            for (int m = 0; m < 4; ++m) {
                const int row = u.pm * 256 + ai * 128 + wr * 64 + m * 16 + fr;
                const float rstd = rs8[ai * 4 + m];
                float o[8];
#pragma unroll
                for (int n = 0; n < 2; ++n)
#pragma unroll
                    for (int i = 0; i < 4; ++i) {
                        const float a = acc[ai][0][m][n][i] * rstd, b = acc[ai][1][m][n][i] * rstd;
                        o[4 * n + i] = a * __builtin_amdgcn_rcpf(1.f + __builtin_amdgcn_exp2f(-a * LOG2E)) * b;
                    }
                u32x4 w; w.x = pk2(o[0], o[1]); w.y = pk2(o[2], o[3]); w.z = pk2(o[4], o[5]); w.w = pk2(o[6], o[7]);
                *(u32x4*)(act + (size_t)row * DFF + u.pn * 128 + wc * 32 + 8 * fq) = w;
            }
        }
        return false;
    }
};

#define XB_TMO      128
#define XB_XCNT(j)  (256  + 64 * (j))
#define XB_XSUB(j)  (1280 + 64 * (j))
#define XB_XGEN(j)  (2304 + 64 * (j))
#define XB_TOP      3328
#define XB_TOPGEN   3392
#define XCD_BAR_WORDS 3456
#define XB_SPIN_CAP (1u << 18)
__device__ __forceinline__ unsigned xb_ld(unsigned* p)              { return __hip_atomic_load(p, __ATOMIC_RELAXED, __HIP_MEMORY_SCOPE_AGENT); }
__device__ __forceinline__ unsigned xb_add(unsigned* p, unsigned v) { return __hip_atomic_fetch_add(p, v, __ATOMIC_RELAXED, __HIP_MEMORY_SCOPE_AGENT); }
__device__ __forceinline__ unsigned xb_xcc_id() { return (unsigned)__builtin_amdgcn_s_getreg((3 << 11) | 20) & 0xFu; }
#define XB_SPIN(cond, bar) do { unsigned _sp = 0; while (cond) { __builtin_amdgcn_s_sleep(1); \
    if ((++_sp & 255u) == 0u) { if (xb_ld(&(bar)[XB_TMO])) break; if (_sp > XB_SPIN_CAP) { atomicAdd(&(bar)[XB_TMO], 1u); break; } } } } while (0)
struct XcdBarrier { unsigned* bar; unsigned x; volatile LAS unsigned* st; };
__device__ __forceinline__ XcdBarrier xcd_barrier_post(unsigned* bar, volatile LAS unsigned* st) {
    XcdBarrier b; b.bar = bar; b.x = xb_xcc_id(); b.st = st;
    if (threadIdx.x == 0) (void)xb_add(&bar[XB_XCNT(b.x)], 1u);
    return b;
}
__device__ __forceinline__ void xcd_barrier_complete(unsigned* bar, unsigned x, unsigned& nloc, unsigned& nx) {
    const unsigned G = gridDim.x * gridDim.y * gridDim.z;
    unsigned sum, cnt, mine, sp = 0u;
    for (;;) {
        sum = 0u; cnt = 0u; mine = 0u;
#pragma unroll
        for (unsigned j = 0; j < 16; ++j) { const unsigned c = xb_ld(&bar[XB_XCNT(j)]); sum += c; cnt += (c > 0u) ? 1u : 0u; mine = (j == x) ? c : mine; }
        if (sum == G) break;
        __builtin_amdgcn_s_sleep(1);
        if ((++sp & 255u) == 0u) { if (xb_ld(&bar[XB_TMO])) break; if (sp > XB_SPIN_CAP) { atomicAdd(&bar[XB_TMO], 1u); break; } }
    }
    nloc = mine > 0u ? mine : 1u; nx = cnt > 0u ? cnt : 1u;
}
__device__ __forceinline__ void xcd_barrier(const XcdBarrier& b) {
    asm volatile("s_waitcnt vmcnt(0)" ::: "memory");
    __syncthreads();
    if (threadIdx.x == 0) {
        unsigned* bar = b.bar;
        __builtin_amdgcn_s_waitcnt(0);
        unsigned nloc = b.st[0], nx = b.st[1];
        if (nloc == 0u) { xcd_barrier_complete(bar, b.x, nloc, nx); b.st[0] = nloc; b.st[1] = nx; }
        const unsigned old = xb_add(&bar[XB_XSUB(b.x)], 1u);
        const unsigned gen = old / nloc;
        if (old + 1u == (gen + 1u) * nloc) {
            __builtin_amdgcn_fence(__ATOMIC_RELEASE, "agent");
            asm volatile("s_waitcnt vmcnt(0)" ::: "memory");
            const unsigned og = xb_add(&bar[XB_TOP], 1u);
            const unsigned tg = og / nx;
            if (og + 1u == (tg + 1u) * nx) xb_add(&bar[XB_TOPGEN], 1u);
            else XB_SPIN(xb_ld(&bar[XB_TOPGEN]) == tg, bar);
            __builtin_amdgcn_fence(__ATOMIC_ACQUIRE, "agent");
            xb_add(&bar[XB_XGEN(b.x)], 1u);
            asm volatile("s_waitcnt vmcnt(0)" ::: "memory");
        } else {
            XB_SPIN(xb_ld(&bar[XB_XGEN(b.x)]) == gen, bar);
            __builtin_amdgcn_fence(__ATOMIC_ACQUIRE, "agent");
            asm volatile("s_waitcnt vmcnt(0)" ::: "memory");
        }
    }
    __syncthreads();
}

struct Frame {
    LAS unsigned char* lds;
    int tid, lane, wave, G, bid;
    bool dry;
    const Params* P;
};

__device__ __forceinline__ void transpose_item(const float* W, int N, int k0, int n0, bf16_t* WT, int K, int drow_lo, int drow_hi, const float* gain, LAS float* scr, int lane) {
#pragma unroll
    for (int h = 0; h < 2; ++h) {
        f32x4 v[8];
#pragma unroll
        for (int i = 0; i < 8; ++i) { const int kk = 4 * (8 * h + i) + (lane >> 4); v[i] = __builtin_nontemporal_load((const f32x4*)(W + (size_t)(k0 + kk) * N + n0 + 4 * (lane & 15))); }
#pragma unroll
        for (int i = 0; i < 8; ++i) { const int kk = 4 * (8 * h + i) + (lane >> 4); f32x4 w = v[i]; if (gain) w = w * gain[k0 + kk];
            LAS float* d = scr + kk * 65 + 4 * (lane & 15); d[0] = w[0]; d[1] = w[1]; d[2] = w[2]; d[3] = w[3]; }
    }
    asm volatile("s_waitcnt lgkmcnt(0)" ::: "memory");
    const int c = lane & 7;
#pragma unroll
    for (int j = 0; j < 8; ++j) { const int n = (lane >> 3) + 8 * j; const LAS float* s = scr + (8 * c) * 65 + n;
        u32x4 o; o.x = pk2(s[0 * 65], s[1 * 65]); o.y = pk2(s[2 * 65], s[3 * 65]); o.z = pk2(s[4 * 65], s[5 * 65]); o.w = pk2(s[6 * 65], s[7 * 65]);
        const int drow = (n < 32) ? drow_lo + n : drow_hi + n - 32;
        *(u32x4*)(WT + (size_t)drow * K + k0 + 8 * c) = o; }
    asm volatile("s_waitcnt lgkmcnt(0)" ::: "memory");
}
__device__ __forceinline__ unsigned q8(float t) { return __builtin_bit_cast(unsigned, __builtin_amdgcn_fmed3f(t, -127.f, 127.f) + 12582912.f); }
__device__ __forceinline__ float absmax_item(const float* W, int N, int k0, int n0, const float* gain, int lane) {
    float mx = 0.f;
#pragma unroll
    for (int h = 0; h < 2; ++h) {
        f32x4 v[8];
#pragma unroll
        for (int i = 0; i < 8; ++i) { const int kk = 4 * (8 * h + i) + (lane >> 4); v[i] = *(const f32x4*)(W + (size_t)(k0 + kk) * N + n0 + 4 * (lane & 15)); }
#pragma unroll
        for (int i = 0; i < 8; ++i) { const int kk = 4 * (8 * h + i) + (lane >> 4); const float g = fabsf(gain[k0 + kk]);
            mx = fmaxf(mx, g * fmaxf(fmaxf(fabsf(v[i][0]), fabsf(v[i][1])), fmaxf(fabsf(v[i][2]), fabsf(v[i][3])))); }
    }
#pragma unroll
    for (int o = 32; o > 0; o >>= 1) mx = fmaxf(mx, __shfl_xor(mx, o));
    return mx;
}
__device__ __forceinline__ void transpose_item_i8(const float* W, int N, int k0, int n0, unsigned char* WT8, int K, int drow0, const float* gain, float scale, LAS float* scr, int lane) {
#pragma unroll
    for (int h = 0; h < 2; ++h) {
        f32x4 v[8];
#pragma unroll
        for (int i = 0; i < 8; ++i) { const int kk = 4 * (8 * h + i) + (lane >> 4); v[i] = __builtin_nontemporal_load((const f32x4*)(W + (size_t)(k0 + kk) * N + n0 + 4 * (lane & 15))); }
#pragma unroll
        for (int i = 0; i < 8; ++i) { const int kk = 4 * (8 * h + i) + (lane >> 4); const f32x4 w = v[i] * (gain[k0 + kk] * scale);
            LAS float* d = scr + kk * 65 + 4 * (lane & 15); d[0] = w[0]; d[1] = w[1]; d[2] = w[2]; d[3] = w[3]; }
    }
    asm volatile("s_waitcnt lgkmcnt(0)" ::: "memory");
    const int c = lane & 7;
#pragma unroll
    for (int j = 0; j < 8; ++j) { const int n = (lane >> 3) + 8 * j; const LAS float* s = scr + (8 * c) * 65 + n;
        const unsigned lo = pack_b0(q8(s[0 * 65]), q8(s[1 * 65]), q8(s[2 * 65]), q8(s[3 * 65])), hi = pack_b0(q8(s[4 * 65]), q8(s[5 * 65]), q8(s[6 * 65]), q8(s[7 * 65]));
        *(u32x2*)(WT8 + (size_t)(drow0 + n) * K + k0 + 8 * c) = (u32x2){lo, hi}; }
    asm volatile("s_waitcnt lgkmcnt(0)" ::: "memory");
}
__device__ __forceinline__ int inproj_base(int g) {
    if (g < 8) return 64 * g;
    if (g < 10) return 512 + 64 * (g - 8);
    if (g < 12) return 640 + 64 * (g - 10);
    if (g < 20) return 2304 + 64 * (g - 12);
    if (g < 28) return 2816 + 64 * (g - 20);
    if (g < 36) return 3328 + 64 * (g - 28);
    return 768 + 64 * (g - 36);
}
__device__ __forceinline__ void p0_weights(const Frame& F, int l) {
    const Params& P = *F.P;
    LAS float* scr = (LAS float*)(F.lds + F.wave * 16640);
    const int gw = F.bid * 8 + F.wave, NGW = F.G * 8;
    unsigned char* ws = P.ws + opaque_zero();
    const float* w_in = P.in[I_WIN] + (size_t)l * DM * INC;
    const float* n1g = P.in[I_N1G] + l * DM; const float* n2g = P.in[I_N2G] + l * DM;
    constexpr int N1 = 60 * 16, N2 = 48 * 16, N3 = 3 * 128, N4 = 256, N5 = 2 * 44 * 16, N6 = 44 * 16;
    constexpr int NIT = N1 + N2 + N3 + N4 + N5 + N6;
    for (int it = gw; it < NIT; it += NGW) {
        int r = it;
        if (r < N1) { const int g = r / 16, kb = r % 16; const int d0 = 256 * (g >> 2) + 32 * (g & 3);
            transpose_item(w_in, INC, 64 * kb, inproj_base(g), (bf16_t*)(ws + W_IN), DM, d0, d0 + 128, n1g, scr, F.lane); continue; }
        r -= N1;
        if (r < N2) { const int cb = r / 16, kb = r % 16;
            const float mx = absmax_item(w_in, INC, 64 * kb, NMAIN + 64 * cb, n1g, F.lane);
            if (F.lane == 0) atomicMax((unsigned*)(ws + CTL_BAR) + CTLW_GWMAX + 16 * l, __builtin_bit_cast(unsigned, mx)); continue; }
        r -= N2;
        if (r < N3) { const int w = r / 128, q = r % 128, cb = q / 8, kb = q % 8;
            const float* src = P.in[I_WOA + w] + (size_t)l * 512 * DM;
            transpose_item(src, DM, 64 * kb, 64 * cb, (bf16_t*)(ws + W_OA) + (size_t)w * DM * 512, 512, 64 * cb, 64 * cb + 32, nullptr, scr, F.lane); continue; }
        r -= N3;
        if (r < N4) { const int cb = r / 16, kb = r % 16;
            transpose_item(P.in[I_WOUT] + (size_t)l * DM * DM, DM, 64 * kb, 64 * cb, (bf16_t*)(ws + W_OUT), DM, 64 * cb, 64 * cb + 32, nullptr, scr, F.lane); continue; }
        r -= N4;
        if (r < N5) { const int which = r / (44 * 16), q = r % (44 * 16), cb = q / 16, kb = q % 16; const int c = 64 * cb;
            const float* src = P.in[which ? I_FFW3 : I_FFW1] + (size_t)l * DM * DFF; const int d0 = 256 * (c >> 7) + 128 * which + (c & 127);
            transpose_item(src, DFF, 64 * kb, c, (bf16_t*)(ws + W_13), DM, d0, d0 + 32, n2g, scr, F.lane); continue; }
        r -= N5;
        { const int cb = r / 44, kb = r % 44;
            transpose_item(P.in[I_FFW2] + (size_t)l * DFF * DM, DM, 64 * kb, 64 * cb, (bf16_t*)(ws + W_2), DFF, 64 * cb, 64 * cb + 32, nullptr, scr, F.lane); }
    }
}
__device__ __forceinline__ void p0_misc(const Frame& F) {
    const Params& P = *F.P;
    unsigned char* ws = P.ws + opaque_zero();
    const int gw = F.bid * 8 + F.wave, NGW = F.G * 8, lane = F.lane;
    const int gt = F.bid * NTHREADS + F.tid, NGT = F.G * NTHREADS;
    float* rowssA = (float*)(ws + WS_ROWSSA);
    const float* x = P.in[I_X]; bf16_t* xb = (bf16_t*)(ws + WS_XB);
    for (int m = gw; m < MTOK; m += NGW) {
        const f32x4* xr = (const f32x4*)(x + (size_t)m * DM) + lane;
        float s = 0.f; f32x4 v[4];
#pragma unroll
        for (int j = 0; j < 4; ++j) { v[j] = __builtin_nontemporal_load(xr + 64 * j); s += v[j][0] * v[j][0] + v[j][1] * v[j][1] + v[j][2] * v[j][2] + v[j][3] * v[j][3]; }
        s = wave_sum(s);
        u32x2* o = (u32x2*)(xb + (size_t)m * DM) + lane;
#pragma unroll
        for (int j = 0; j < 4; ++j) { u32x2 w; w.x = pk2(v[j][0], v[j][1]); w.y = pk2(v[j][2], v[j][3]); o[64 * j] = w; }
        if (lane < 4) rowssA[(size_t)m * 4 + lane] = (lane == 0) ? s : 0.f;
    }
    unsigned* csT = (unsigned*)(ws + CTL_COS);
    for (int i = gt; i < SEQ * 32; i += NGT) { const int pos = i >> 5, k = i & 31;
        const double inv = exp(-(double)k / 32.0 * log(10000.0)); const double ang = (double)pos * inv;
        const _Float16 ch = (_Float16)(float)cos(ang), sh = (_Float16)(float)sin(ang);
        csT[i] = (unsigned)__builtin_bit_cast(unsigned short, ch) | ((unsigned)__builtin_bit_cast(unsigned short, sh) << 16); }
    f32x2* tw = (f32x2*)(ws + CTL_TW);
    for (int i = gt; i < 2048; i += NGT) { float s, c; sincospif(-(float)i * (1.f / 2048.f), &s, &c); tw[i] = (f32x2){c, s}; }
    { unsigned* gp = (unsigned*)(ws + CTL_SIN);
      for (int i = gt; i < DEPTH * 4 * 32; i += NGT) { const int l = i >> 7, ty = (i >> 5) & 3, d = i & 31;
          const float* gsrc = P.in[ty == 0 ? I_QNA : (ty == 1 ? I_KNA : (ty == 2 ? I_QNC : I_KNC))] + l * 64;
          const _Float16 lo = (_Float16)gsrc[d], hi = (_Float16)gsrc[d + 32];
          gp[i] = (unsigned)__builtin_bit_cast(unsigned short, lo) | ((unsigned)__builtin_bit_cast(unsigned short, hi) << 16); } }
    if (gt < DEPTH) { const int l = gt; float a = 0.f, b = 0.f;
        for (int i = 0; i < 64; ++i) { a += P.in[I_LQ1][l * 64 + i] * P.in[I_LK1][l * 64 + i]; b += P.in[I_LQ2][l * 64 + i] * P.in[I_LK2][l * 64 + i]; }
        const float li = 0.8f - 0.6f * expf(-0.3f * (float)l);
        ((float*)(ws + CTL_LAM))[l] = expf(a) - expf(b) + li; }
    float* H2 = (float*)(ws + CTL_H2);
    for (int it = gw; it < DEPTH * SEQ; it += NGW) {
        const int l = it / SEQ, t = it % SEQ;
        const float* w1 = P.in[I_FW1] + l * 33 * 64; const float* w2 = P.in[I_FW2] + l * 64 * 64;
        const int band = (lane & 15) + 1; const int ph = (t * band) & 2047;
        float sv, cv; sincospif((float)ph * (1.f / 1024.f), &sv, &cv);
        float pre = P.in[I_FB1][l * 64 + lane] + ((float)t / (float)(SEQ - 1)) * w1[lane];
#pragma unroll
        for (int k = 0; k < 16; ++k) { pre += __shfl(cv, k) * w1[(1 + k) * 64 + lane]; pre += __shfl(sv, k) * w1[(17 + k) * 64 + lane]; }
        const float h1 = sinf(P.in[I_FF1][l * 64 + lane] * pre);
        float pre2 = P.in[I_FB2][l * 64 + lane];
        for (int j = 0; j < 64; ++j) pre2 += __shfl(h1, j) * w2[j * 64 + lane];
        ((bf16_t*)H2)[(size_t)it * 64 + lane] = f2bf(sinf(P.in[I_FF2][l * 64 + lane] * pre2));
    }
}

__device__ __forceinline__ f32x2 cmul(f32x2 a, f32x2 b) { return (f32x2){a.x * b.x - a.y * b.y, a.x * b.y + a.y * b.x}; }
__device__ __forceinline__ f32x2 cmulc(f32x2 a, f32x2 b) { return (f32x2){a.x * b.x + a.y * b.y, a.y * b.x - a.x * b.y}; }
__device__ __forceinline__ f32x2 mul_mi(f32x2 a) { return (f32x2){a.y, -a.x}; }
__device__ __forceinline__ f32x2 mul_pi(f32x2 a) { return (f32x2){-a.y, a.x}; }
constexpr float RS2 = 0.70710678118654752f;
__device__ __forceinline__ int pidx(int i) { return i + (i >> 3); }
struct Tw3 { f32x2 w1, w2, w3; };
struct TwF { f32x2 w1, s1, w2, s2, w3, s3; };
struct TwI { f32x2 c1, t1, c2, t2, c3, t3; };
__device__ __forceinline__ f32x2 cm2(f32x2 a, f32x2 w, f32x2 s) { const f32x2 t = (f32x2){a.x, a.x} * w; return __builtin_elementwise_fma((f32x2){a.y, a.y}, s, t); }
__device__ __forceinline__ TwF tw_fwd(const Tw3& t) { return TwF{t.w1, (f32x2){-t.w1.y, t.w1.x}, t.w2, (f32x2){-t.w2.y, t.w2.x}, t.w3, (f32x2){-t.w3.y, t.w3.x}}; }
__device__ __forceinline__ TwI tw_inv(const Tw3& t) { return TwI{(f32x2){t.w1.x, -t.w1.y}, (f32x2){t.w1.y, t.w1.x}, (f32x2){t.w2.x, -t.w2.y}, (f32x2){t.w2.y, t.w2.x}, (f32x2){t.w3.x, -t.w3.y}, (f32x2){t.w3.y, t.w3.x}}; }
template <bool UNIT> __device__ __forceinline__ void r8_fwd(f32x2 (&v)[8], const TwF& T) {
    {
        f32x2 d0 = v[0] - v[4], d1 = v[1] - v[5], d2 = v[2] - v[6], d3 = v[3] - v[7];
        v[0] = v[0] + v[4]; v[1] = v[1] + v[5]; v[2] = v[2] + v[6]; v[3] = v[3] + v[7];
        d1 = (f32x2){(d1.x + d1.y) * RS2, (d1.y - d1.x) * RS2};
        d2 = mul_mi(d2);
        d3 = (f32x2){(d3.y - d3.x) * RS2, -(d3.x + d3.y) * RS2};
        if (UNIT) { v[4] = d0; v[5] = d1; v[6] = d2; v[7] = d3; }
        else { v[4] = cm2(d0, T.w1, T.s1); v[5] = cm2(d1, T.w1, T.s1); v[6] = cm2(d2, T.w1, T.s1); v[7] = cm2(d3, T.w1, T.s1); }
    }
#pragma unroll
    for (int q = 0; q < 8; q += 4) {
        const f32x2 d0 = v[q] - v[q + 2], d1 = mul_mi(v[q + 1] - v[q + 3]);
        v[q] = v[q] + v[q + 2]; v[q + 1] = v[q + 1] + v[q + 3];
        if (UNIT) { v[q + 2] = d0; v[q + 3] = d1; } else { v[q + 2] = cm2(d0, T.w2, T.s2); v[q + 3] = cm2(d1, T.w2, T.s2); }
    }
#pragma unroll
    for (int q = 0; q < 8; q += 2) { const f32x2 d = v[q] - v[q + 1]; v[q] = v[q] + v[q + 1]; v[q + 1] = UNIT ? d : cm2(d, T.w3, T.s3); }
}
template <bool UNIT> __device__ __forceinline__ void r8_inv(f32x2 (&v)[8], const TwI& T) {
#pragma unroll
    for (int q = 0; q < 8; q += 2) { const f32x2 b = UNIT ? v[q + 1] : cm2(v[q + 1], T.c3, T.t3), a = v[q]; v[q] = a + b; v[q + 1] = a - b; }
#pragma unroll
    for (int q = 0; q < 8; q += 4) {
        const f32x2 b0 = UNIT ? v[q + 2] : cm2(v[q + 2], T.c2, T.t2), b1 = mul_pi(UNIT ? v[q + 3] : cm2(v[q + 3], T.c2, T.t2)), a0 = v[q], a1 = v[q + 1];
        v[q] = a0 + b0; v[q + 2] = a0 - b0; v[q + 1] = a1 + b1; v[q + 3] = a1 - b1;
    }
    {
        const f32x2 b0 = UNIT ? v[4] : cm2(v[4], T.c1, T.t1); f32x2 b1 = UNIT ? v[5] : cm2(v[5], T.c1, T.t1); const f32x2 b2 = mul_pi(UNIT ? v[6] : cm2(v[6], T.c1, T.t1)); f32x2 b3 = UNIT ? v[7] : cm2(v[7], T.c1, T.t1);
        b1 = (f32x2){(b1.x - b1.y) * RS2, (b1.x + b1.y) * RS2};
        b3 = (f32x2){-(b3.x + b3.y) * RS2, (b3.x - b3.y) * RS2};
        const f32x2 a0 = v[0], a1 = v[1], a2 = v[2], a3 = v[3];
        v[0] = a0 + b0; v[4] = a0 - b0; v[1] = a1 + b1; v[5] = a1 - b1; v[2] = a2 + b2; v[6] = a2 - b2; v[3] = a3 + b3; v[7] = a3 - b3;
    }
}
__device__ __forceinline__ void wave_lds_sync() { asm volatile("s_waitcnt lgkmcnt(0)" ::: "memory"); }
struct FftTw { Tw3 w512, w64, w8; };
__device__ __forceinline__ Tw3 tw3_make(int e) {
    Tw3 t; float s, c;
    sincospif(-(float)e * (1.f / 2048.f), &s, &c); t.w1 = (f32x2){c, s};
    sincospif(-(float)(2 * e) * (1.f / 2048.f), &s, &c); t.w2 = (f32x2){c, s};
    sincospif(-(float)(4 * e) * (1.f / 2048.f), &s, &c); t.w3 = (f32x2){c, s};
    return t;
}
__device__ __forceinline__ FftTw fft_twiddles(int tid) { FftTw t; t.w512 = tw3_make(tid); t.w64 = tw3_make(8 * (tid & 63)); t.w8 = tw3_make(64 * (tid & 7)); return t; }
template <int SP> __device__ __forceinline__ int fft_base(int tid) { return (tid / SP) * 8 * SP + (tid & (SP - 1)); }
template <int SP> __device__ __forceinline__ void fft_ld(const LAS f32x2* X, int tid, f32x2 (&v)[8]) {
    const int base = fft_base<SP>(tid);
#pragma unroll
    for (int j = 0; j < 8; ++j) v[j] = X[pidx(base + j * SP)];
}
template <int SP> __device__ __forceinline__ void fft_st(LAS f32x2* X, int tid, const f32x2 (&v)[8]) {
    const int base = fft_base<SP>(tid);
#pragma unroll
    for (int j = 0; j < 8; ++j) X[pidx(base + j * SP)] = v[j];
}
template <int SP> __device__ __forceinline__ void fft_pass_fwd(LAS f32x2* X, int tid, const Tw3& w) { const TwF T = tw_fwd(w); f32x2 v[8]; fft_ld<SP>(X, tid, v); r8_fwd<false>(v, T); fft_st<SP>(X, tid, v); }
template <int SP> __device__ __forceinline__ void fft_pass_inv(LAS f32x2* X, int tid, const Tw3& w) { const TwI T = tw_inv(w); f32x2 v[8]; fft_ld<SP>(X, tid, v); r8_inv<false>(v, T); fft_st<SP>(X, tid, v); }

constexpr int HY_STG = 0, HY_STG_BYTES = 2 * 2050 * 16, HY_X = 65664, HY_X_BYTES = 4608 * 8, HY_RED = HY_X + HY_X_BYTES;
static_assert(HY_STG_BYTES <= HY_X && HY_X + 2 * HY_X_BYTES <= LDS_BARST, "hyena lds");

constexpr int HM_RS = 192, HM_PLANE = 32 * HM_RS, HM_STG = 0, HM_STG_BYTES = 16 * HM_PLANE;
constexpr int HM_FT = HM_STG_BYTES, HM_FRS = 136, HM_FTBL = 64 * HM_FRS;
constexpr int HM_WT = HM_FT + 3 * HM_FTBL, HM_END = HM_WT + 4096 * 4;
static_assert(HM_END + 128 <= LDS_BARST, "hyena mfma lds");
__device__ __forceinline__ bf16x8 hm_ld_tr(const LAS unsigned char* p) {
    const s16x4 lo4 = __builtin_amdgcn_ds_read_tr16_b64_v4i16((LAS s16x4*)p);
    const s16x4 hi4 = __builtin_amdgcn_ds_read_tr16_b64_v4i16((LAS s16x4*)(p + 4 * HM_RS));
    return (bf16x8){lo4[0], lo4[1], lo4[2], lo4[3], hi4[0], hi4[1], hi4[2], hi4[3]};
}
__device__ __forceinline__ bf16x8 hm_ld2(const LAS unsigned char* p, int off2) {
    const u32x2 a = *(const LAS u32x2*)p, b = *(const LAS u32x2*)(p + off2);
    return __builtin_bit_cast(bf16x8, (u32x4){a.x, a.y, b.x, b.y});
}
__device__ __forceinline__ bf16x8 hm_pack(const f32x16& t, int s) {
    u32x4 w; w.x = pk2(t[8 * s + 0], t[8 * s + 1]); w.y = pk2(t[8 * s + 2], t[8 * s + 3]); w.z = pk2(t[8 * s + 4], t[8 * s + 5]); w.w = pk2(t[8 * s + 6], t[8 * s + 7]);
    return __builtin_bit_cast(bf16x8, w);
}
#define HM_MFMA(a, b, c) __builtin_amdgcn_mfma_f32_32x32x16_bf16(a, b, c, 0, 0, 0)
struct HmF3 { bf16x8 r, i, n; };
__device__ __forceinline__ HmF3 hm_ldf(const LAS unsigned char* fp, int off2) { HmF3 f; f.r = hm_ld2(fp, off2); f.i = hm_ld2(fp + HM_FTBL, off2); f.n = hm_ld2(fp + 2 * HM_FTBL, off2); return f; }
__device__ __forceinline__ void hm_conv_wave(LAS unsigned char* lds, int lane, int ch, const f32x2* H) {
    const int r32 = lane & 31, h = lane >> 5;
    LAS unsigned char* PR = lds + HM_STG + (ch * 2) * HM_PLANE; LAS unsigned char* PI = PR + HM_PLANE;
    const LAS unsigned char* FT = lds + HM_FT; const LAS unsigned* WT = (const LAS unsigned*)(lds + HM_WT);
    f32x16 xr[2], xi[2];
#pragma unroll
    for (int nt = 0; nt < 2; ++nt)
#pragma unroll
        for (int r = 0; r < 16; ++r) { xr[nt][r] = 0.f; xi[nt][r] = 0.f; }
    const int trow0 = 8 * h + ((lane & 15) >> 2), tcol0 = 16 * ((lane >> 4) & 1) + 4 * (lane & 3);
#pragma unroll 1
    for (int c1 = 0; c1 < 2; ++c1) {
        const int k1 = 32 * c1 + r32;
        bf16x8 yrB[4], yiB[4];
        {
            const LAS unsigned char* fb = FT + k1 * HM_FRS + 8 * h * 2;
            bf16x8 aR = hm_ld_tr(PR + trow0 * HM_RS + tcol0 * 2), aI = hm_ld_tr(PI + trow0 * HM_RS + tcol0 * 2);
            HmF3 f = hm_ldf(fb, 8);
#pragma unroll
            for (int rt = 0; rt < 2; ++rt) {
                f32x16 yr, yi;
#pragma unroll
                for (int r = 0; r < 16; ++r) { yr[r] = 0.f; yi[r] = 0.f; }
#pragma unroll
                for (int ks = 0; ks < 2; ++ks) {
                    const int g = 2 * rt + ks;
                    bf16x8 aRn = aR, aIn = aI; HmF3 fn = f;
                    if (g + 1 < 4) { const int rt2 = (g + 1) >> 1, ks2 = (g + 1) & 1;
                        aRn = hm_ld_tr(PR + (16 * ks2 + trow0) * HM_RS + (32 * rt2 + tcol0) * 2); aIn = hm_ld_tr(PI + (16 * ks2 + trow0) * HM_RS + (32 * rt2 + tcol0) * 2);
                        fn = hm_ldf(fb + 16 * ks2 * 2, 8); }
                    yr = HM_MFMA(aR, f.r, yr); yr = HM_MFMA(aI, f.n, yr);
                    yi = HM_MFMA(aR, f.i, yi); yi = HM_MFMA(aI, f.r, yi);
                    asm volatile("" ::: "memory");
                    aR = aRn; aI = aIn; f = fn;
                }
#pragma unroll
                for (int r = 0; r < 16; ++r) {
                    const int n2 = 32 * rt + (r & 3) + 8 * (r >> 2) + 4 * h;
                    const unsigned w = WT[k1 * n2];
                    const float wr = (float)__builtin_bit_cast(_Float16, (unsigned short)(w & 0xffffu)), wi = (float)__builtin_bit_cast(_Float16, (unsigned short)(w >> 16));
                    const float a = yr[r], b = yi[r];
                    yr[r] = a * wr - b * wi; yi[r] = a * wi + b * wr;
                }
#pragma unroll
                for (int s = 0; s < 2; ++s) { yrB[2 * rt + s] = hm_pack(yr, s); yiB[2 * rt + s] = hm_pack(yi, s); }
            }
        }
        bf16x8 zrA[4], ziA[4];
#pragma unroll
        for (int kt = 0; kt < 2; ++kt) {
            f32x16 zr, zi;
#pragma unroll
            for (int r = 0; r < 16; ++r) { zr[r] = 0.f; zi[r] = 0.f; }
            f32x2 hv[16];
#pragma unroll
            for (int r = 0; r < 16; ++r) hv[r] = H[(32 * kt + (r & 3) + 8 * (r >> 2) + 4 * h) * 64 + k1];
            const LAS unsigned char* fb = FT + (32 * kt + r32) * HM_FRS + 4 * h * 2;
            HmF3 f = hm_ldf(fb, 16);
#pragma unroll
            for (int q = 0; q < 4; ++q) {
                HmF3 fn = f; if (q + 1 < 4) fn = hm_ldf(fb + 16 * (q + 1) * 2, 16);
                zr = HM_MFMA(f.r, yrB[q], zr); zr = HM_MFMA(f.n, yiB[q], zr);
                zi = HM_MFMA(f.i, yrB[q], zi); zi = HM_MFMA(f.r, yiB[q], zi);
                asm volatile("" ::: "memory");
                f = fn;
            }
#pragma unroll
            for (int r = 0; r < 16; ++r) {
                const float a = zr[r], b = zi[r];
                zr[r] = a * hv[r].x - b * hv[r].y; zi[r] = a * hv[r].y + b * hv[r].x;
            }
#pragma unroll
            for (int s = 0; s < 2; ++s) { zrA[2 * kt + s] = hm_pack(zr, s); ziA[2 * kt + s] = hm_pack(zi, s); }
        }
#pragma unroll
        for (int nt = 0; nt < 2; ++nt) {
            const int n2 = 32 * nt + r32;
            f32x16 vr, vi;
#pragma unroll
            for (int r = 0; r < 16; ++r) { vr[r] = 0.f; vi[r] = 0.f; }
            const LAS unsigned char* fb = FT + n2 * HM_FRS + 4 * h * 2;
            HmF3 f = hm_ldf(fb, 16);
#pragma unroll
            for (int q = 0; q < 4; ++q) {
                HmF3 fn = f; if (q + 1 < 4) fn = hm_ldf(fb + 16 * (q + 1) * 2, 16);
                vr = HM_MFMA(zrA[q], f.r, vr); vr = HM_MFMA(ziA[q], f.i, vr);
                vi = HM_MFMA(ziA[q], f.r, vi); vi = HM_MFMA(zrA[q], f.n, vi);
                asm volatile("" ::: "memory");
                f = fn;
            }
            const LAS unsigned char* f4 = FT + r32 * HM_FRS + (32 * c1 + 4 * h) * 2;
            HmF3 g0 = hm_ldf(f4, 16), g1 = hm_ldf(f4 + 16 * 2, 16);
#pragma unroll
            for (int r = 0; r < 16; ++r) {
                const int kk = 32 * c1 + (r & 3) + 8 * (r >> 2) + 4 * h;
                const unsigned w = WT[kk * n2];
                const float wr = (float)__builtin_bit_cast(_Float16, (unsigned short)(w & 0xffffu)), wi = (float)__builtin_bit_cast(_Float16, (unsigned short)(w >> 16));
                const float a = vr[r], b = vi[r];
                vr[r] = a * wr + b * wi; vi[r] = b * wr - a * wi;
            }
            {
                const bf16x8 vrB = hm_pack(vr, 0), viB = hm_pack(vi, 0);
                xr[nt] = HM_MFMA(g0.r, vrB, xr[nt]); xr[nt] = HM_MFMA(g0.i, viB, xr[nt]);
                xi[nt] = HM_MFMA(g0.r, viB, xi[nt]); xi[nt] = HM_MFMA(g0.n, vrB, xi[nt]);
            }
            {
                const bf16x8 vrB = hm_pack(vr, 1), viB = hm_pack(vi, 1);
                xr[nt] = HM_MFMA(g1.r, vrB, xr[nt]); xr[nt] = HM_MFMA(g1.i, viB, xr[nt]);
                xi[nt] = HM_MFMA(g1.r, viB, xi[nt]); xi[nt] = HM_MFMA(g1.n, vrB, xi[nt]);
            }
            asm volatile("" ::: "memory");
        }
    }
    asm volatile("s_waitcnt lgkmcnt(0)" ::: "memory");
#pragma unroll
    for (int nt = 0; nt < 2; ++nt)
#pragma unroll
        for (int r = 0; r < 16; ++r) {
            const int n1 = (r & 3) + 8 * (r >> 2) + 4 * h, off = n1 * HM_RS + (32 * nt + r32) * 2;
            *(LAS unsigned short*)(PR + off) = f2bf(xr[nt][r]); *(LAS unsigned short*)(PI + off) = f2bf(xi[nt][r]);
        }
}
__device__ __forceinline__ void hm_init_tables(LAS unsigned char* lds, int tid) {
    for (int i = tid; i < 4096; i += NTHREADS) {
        const int a = i >> 6, b = i & 63; float s, c; sincospif(-(float)((a * b) & 63) * (1.f / 32.f), &s, &c);
        LAS unsigned short* fp = (LAS unsigned short*)(lds + HM_FT + a * HM_FRS + b * 2);
        fp[0] = f2bf(c); fp[HM_FTBL / 2] = f2bf(s); fp[HM_FTBL] = f2bf(-s);
        float s2, c2; sincospif(-(float)i * (1.f / 2048.f), &s2, &c2);
        const _Float16 ch_ = (_Float16)c2, sh_ = (_Float16)s2;
        ((LAS unsigned*)(lds + HM_WT))[i] = (unsigned)__builtin_bit_cast(unsigned short, ch_) | ((unsigned)__builtin_bit_cast(unsigned short, sh_) << 16);
    }
}
__device__ __forceinline__ void hm_spec_wave(const LAS unsigned char* lds, int lane, int cc, int c1, float scale, float dd, f32x2* dst) {
    const int r32 = lane & 31, h = lane >> 5, k1 = 32 * c1 + r32;
    const LAS unsigned char* PR = lds + HM_STG + cc * (64 * HM_RS);
    const LAS unsigned char* FT = lds + HM_FT; const LAS unsigned* WT = (const LAS unsigned*)(lds + HM_WT);
    const int trow0 = 8 * h + ((lane & 15) >> 2), tcol0 = 16 * ((lane >> 4) & 1) + 4 * (lane & 3);
    bf16x8 yrB[4], yiB[4];
#pragma unroll
    for (int rt = 0; rt < 2; ++rt) {
        f32x16 yr, yi;
#pragma unroll
        for (int r = 0; r < 16; ++r) { yr[r] = 0.f; yi[r] = 0.f; }
#pragma unroll
        for (int ks = 0; ks < 4; ++ks) {
            const bf16x8 aR = hm_ld_tr(PR + (16 * ks + trow0) * HM_RS + (32 * rt + tcol0) * 2);
            const LAS unsigned char* fp = FT + k1 * HM_FRS + (16 * ks + 8 * h) * 2;
            const bf16x8 bFr = hm_ld2(fp, 8), bFi = hm_ld2(fp + HM_FTBL, 8);
            yr = HM_MFMA(aR, bFr, yr); yi = HM_MFMA(aR, bFi, yi);
            asm volatile("" ::: "memory");
        }
#pragma unroll
        for (int r = 0; r < 16; ++r) {
            const int n2 = 32 * rt + (r & 3) + 8 * (r >> 2) + 4 * h;
            const unsigned w = WT[k1 * n2];
            const float wr = (float)__builtin_bit_cast(_Float16, (unsigned short)(w & 0xffffu)), wi = (float)__builtin_bit_cast(_Float16, (unsigned short)(w >> 16));
            const float a = yr[r], b = yi[r];
            yr[r] = a * wr - b * wi; yi[r] = a * wi + b * wr;
        }
#pragma unroll
        for (int s = 0; s < 2; ++s) { yrB[2 * rt + s] = hm_pack(yr, s); yiB[2 * rt + s] = hm_pack(yi, s); }
    }
#pragma unroll
    for (int kt = 0; kt < 2; ++kt) {
        f32x16 zr, zi;
#pragma unroll
        for (int r = 0; r < 16; ++r) { zr[r] = 0.f; zi[r] = 0.f; }
#pragma unroll
        for (int q = 0; q < 4; ++q) {
            const HmF3 f = hm_ldf(FT + (32 * kt + r32) * HM_FRS + (16 * q + 4 * h) * 2, 16);
            zr = HM_MFMA(f.r, yrB[q], zr); zr = HM_MFMA(f.n, yiB[q], zr);
            zi = HM_MFMA(f.i, yrB[q], zi); zi = HM_MFMA(f.r, yiB[q], zi);
            asm volatile("" ::: "memory");
        }
#pragma unroll
        for (int r = 0; r < 16; ++r) {
            const int k2 = 32 * kt + (r & 3) + 8 * (r >> 2) + 4 * h;
            dst[k2 * 64 + k1] = (f32x2){zr[r] * scale + dd, zi[r] * scale};
        }
    }
}
constexpr int HM_W3L = HM_END + 128;
static_assert(HM_W3L + 32 * HM_FRS <= LDS_BARST, "spectra lds");
__device__ __forceinline__ void spectra_phase(const Frame& F, int l) {
    const Params& P = *F.P; unsigned char* ws = P.ws + opaque_zero(); const int tid = F.tid, lane = F.lane, r32 = lane & 31, h = lane >> 5;
    LAS unsigned char* lds = F.lds; LAS float* red = (LAS float*)(lds + HM_END);
    hm_init_tables(lds, tid);
    const bf16_t* H2B = (const bf16_t*)(ws + CTL_H2) + (size_t)l * SEQ * 64;
    const float* w3 = P.in[I_FW3] + (size_t)l * 64 * 2048;
    f32x2* spec = (f32x2*)(ws + WS_S);
    const float min_decay = logf(0.01f) / 1.5f, max_decay = logf(0.01f) / 0.3f;
    for (int it = F.bid; it < 256; it += F.G) {
        const int o = it >> 7, c0 = (it & 127) * 4;
        { const int row = tid >> 6, j = tid & 63;
          *(LAS unsigned short*)(lds + HM_W3L + row * HM_FRS + j * 2) = f2bf(w3[(size_t)j * 2048 + (o * 2 + (row >> 2)) * 512 + c0 + (row & 3)]);
#pragma unroll
          for (int k = 0; k < 3; ++k) { const int e = tid + 512 * k; *(LAS unsigned short*)(lds + HM_W3L + (8 + (e >> 6)) * HM_FRS + (e & 63) * 2) = 0; } }
        __syncthreads();
        bf16x8 wA[4];
#pragma unroll
        for (int ks = 0; ks < 4; ++ks) wA[ks] = hm_ld2(lds + HM_W3L + r32 * HM_FRS + (16 * ks + 8 * h) * 2, 8);
        float dl[4];
#pragma unroll
        for (int cc = 0; cc < 4; ++cc) dl[cc] = fabsf(min_decay + (max_decay - min_decay) * ((float)(c0 + cc) / 511.f));
        float ss[4] = {0.f, 0.f, 0.f, 0.f};
#pragma unroll 2
        for (int tt = F.wave; tt < 64; tt += 8) {
            const int t = 32 * tt + r32;
            const bf16_t* hp = H2B + (size_t)t * 64 + 8 * h;
            f32x16 d;
#pragma unroll
            for (int r = 0; r < 16; ++r) d[r] = 0.f;
            bf16x8 hb[4];
#pragma unroll
            for (int ks = 0; ks < 4; ++ks) hb[ks] = *(const bf16x8*)(hp + 16 * ks);
#pragma unroll
            for (int ks = 0; ks < 4; ++ks) d = HM_MFMA(wA[ks], hb[ks], d);
            const float tn = (float)t / (float)(SEQ - 1);
#pragma unroll
            for (int cc = 0; cc < 4; ++cc) {
                float v = d[cc] * expf(-tn * dl[cc]);
                const float other = __shfl_xor(v, 32);
                LAS unsigned char* PR = lds + HM_STG + cc * (64 * HM_RS);
                int n;
                if (t == 0) { if (h == 0) { v += other; n = 0; } else { v = 0.f; n = 2048; } }
                else n = h ? 4096 - t : t;
                *(LAS unsigned short*)(PR + (n >> 6) * HM_RS + (n & 63) * 2) = f2bf(v);
                ss[cc] += v * v;
            }
        }
#pragma unroll
        for (int cc = 0; cc < 4; ++cc) ss[cc] = wave_sum(ss[cc]);
        if (lane == 0) *(LAS f32x4*)(red + F.wave * 4) = (f32x4){ss[0], ss[1], ss[2], ss[3]};
        __syncthreads();
        {
            const int cc = F.wave & 3, c = c0 + cc;
            float tot = 0.f;
#pragma unroll
            for (int w = 0; w < 8; ++w) tot += red[w * 4 + cc];
            const float scale = rsqrtf(tot + RMS_EPS) * (1.f / 4096.f);
            const float dd = P.in[I_HYD][(l * 2 + o) * 512 + c] * (1.f / 4096.f);
            hm_spec_wave(lds, lane, cc, F.wave >> 2, scale, dd, spec + (size_t)(o * 512 + c) * 4096);
        }
        __syncthreads();
    }
}

__device__ __forceinline__ int hm_addr(int ch, int pl, int t) { return ((ch * 2 + pl) * 32 + (t >> 6)) * HM_RS + (t & 63) * 2; }
template <int MODE> __device__ __forceinline__ void hm_elem_pass(const Frame& F, LAS unsigned char* lds, const bf16_t* HY, int b0, int coff, const float* cw, const float* cb, bf16_t* outp, int c0) {
    const int tid = F.tid, b = tid >> 8, t0 = (tid & 255) * 8;
    const bf16_t* rp = HY + ((size_t)(coff >> 3) * MTOK + (size_t)(b0 + b) * SEQ + t0) * 8;
    u32x4 x[10];
    const u32x4 z4 = {0u, 0u, 0u, 0u};
    x[0] = (t0 > 0) ? *(const u32x4*)(rp - 8) : z4;
#pragma unroll
    for (int i = 0; i < 8; ++i) x[1 + i] = *(const u32x4*)(rp + 8 * i);
    x[9] = (t0 + 8 < SEQ) ? *(const u32x4*)(rp + 64) : z4;
    u32x4 res[8];
#pragma unroll
    for (int kp = 0; kp < 4; ++kp) {
        const float wl0 = cw[coff + 2 * kp], wl1 = cw[1536 + coff + 2 * kp], wl2 = cw[2 * 1536 + coff + 2 * kp], bl = cb[coff + 2 * kp];
        const float wh0 = cw[coff + 2 * kp + 1], wh1 = cw[1536 + coff + 2 * kp + 1], wh2 = cw[2 * 1536 + coff + 2 * kp + 1], bh = cb[coff + 2 * kp + 1];
        float lo[8], hi[8];
#pragma unroll
        for (int i = 0; i < 8; ++i) {
            lo[i] = bflo(x[i][kp]) * wl0 + bflo(x[i + 1][kp]) * wl1 + bflo(x[i + 2][kp]) * wl2 + bl;
            hi[i] = bfhi(x[i][kp]) * wh0 + bfhi(x[i + 1][kp]) * wh1 + bfhi(x[i + 2][kp]) * wh2 + bh;
        }
        if (MODE != 0) {
            const u32x4 pl = *(const LAS u32x4*)(lds + HM_STG + hm_addr(2 * kp, b, t0)), ph = *(const LAS u32x4*)(lds + HM_STG + hm_addr(2 * kp + 1, b, t0));
#pragma unroll
            for (int i = 0; i < 4; ++i) { lo[2 * i] *= bflo(pl[i]); lo[2 * i + 1] *= bfhi(pl[i]); hi[2 * i] *= bflo(ph[i]); hi[2 * i + 1] *= bfhi(ph[i]); }
        }
        res[2 * kp] = (u32x4){pk2(lo[0], lo[1]), pk2(lo[2], lo[3]), pk2(lo[4], lo[5]), pk2(lo[6], lo[7])};
        res[2 * kp + 1] = (u32x4){pk2(hi[0], hi[1]), pk2(hi[2], hi[3]), pk2(hi[4], hi[5]), pk2(hi[6], hi[7])};
    }
    if (MODE == 2) {
#pragma unroll
        for (int i = 0; i < 8; ++i) {
            u32x4 w;
#pragma unroll
            for (int kp = 0; kp < 4; ++kp) {
                const unsigned a = res[2 * kp][i >> 1], c = res[2 * kp + 1][i >> 1];
                w[kp] = (i & 1) ? ((a >> 16) | (c & 0xffff0000u)) : ((a & 0xffffu) | (c << 16));
            }
            *(u32x4*)(outp + ((size_t)(b0 + b) * SEQ + t0 + i) * 512 + c0) = w;
        }
    } else {
#pragma unroll
        for (int k = 0; k < 8; ++k) *(LAS u32x4*)(lds + HM_STG + hm_addr(k, b, t0)) = res[k];
    }
    __syncthreads();
}
__device__ __forceinline__ void p2_gate_prep(const Frame& F, int l) {
    const Params& P = *F.P; unsigned char* ws = P.ws + opaque_zero();
    const int gw = F.bid * 8 + F.wave, NGW = F.G * 8, lane = F.lane;
    LAS float* scr = (LAS float*)(F.lds + F.wave * 16640);
    const float wmax = __builtin_bit_cast(float, ((const unsigned*)(ws + CTL_BAR))[CTLW_GWMAX + 16 * l]);
    const float wscale = wmax > 0.f ? 127.f / wmax : 0.f;
    const float* w_in = P.in[I_WIN] + (size_t)l * DM * INC; const float* n1g = P.in[I_N1G] + l * DM;
    for (int it = gw; it < 48 * 16; it += NGW) { const int cb = it / 16, kb = it % 16;
        transpose_item_i8(w_in, INC, 64 * kb, NMAIN + 64 * cb, ws + W_IN + (size_t)NMAIN * DM * 2, DM, 64 * cb, n1g, wscale, scr, lane); }
}
__device__ __forceinline__ void gate_rows_i8(const Frame& F, int wv, int nw) {
    const Params& P = *F.P; unsigned char* ws = P.ws + opaque_zero(); const int lane = F.lane;
    const float* rowss = (const float*)(ws + WS_ROWSSA); float* fct = (float*)(ws + CTL_FCTA);
    for (int m0 = wv; m0 < MTOK; m0 += 4 * nw) {
        u32x4 v[4][2];
#pragma unroll
        for (int r = 0; r < 4; ++r) { const int m = m0 + r * nw; if (m < MTOK) { const u32x4* xr = (const u32x4*)(ws + WS_XB + (size_t)m * DM * 2) + lane; v[r][0] = xr[0]; v[r][1] = xr[64]; } }
#pragma unroll
        for (int r = 0; r < 4; ++r) { const int m = m0 + r * nw; if (m < MTOK) {
            float f[16];
#pragma unroll
            for (int h = 0; h < 2; ++h) { const u32x4 w = v[r][h]; f[8 * h + 0] = bflo(w.x); f[8 * h + 1] = bfhi(w.x); f[8 * h + 2] = bflo(w.y); f[8 * h + 3] = bfhi(w.y);
                f[8 * h + 4] = bflo(w.z); f[8 * h + 5] = bfhi(w.z); f[8 * h + 6] = bflo(w.w); f[8 * h + 7] = bfhi(w.w); }
            float mx = 0.f;
#pragma unroll
            for (int e = 0; e < 16; ++e) mx = fmaxf(mx, fabsf(f[e]));
#pragma unroll
            for (int o = 32; o > 0; o >>= 1) mx = fmaxf(mx, __shfl_xor(mx, o));
            const float sc = mx > 0.f ? 127.f / mx : 0.f;
            u32x2* o8 = (u32x2*)(ws + WS_XB8 + (size_t)m * DM) + lane;
#pragma unroll
            for (int h = 0; h < 2; ++h)
                o8[64 * h] = (u32x2){pack_b0(q8(f[8 * h] * sc), q8(f[8 * h + 1] * sc), q8(f[8 * h + 2] * sc), q8(f[8 * h + 3] * sc)), pack_b0(q8(f[8 * h + 4] * sc), q8(f[8 * h + 5] * sc), q8(f[8 * h + 6] * sc), q8(f[8 * h + 7] * sc))};
            if (lane == 0) { const f32x4 q = *(const f32x4*)(rowss + (size_t)m * 4);
                *(f32x4*)(fct + (size_t)m * 4) = (f32x4){rsqrtf(((q[0] + q[1]) + (q[2] + q[3])) * (1.f / DM) + RMS_EPS) * mx * (1.f / 127.f), 0.f, 0.f, 0.f}; }
        } }
    }
}
__device__ __forceinline__ void hyena_phase(const Frame& F, int l) {
    const Params& P = *F.P; unsigned char* ws = P.ws + opaque_zero(); const int tid = F.tid;
    LAS unsigned char* lds = F.lds;
    hm_init_tables(lds, tid);
    const bf16_t* HY = (const bf16_t*)(ws + G_HY); bf16_t* OB = (bf16_t*)(ws + WS_OB);
    const f32x2* spec = (const f32x2*)(ws + WS_S);
    const float* cw = P.in[I_CONVW] + (size_t)l * 3 * 1536; const float* cb = P.in[I_CONVB] + (size_t)l * 1536;
    for (int it = F.bid; it < 256; it += F.G) {
        const int combo = (it & 7) * 4 + (it >> 6), bp = combo >> 3, cg = (combo & 7) * 8 + ((it >> 3) & 7), b0 = 2 * bp, c0 = 8 * cg;
        hm_elem_pass<0>(F, lds, HY, b0, c0, cw, cb, nullptr, c0);
        hm_conv_wave(lds, F.lane, F.wave, spec + (size_t)(c0 + F.wave) * 4096);
        __syncthreads();
        hm_elem_pass<1>(F, lds, HY, b0, 512 + c0, cw, cb, nullptr, c0);
        hm_conv_wave(lds, F.lane, F.wave, spec + (size_t)(512 + c0 + F.wave) * 4096);
        __syncthreads();
        hm_elem_pass<2>(F, lds, HY, b0, 1024 + c0, cw, cb, OB, c0);
    }
}

template <int KW, int DV, bool WINDOW>
__device__ __forceinline__ void attn_core(LAS unsigned char* lds, int tid, const bf16_t* Qg, int ldq, const bf16_t* Kb, int ldk, const bf16_t* Vb, int ldv,
                                          int q0, int t_lo, int t_hi, float m_init, float l_init, int kcol, f32x16 (&o)[DV / 32], float& m_out, float& l_out) {
    constexpr int KSTR = (KW + 8) * 2, VSTR = (DV == 128) ? 320 : 192, KCH = KW / 8, VCH = DV / 8, NK = 64 * KCH / NTHREADS, NV = 64 * VCH / NTHREADS;
    constexpr int KBUF = 64 * KSTR, VBUF = 64 * VSTR, VOFF = 2 * KBUF;
    const int lane = tid & 63, wave = tid >> 6, w4 = wave & 3, r32 = lane & 31, h = lane >> 5;
    const int qrow = q0 + 32 * w4 + r32;
    bf16x8 qf[4];
#pragma unroll
    for (int ds = 0; ds < 4; ++ds) qf[ds] = *(const bf16x8*)(Qg + (size_t)qrow * ldq + 16 * ds + 8 * h);
#pragma unroll
    for (int db = 0; db < DV / 32; ++db)
#pragma unroll
        for (int r = 0; r < 16; ++r) o[db][r] = 0.f;
    float m = m_init, l = l_init;
    u32x4 kreg[NK], vreg[NV];
    auto kload = [&](int t) {
#pragma unroll
        for (int i = 0; i < NK; ++i) { const int c = tid + NTHREADS * i, row = c / KCH, ch = c % KCH; kreg[i] = *(const u32x4*)(Kb + (size_t)(64 * t + row) * ldk + ch * 8); }
    };
    auto vload = [&](int t) {
#pragma unroll
        for (int i = 0; i < NV; ++i) { const int c = tid + NTHREADS * i, row = c / VCH, ch = c % VCH; vreg[i] = *(const u32x4*)(Vb + (size_t)(64 * t + row) * ldv + ch * 8); }
    };
    auto kstore = [&](int buf) {
#pragma unroll
        for (int i = 0; i < NK; ++i) { const int c = tid + NTHREADS * i, row = c / KCH, ch = c % KCH; *(LAS u32x4*)(lds + buf * KBUF + row * KSTR + ch * 16) = kreg[i]; }
    };
    auto vstore = [&](int buf) {
#pragma unroll
        for (int i = 0; i < NV; ++i) { const int c = tid + NTHREADS * i, row = c / VCH, ch = c % VCH; *(LAS u32x4*)(lds + VOFF + buf * VBUF + row * VSTR + ch * 16) = vreg[i]; }
    };
    auto qk = [&](int buf, f32x16& S0, f32x16& S1) {
#pragma unroll
        for (int r = 0; r < 16; ++r) { S0[r] = 0.f; S1[r] = 0.f; }
        const LAS unsigned char* kb = lds + buf * KBUF + r32 * KSTR + (kcol + 8 * h) * 2;
#pragma unroll
        for (int ds = 0; ds < 4; ++ds) {
            const bf16x8 k0 = *(const LAS bf16x8*)(kb + ds * 32);
            const bf16x8 k1 = *(const LAS bf16x8*)(kb + 32 * KSTR + ds * 32);
            S0 = __builtin_amdgcn_mfma_f32_32x32x16_bf16(k0, qf[ds], S0, 0, 0, 0);
            S1 = __builtin_amdgcn_mfma_f32_32x32x16_bf16(k1, qf[ds], S1, 0, 0, 0);
        }
    };
    kload(t_lo); vload(t_lo); kstore(0); vstore(0);
    if (t_lo < t_hi) kload(t_lo + 1);
    __syncthreads();
    f32x16 Sa0, Sa1, Sb0, Sb1;
    qk(0, Sa0, Sa1);
    if (t_lo < t_hi) kstore(1);
    __syncthreads();
    auto step = [&](int t, f32x16& S0, f32x16& S1, f32x16& N0, f32x16& N1) {
        const int i = t - t_lo, vcur = i & 1, knext = (i + 1) & 1;
        if (t + 2 <= t_hi) kload(t + 2);
        if (t + 1 <= t_hi) { vload(t + 1); qk(knext, N0, N1); }
        if (WINDOW) {
            const int kbase = 64 * t + 4 * h - qrow;
#pragma unroll
            for (int r = 0; r < 16; ++r) {
                const int d0 = kbase + (r & 3) + 8 * (r >> 2), d1 = d0 + 32;
                if (d0 > 128 || d0 < -128) S0[r] = -1e30f;
                if (d1 > 128 || d1 < -128) S1[r] = -1e30f;
            }
        }
        float mx0 = fmaxf(fmaxf(S0[0], S0[1]), S0[2]), mx1 = fmaxf(fmaxf(S1[0], S1[1]), S1[2]);
#pragma unroll
        for (int r = 3; r < 15; r += 2) { mx0 = fmaxf(fmaxf(mx0, S0[r]), S0[r + 1]); mx1 = fmaxf(fmaxf(mx1, S1[r]), S1[r + 1]); }
        float mx = fmaxf(fmaxf(mx0, S0[15]), fmaxf(mx1, S1[15]));
        mx = fmaxf(mx, __shfl_xor(mx, 32));
        if (__any(mx > m + 6.0f)) {
            const float mnew = fmaxf(m, mx);
            const float alpha = __builtin_amdgcn_exp2f(m - mnew);
            m = mnew; l *= alpha;
#pragma unroll
            for (int db = 0; db < DV / 32; ++db)
#pragma unroll
                for (int r = 0; r < 16; ++r) o[db][r] *= alpha;
        }
        float ps0 = 0.f, ps1 = 0.f, ps2 = 0.f, ps3 = 0.f;
#pragma unroll
        for (int r = 0; r < 16; r += 2) {
            S0[r] = __builtin_amdgcn_exp2f(S0[r] - m); S0[r + 1] = __builtin_amdgcn_exp2f(S0[r + 1] - m); S1[r] = __builtin_amdgcn_exp2f(S1[r] - m); S1[r + 1] = __builtin_amdgcn_exp2f(S1[r + 1] - m);
            ps0 += S0[r]; ps1 += S0[r + 1]; ps2 += S1[r]; ps3 += S1[r + 1];
        }
        l += (ps0 + ps1) + (ps2 + ps3);
        bf16x8 pf[2][2];
#pragma unroll
        for (int s = 0; s < 2; ++s) {
            u32x4 w0, w1;
            w0.x = pk2(S0[8 * s + 0], S0[8 * s + 1]); w0.y = pk2(S0[8 * s + 2], S0[8 * s + 3]); w0.z = pk2(S0[8 * s + 4], S0[8 * s + 5]); w0.w = pk2(S0[8 * s + 6], S0[8 * s + 7]);
            w1.x = pk2(S1[8 * s + 0], S1[8 * s + 1]); w1.y = pk2(S1[8 * s + 2], S1[8 * s + 3]); w1.z = pk2(S1[8 * s + 4], S1[8 * s + 5]); w1.w = pk2(S1[8 * s + 6], S1[8 * s + 7]);
            pf[0][s] = __builtin_bit_cast(bf16x8, w0); pf[1][s] = __builtin_bit_cast(bf16x8, w1);
        }
        const LAS unsigned char* vb = lds + VOFF + vcur * VBUF + (4 * h + ((lane & 15) >> 2)) * VSTR + (16 * ((lane >> 4) & 1) + 4 * (lane & 3)) * 2;
#pragma unroll
        for (int kh = 0; kh < 2; ++kh)
#pragma unroll
            for (int s = 0; s < 2; ++s)
#pragma unroll
                for (int db = 0; db < DV / 32; ++db) {
                    const LAS unsigned char* p = vb + (32 * kh + 16 * s) * VSTR + db * 64;
                    const s16x4 lo4 = __builtin_amdgcn_ds_read_tr16_b64_v4i16((LAS s16x4*)p);
                    const s16x4 hi4 = __builtin_amdgcn_ds_read_tr16_b64_v4i16((LAS s16x4*)(p + 8 * VSTR));
                    const bf16x8 vf = {lo4[0], lo4[1], lo4[2], lo4[3], hi4[0], hi4[1], hi4[2], hi4[3]};
                    o[db] = __builtin_amdgcn_mfma_f32_32x32x16_bf16(vf, pf[kh][s], o[db], 0, 0, 0);
                }
        if (t + 2 <= t_hi) kstore(i & 1);
        if (t + 1 <= t_hi) vstore((i + 1) & 1);
        __syncthreads();
    };
    int t = t_lo;
    for (; t + 1 <= t_hi; t += 2) { step(t, Sa0, Sa1, Sb0, Sb1); step(t + 1, Sb0, Sb1, Sa0, Sa1); }
    if (t <= t_hi) step(t, Sa0, Sa1, Sb0, Sb1);
    m_out = m; l_out = l;
}

constexpr int ATT_CMB = 75776;
template <int WHICH> __device__ __forceinline__ void attn_phase(const Frame& F, int l) {
    const Params& P = *F.P; unsigned char* ws = P.ws + opaque_zero(); const int tid = F.tid, lane = F.lane, wave = F.wave, g = wave >> 2, w4 = wave & 3, r32 = lane & 31, h = lane >> 5;
    if constexpr (WHICH == 0) {
        const bf16_t* QC = (const bf16_t*)(ws + WS_QC); const bf16_t* KC = (const bf16_t*)(ws + G_KC); const bf16_t* VC = (const bf16_t*)(ws + G_VC); bf16_t* OC = (bf16_t*)(ws + WS_QC);
        const float lam = ((const float*)(ws + CTL_LAM))[l];
        const float lam_init = 0.8f - 0.6f * expf(-0.3f * (float)l);
        const float* subln = P.in[I_SUBLN] + l * 128;
        for (int u = F.bid; u < 512; u += F.G) {
            const int b = u >> 6, head = (u >> 4) & 3, qblk = u & 15, q0 = qblk * 128;
            const size_t rb = (size_t)b * SEQ;
            f32x16 o[4]; float m, lsum;
            attn_core<128, 128, false>(F.lds, tid, QC + rb * 512 + head * 128 + g * 64, 512, KC + rb * 512 + head * 128, 512, VC + rb * 512 + head * 128, 512,
                                       q0, 0, 31, -1e30f, 0.f, g * 64, o, m, lsum);
            lsum += __shfl_xor(lsum, 32);
            const float inv = 1.f / lsum;
            LAS f32x4* cmb = (LAS f32x4*)(F.lds + ATT_CMB);
            if (g == 1) {
#pragma unroll
                for (int db = 0; db < 4; ++db)
#pragma unroll
                    for (int rq = 0; rq < 4; ++rq) cmb[((w4 * 16 + db * 4 + rq) * 64) + lane] = (f32x4){o[db][4 * rq] * inv, o[db][4 * rq + 1] * inv, o[db][4 * rq + 2] * inv, o[db][4 * rq + 3] * inv};
            }
            __syncthreads();
            if (g == 0 && !F.dry) {
                float ss = 0.f;
#pragma unroll
                for (int db = 0; db < 4; ++db)
#pragma unroll
                    for (int rq = 0; rq < 4; ++rq) {
                        const f32x4 o2 = cmb[((w4 * 16 + db * 4 + rq) * 64) + lane];
#pragma unroll
                        for (int i = 0; i < 4; ++i) { const float v = o[db][4 * rq + i] * inv - lam * o2[i]; o[db][4 * rq + i] = v; ss += v * v; }
                    }
                ss += __shfl_xor(ss, 32);
                const float rn = rsqrtf(ss * (1.f / 128.f) + RMS_EPS) * (1.f - lam_init);
                const int qrow = q0 + 32 * w4 + r32;
                bf16_t* op = OC + (rb + qrow) * 512 + head * 128;
#pragma unroll
                for (int db = 0; db < 4; ++db)
#pragma unroll
                    for (int rp = 0; rp < 2; ++rp) {
                        u32x2 w[2];
#pragma unroll
                        for (int k = 0; k < 2; ++k) { const int rq = 2 * rp + k, d = 32 * db + 8 * rq + 4 * h; const f32x4 sg = *(const f32x4*)(subln + d);
                            w[k].x = pk2(o[db][4 * rq] * rn * sg[0], o[db][4 * rq + 1] * rn * sg[1]); w[k].y = pk2(o[db][4 * rq + 2] * rn * sg[2], o[db][4 * rq + 3] * rn * sg[3]); }
                        { auto r = __builtin_amdgcn_permlane32_swap(w[0].x, w[1].x, false, false); w[0].x = r[0]; w[1].x = r[1]; }
                        { auto r = __builtin_amdgcn_permlane32_swap(w[0].y, w[1].y, false, false); w[0].y = r[0]; w[1].y = r[1]; }
                        *(u32x4*)(op + 32 * db + 16 * rp + 8 * h) = (u32x4){w[0].x, w[0].y, w[1].x, w[1].y};
                    }
            }
        }
    }
    if constexpr (WHICH == 1) {
        const bf16_t* QA = (const bf16_t*)(ws + WS_QA); const bf16_t* KA = (const bf16_t*)(ws + G_KA); const bf16_t* VA = (const bf16_t*)(ws + G_VA); bf16_t* OA = (bf16_t*)(ws + WS_QA);
        const float* sink = P.in[I_SINK] + l * 8;
        for (int u = F.bid; u < 512; u += F.G) {
            const int b = u >> 6, kvh = (u >> 5) & 1, qblk = (u >> 1) & 15, hp = u & 1, q0 = qblk * 128;
            const int qh = kvh * 4 + hp * 2 + g;
            const size_t rb = (size_t)b * SEQ;
            int t_lo = (q0 - 128) / 64; if (t_lo < 0) t_lo = 0;
            int t_hi = (q0 + 255) / 64; if (t_hi > 31) t_hi = 31;
            f32x16 o[2]; float m, lsum;
            attn_core<64, 64, true>(F.lds, tid, QA + rb * 512 + qh * 64, 512, KA + rb * 128 + kvh * 64, 128, VA + rb * 128 + kvh * 64, 128,
                                    q0, t_lo, t_hi, sink[qh] * LOG2E, (h == 0) ? 1.f : 0.f, 0, o, m, lsum);
            lsum += __shfl_xor(lsum, 32);
            const float inv = 1.f / lsum;
            const int qrow = q0 + 32 * w4 + r32;
            bf16_t* op = OA + (rb + qrow) * 512 + qh * 64;
            if (!F.dry)
#pragma unroll
            for (int db = 0; db < 2; ++db)
#pragma unroll
                for (int rp = 0; rp < 2; ++rp) {
                    u32x2 w[2];
#pragma unroll
                    for (int k = 0; k < 2; ++k) { const int rq = 2 * rp + k;
                        w[k].x = pk2(o[db][4 * rq] * inv, o[db][4 * rq + 1] * inv); w[k].y = pk2(o[db][4 * rq + 2] * inv, o[db][4 * rq + 3] * inv); }
                    { auto r = __builtin_amdgcn_permlane32_swap(w[0].x, w[1].x, false, false); w[0].x = r[0]; w[1].x = r[1]; }
                    { auto r = __builtin_amdgcn_permlane32_swap(w[0].y, w[1].y, false, false); w[0].y = r[0]; w[1].y = r[1]; }
                    *(u32x4*)(op + 32 * db + 16 * rp + 8 * h) = (u32x4){w[0].x, w[0].y, w[1].x, w[1].y};
                }
        }
    }
}

__device__ __forceinline__ void p1_inproj(const Frame& F, int l) {
    const Params& P = *F.P; unsigned char* ws = P.ws + opaque_zero();
    pg8::Gemm g{(const bf16_t*)(ws + WS_XB), (const bf16_t*)(ws + W_IN), MTOK, NMAIN, DM, 0, 0};
    pg8::StaticOrder S; S.init(MTOK, NMAIN, F.G, F.bid);
    EpiInProj E{nullptr, (const float*)(ws + WS_ROWSSA), (const unsigned*)(ws + CTL_COS), (const unsigned*)(ws + CTL_SIN) + l * 128,
                (bf16_t*)(ws + WS_QA), (bf16_t*)(ws + G_KA), (bf16_t*)(ws + G_VA), (bf16_t*)(ws + WS_QC), (bf16_t*)(ws + G_KC), (bf16_t*)(ws + G_VC), (bf16_t*)(ws + G_HY)};
    pg8::Acc acc;
    {
        const int U = (MTOK / 256) * (NMAIN / 256), R = (U + F.G - 1) / F.G; int ns = R * F.G - U, si = F.bid - (F.G - ns);
        if (ns == 0) { ns = F.G; si = F.bid; }
        if (si >= 0) gate_rows_i8(F, si * 8 + F.wave, ns * 8);
        __syncthreads();
    }
    pg8::gemm_phase<EpiInProj, pg8::StaticOrder, true, true, true>(F.lds, F.tid, g, S, E, acc);
}
__device__ __forceinline__ void p3_merge(const Frame& F, int l) {
    const Params& P = *F.P; unsigned char* ws = P.ws + opaque_zero();
    pg8::ChainOrder3 S; S.S.init(MTOK, DM, F.G, F.bid);
    {
        pg8::Gemm g{(const bf16_t*)(ws + WS_XB8), (const bf16_t*)(ws + W_IN + (size_t)NMAIN * DM * 2), MTOK, DM, DM, 0, (size_t)DM * DM};
        EpiGate E{nullptr, F.tid, (const float*)(ws + CTL_FCTA), __builtin_bit_cast(float, ((const unsigned*)(ws + CTL_BAR))[CTLW_GWMAX + 16 * l]) * (1.f / 127.f), (u32x4*)(ws + WS_G)};
        pg8::Acc acc;
        pg8::gemm_phase<EpiGate, pg8::ChainOrder3, true, true, true, false, true>(F.lds, F.tid, g, S, E, acc);
    }
    {
        pg8::Gemm g{(const bf16_t*)(ws + WS_QA), (const bf16_t*)(ws + W_OA), MTOK, DM, 512, (size_t)16 * MiB, (size_t)DM * 512 * 2};
        EpiMerge E{F.tid, (const u32x4*)(ws + WS_G), (bf16_t*)(ws + WS_S)};
        pg8::Acc acc;
        pg8::gemm_phase<EpiMerge, pg8::ChainOrder3, true, true, true>(F.lds, F.tid, g, S, E, acc);
    }
}
__device__ __forceinline__ void p4_wout(const Frame& F, int l) {
    const Params& P = *F.P; unsigned char* ws = P.ws + opaque_zero();
    pg8::Gemm g{(const bf16_t*)(ws + WS_S), (const bf16_t*)(ws + W_OUT), MTOK, DM, DM, 0, 0};
    pg8::StaticOrder S; S.init(MTOK, DM, F.G, F.bid);
    EpiResid<false> E{(bf16_t*)(ws + WS_XB), P.out, (float*)(ws + WS_ROWSSB), F.dry, (LAS float*)(F.lds + pg8::STAGE_BYTES), F.tid};
    pg8::Acc acc;
    pg8::gemm_phase<EpiResid<false>, pg8::StaticOrder, true, true, true>(F.lds, F.tid, g, S, E, acc);
}
__device__ __forceinline__ void p5_ffn_up(const Frame& F, int l) {
    const Params& P = *F.P; unsigned char* ws = P.ws + opaque_zero();
    pg8::Gemm g{(const bf16_t*)(ws + WS_XB), (const bf16_t*)(ws + W_13), MTOK, 2 * DFF, DM, 0, 0};
    pg8::TailSplitOrder S; S.init(MTOK, 2 * DFF, F.G, F.bid);
    EpiSwiGLU E{nullptr, (const float*)(ws + WS_ROWSSB), (bf16_t*)(ws + WS_G), F.dry && (P.pad == 12)};
    pg8::Acc acc;
    pg8::gemm_phase<EpiSwiGLU, pg8::TailSplitOrder, true, true, true, true>(F.lds, F.tid, g, S, E, acc);
}
template <int L> __device__ __forceinline__ void p6_ffn_down(const Frame& F) {
    const Params& P = *F.P; unsigned char* ws = P.ws + opaque_zero();
    pg8::Gemm g{(const bf16_t*)(ws + WS_G), (const bf16_t*)(ws + W_2), MTOK, DM, DFF, 0, 0};
    pg8::StaticOrder S; S.init(MTOK, DM, F.G, F.bid);
    constexpr bool FINAL = (L + 1 >= DEPTH);
    EpiResid<FINAL> E{(bf16_t*)(ws + WS_XB), P.out, (float*)(ws + WS_ROWSSA), F.dry, (LAS float*)(F.lds + pg8::STAGE_BYTES), F.tid};
    pg8::Acc acc;
    pg8::gemm_phase<EpiResid<FINAL>, pg8::StaticOrder, true, true, true>(F.lds, F.tid, g, S, E, acc);
}

constexpr int PH_PER_LAYER = 7, NPHASE = PH_PER_LAYER * DEPTH;
#define PH_IN(k) (P.lo <= (k) && (k) < P.hi)
#define PH_FRAME() do { int t_ = threadIdx.x; asm volatile("" : "+v"(t_)); F.tid = t_; F.lane = t_ & 63; F.wave = __builtin_amdgcn_readfirstlane(t_ >> 6); \
                        int b_ = blockIdx.x; asm volatile("" : "+s"(b_)); F.bid = b_; } while (0)
#define PH_SEAM(k) do { if (PH_IN(k) && PH_IN((k) + 1)) { if (P.coop) { xcd_barrier(xbar); if (P.pad == 11) xcd_barrier(xbar); } } __syncthreads(); } while (0)
#define PH_RUN(code, call) do { const int nrep_ = (P.pad == (code)) ? 2 : 1; for (int rep_ = 0; rep_ < nrep_; ++rep_) { PH_FRAME(); F.dry = (rep_ + 1 < nrep_); call; __syncthreads(); } } while (0)
template <int L> __device__ __forceinline__ void run_layer(Frame& F, const Params& P, cg::grid_group& grid, const XcdBarrier& xbar) {
    constexpr int B = PH_PER_LAYER * L;
    if (PH_IN(B + 0)) { PH_RUN(1, (p0_weights(F, L), (L == 0 ? p0_misc(F) : (void)0))); }
    PH_SEAM(B + 0);
    if (PH_IN(B + 1)) { PH_RUN(2, spectra_phase(F, L)); PH_RUN(3, p1_inproj(F, L)); }
    PH_SEAM(B + 1);
    if (PH_IN(B + 2)) { PH_RUN(13, p2_gate_prep(F, L)); PH_RUN(4, hyena_phase(F, L)); PH_RUN(5, attn_phase<0>(F, L)); PH_RUN(6, attn_phase<1>(F, L)); }
    PH_SEAM(B + 2);
    if (PH_IN(B + 3)) { PH_RUN(7, p3_merge(F, L)); }
    PH_SEAM(B + 3);
    if (PH_IN(B + 4)) { PH_RUN(8, p4_wout(F, L)); }
    PH_SEAM(B + 4);
    if (PH_IN(B + 5)) { PH_RUN((P.pad == 12 ? 12 : 9), p5_ffn_up(F, L)); }
    PH_SEAM(B + 5);
    if (PH_IN(B + 6)) { PH_RUN(10, p6_ffn_down<L>(F)); }
    PH_SEAM(B + 6);
}
__global__ void __launch_bounds__(NTHREADS, 2) mega_fwd(Params P) {
    extern __shared__ __attribute__((aligned(16))) unsigned char lds_raw[];
    cg::grid_group grid = cg::this_grid();
    Frame F;
    F.lds = (LAS unsigned char*)lds_raw;
    F.G = gridDim.x; F.P = &P;
    volatile LAS unsigned* bst = (volatile LAS unsigned*)(F.lds + LDS_BARST);
    if (threadIdx.x < 4) bst[threadIdx.x] = 0u;
    __syncthreads();
    XcdBarrier xbar; xbar.bar = (unsigned*)(P.ws + CTL_BAR); xbar.x = 0; xbar.st = bst;
    if (P.coop) xbar = xcd_barrier_post((unsigned*)(P.ws + CTL_BAR), bst);
    if (P.coop == 2) grid.sync();
    run_layer<0>(F, P, grid, xbar);
    run_layer<1>(F, P, grid, xbar);
}

#ifndef PROBE_CODE
#define PROBE_CODE 0
#endif
#ifndef N_LAUNCH_MODE
#define N_LAUNCH_MODE 1
#endif
extern "C" void kernel_launch(void* const* d_in, const int* in_sizes, int n_in, void* d_out, int out_size, void* d_ws, size_t ws_size, hipStream_t stream) {
    static int grid = 0;
    if (grid == 0) {
        int dev = 0, cus = 0, per_cu = 0;
        if (hipGetDevice(&dev) != hipSuccess || hipDeviceGetAttribute(&cus, hipDeviceAttributeMultiprocessorCount, dev) != hipSuccess) { fprintf(stderr, "kernel_launch: device query failed\n"); grid = -1; return; }
        if (hipFuncSetAttribute((const void*)mega_fwd, hipFuncAttributeMaxDynamicSharedMemorySize, LDS_BYTES) != hipSuccess) { fprintf(stderr, "kernel_launch: hipFuncSetAttribute failed\n"); grid = -1; return; }
        if (hipOccupancyMaxActiveBlocksPerMultiprocessor(&per_cu, (const void*)mega_fwd, NTHREADS, LDS_BYTES) != hipSuccess || per_cu < 1) { fprintf(stderr, "kernel_launch: occupancy query failed (%d)\n", per_cu); per_cu = 1; }
        (void)hipGetLastError();
        if (per_cu > 1) per_cu = 1;
        grid = cus * per_cu;
        if (n_in != 31 || ws_size < WS_END) fprintf(stderr, "kernel_launch: unexpected n_in %d / ws_size %zu (need %zu)\n", n_in, ws_size, (size_t)WS_END);
    }
    if (grid < 0) return;
    Params p{};
    for (int i = 0; i < 31; ++i) p.in[i] = (const float*)d_in[i];
    p.out = (float*)d_out; p.ws = (unsigned char*)d_ws;
#if N_LAUNCH_MODE == 1
    p.lo = 0; p.hi = NPHASE; p.coop = 1; p.pad = PROBE_CODE;
    if (hipMemsetAsync((char*)d_ws + CTL_BAR, 0, CTL_BAR_BYTES, stream) != hipSuccess) { fprintf(stderr, "kernel_launch: memset of barrier words failed\n"); return; }
    void* args[] = {&p};
    hipError_t e = hipLaunchCooperativeKernel((const void*)mega_fwd, dim3(grid), dim3(NTHREADS), args, LDS_BYTES, stream);
    if (e != hipSuccess) fprintf(stderr, "cooperative launch failed: %s (grid %d)\n", hipGetErrorString(e), grid);
#else
    for (int ph = 0; ph < NPHASE; ++ph) {
        p.lo = ph; p.hi = ph + 1; p.coop = 0;
        hipLaunchKernelGGL(mega_fwd, dim3(grid), dim3(NTHREADS), LDS_BYTES, stream, p);
    }
#endif
}
```

```cpp
#include <hip/hip_runtime.h>
#include <hip/hip_cooperative_groups.h>
#include <cstdint>
#include <cstdio>
namespace cg = cooperative_groups;

#define LAS __attribute__((address_space(3)))
typedef unsigned short bf16_t;
typedef short bf16x8 __attribute__((ext_vector_type(8)));
typedef short s16x4 __attribute__((ext_vector_type(4)));
typedef float f32x2 __attribute__((ext_vector_type(2)));
typedef float f32x4 __attribute__((ext_vector_type(4)));
typedef float f32x16 __attribute__((ext_vector_type(16)));
typedef unsigned u32x2 __attribute__((ext_vector_type(2)));
typedef unsigned u32x4 __attribute__((ext_vector_type(4)));
typedef __bf16 bf16x2_t __attribute__((ext_vector_type(2)));

constexpr int DM = 1024, NBATCH = 8, SEQ = 2048, MTOK = NBATCH * SEQ, DEPTH = 2;
constexpr int INC = 6912, NMAIN = 3840, DFF = 2816;
constexpr float RMS_EPS = 1e-6f;
constexpr float LOG2E = 1.4426950408889634f;
constexpr float QSCALE = 0.125f * LOG2E;
constexpr int NTHREADS = 512;
constexpr int LDS_BYTES = 147456;

constexpr size_t MiB = 1u << 20;
constexpr size_t WS_CTL = 0;
constexpr size_t CTL_ROWSSA = 0;
constexpr size_t CTL_ROWSSB = 128 * 1024;
constexpr size_t CTL_COS = 256 * 1024;
constexpr size_t CTL_SIN = 512 * 1024;
constexpr size_t CTL_LAM = 768 * 1024;
constexpr size_t CTL_TW = 768 * 1024 + 256;
constexpr size_t CTL_H2 = 1 * MiB;
constexpr size_t CTL_BAR = 2 * MiB;
constexpr size_t CTL_BAR_BYTES = 32768;
constexpr int LDS_BARST = LDS_BYTES - 64;
constexpr size_t WS_W = 4 * MiB;
constexpr size_t W_IN = WS_W;
constexpr size_t W_OA = W_IN + (size_t)INC * DM * 2;
constexpr size_t W_OUT = W_OA + 3 * (size_t)DM * 512 * 2;
constexpr size_t W_13 = W_OUT + (size_t)DM * DM * 2;
constexpr size_t W_2 = W_13 + (size_t)2 * DFF * DM * 2;
constexpr size_t WS_XB = 39 * MiB;
constexpr size_t WS_QA = 71 * MiB;
constexpr size_t WS_OB = 87 * MiB;
constexpr size_t WS_QC = 103 * MiB;
constexpr size_t WS_G = 119 * MiB;
constexpr size_t G_KA = WS_G, G_VA = WS_G + 4 * MiB, G_HY = WS_G + 8 * MiB, G_KC = WS_G + 56 * MiB, G_VC = WS_G + 72 * MiB;
constexpr size_t WS_S = 207 * MiB;
constexpr size_t WS_XB8 = 239 * MiB;
constexpr size_t CTL_FCTA = 3 * MiB + 512 * 1024;
constexpr size_t WS_ROWSSA = 2 * MiB + 512 * 1024;
constexpr size_t WS_ROWSSB = 3 * MiB;
constexpr size_t WS_END = 255 * MiB;
constexpr int CTLW_W13MAX = 4096 + 256;
constexpr int CTLW_GWMAX = 4096;
static_assert(W_2 + (size_t)DM * DFF * 2 <= WS_XB, "weights fit");

struct Params {
    const float* in[31];
    float* out;
    unsigned char* ws;
    int lo, hi, coop, pad;
};
enum { I_X = 0, I_N1G, I_WIN, I_SINK, I_QNA, I_KNA, I_CONVW, I_CONVB, I_FW1, I_FB1, I_FF1, I_FW2, I_FB2, I_FF2, I_FW3, I_HYD, I_QNC, I_KNC, I_LQ1, I_LK1, I_LQ2, I_LK2, I_SUBLN,
       I_WOA, I_WOB, I_WOC, I_WOUT, I_N2G, I_FFW1, I_FFW3, I_FFW2 };

__device__ __forceinline__ unsigned pk2(float lo, float hi) { f32x2 v = {lo, hi}; bf16x2_t b = __builtin_convertvector(v, bf16x2_t); return __builtin_bit_cast(unsigned, b); }
__device__ __forceinline__ float bf2f(unsigned short b) { return __uint_as_float(((unsigned)b) << 16); }
__device__ __forceinline__ float bflo(unsigned w) { return __uint_as_float(w << 16); }
__device__ __forceinline__ float bfhi(unsigned w) { return __uint_as_float(w & 0xffff0000u); }
__device__ __forceinline__ unsigned short f2bf(float f) { return (unsigned short)(pk2(f, 0.f) & 0xffffu); }
__device__ __forceinline__ size_t opaque_zero() { unsigned z = 0; asm volatile("" : "+s"(z)); return (size_t)z; }
__device__ __forceinline__ float wave_sum(float v) {
#pragma unroll
    for (int o = 1; o < 64; o <<= 1) v += __shfl_xor(v, o);
    return v;
}
__device__ __forceinline__ void rows_rstd8(const float* rowss, int row0, float (&rs)[8]) {
    f32x4 q[8];
#pragma unroll
    for (int k = 0; k < 8; ++k) q[k] = *(const f32x4*)(rowss + (size_t)(row0 + (k >> 2) * 128 + (k & 3) * 16) * 4);
#pragma unroll
    for (int k = 0; k < 8; ++k) rs[k] = rsqrtf(((q[k][0] + q[k][1]) + (q[k][2] + q[k][3])) * (1.f / DM) + RMS_EPS);
}
__device__ __forceinline__ void rows_rstd8_lds(LAS const float* p, int fr, float (&rs)[8]) {
    f32x4 q[8];
#pragma unroll
    for (int k = 0; k < 8; ++k) q[k] = *(LAS const f32x4*)(p + (k >> 2) * 256 + ((k & 3) * 16 + fr) * 4);
#pragma unroll
    for (int k = 0; k < 8; ++k) rs[k] = rsqrtf(((q[k][0] + q[k][1]) + (q[k][2] + q[k][3])) * (1.f / DM) + RMS_EPS);
}
__device__ __forceinline__ int crow(int r, int hi) { return (r & 3) + 8 * (r >> 2) + 4 * hi; }

namespace pg8 {
constexpr int BM = 256, BK = 64, HALF = 128, HTB = HALF * BK * 2, STAGE_BYTES = 8 * HTB, NXCD = 8, WGM = 8;
constexpr int RS_OFF = STAGE_BYTES + 4096;
__host__ __device__ __forceinline__ int lds_byte(int r, int c) { const int st = (r >> 4) * 2 + (c >> 5), rr = r & 15, cc = c & 31, ob = rr * 64 + cc * 2; return st * 1024 + (ob ^ (((ob >> 9) & 1) << 5)); }
__host__ __device__ __forceinline__ void stage_rc(int b, int& R, int& C) { const int st = b / 1024, sb = b % 1024, swz = sb ^ (((sb >> 9) & 1) << 5); R = (st >> 1) * 16 + swz / 64; C = (st & 1) * 32 + (swz % 64) / 2; }
__host__ __device__ __forceinline__ int perm32(int rho) { const int n = rho >> 4, i = rho & 15; return 8 * (i >> 2) + 4 * n + (i & 3); }

struct Unit { int pm, pn, sub, half; };
struct Gemm { const bf16_t* A; const bf16_t* Bt; int M, N, K; size_t sA, sB; };

struct StaticOrder {
    int nM, nN, nwg, G, c;
    __host__ __device__ void init(int M, int N, int G_, int c_) { nM = M / BM; nN = N / BM; nwg = nM * nN; G = G_; c = c_; }
    __host__ __device__ void map(int L, Unit& u) const {
        int wgid = L; { const int q = nwg / NXCD, r = nwg % NXCD, xcd = wgid % NXCD, off = wgid / NXCD; wgid = (xcd < r ? xcd * (q + 1) : r * (q + 1) + (xcd - r) * q) + off; }
        const int nig = WGM * nN, gid = wgid / nig, fm = gid * WGM, gsz = (nM - fm) < WGM ? (nM - fm) : WGM;
        u.pm = fm + ((wgid % nig) % gsz); u.pn = (wgid % nig) / gsz; u.sub = 0; u.half = 0;
    }
    __host__ __device__ bool next(int i, Unit& u) const {
        const long L = (long)i * G + c; if (L >= nwg) return false;
        map((int)L, u); return true;
    }
};
struct TailSplitOrder {
    StaticOrder S; int full, rem;
    __device__ __forceinline__ void init(int M, int N, int G_, int c_) { S.init(M, N, G_, c_); full = (S.nwg / G_) * G_; rem = S.nwg - full; }
    __device__ __forceinline__ bool next(int i, Unit& u) const {
        const long L = (long)i * S.G + S.c;
        if (2 * rem != S.G || L < full) return S.next(i, u);
        if (i != full / S.G) return false;
        S.map(full + (S.c >> 1), u); u.half = 1 + (S.c & 1); return true;
    }
};
struct ChainOrder3 {
    StaticOrder S;
    __device__ __forceinline__ bool next(int i, Unit& u) const { const int q = i / 3; if (!S.next(q, u)) return false; u.sub = i - 3 * q; return true; }
};

typedef f32x4 Acc[2][2][4][2];
typedef int i32x4v __attribute__((ext_vector_type(4)));

template <class Epi, class Sched, bool ALIGN_EPI, bool SP2, bool ZERO, bool HALF_OK = false, bool I8 = false>
__device__ __forceinline__ void gemm_phase(LAS unsigned char* lds, const int tid, const Gemm g, const Sched& S, Epi& E, Acc& acc) {
    const int wid = __builtin_amdgcn_readfirstlane(tid >> 6), lane = tid & 63, wr = wid >> 2, wc = wid & 3, fr = lane & 15, fq = lane >> 4;
    constexpr int ES = I8 ? 1 : 2;
    const int K = g.K, nt = K * ES / (BK * 2);
    unsigned voffA[2], voffB[2];
#pragma unroll
    for (int i = 0; i < 2; ++i) { int R, C; stage_rc(tid * 16 + i * 8192, R, C); const int Rb = Epi::PERM ? ((R & ~31) + perm32(R & 31)) : R;
        voffA[i] = (unsigned)(R * K * ES + C * 2); voffB[i] = (unsigned)(Rb * K * ES + C * 2); }
    const size_t kstep = (size_t)(BK * 2);
    const size_t hstep = (size_t)HALF * K * ES;
    const size_t tstep = 2 * hstep;
    const unsigned ldsw = (unsigned)wid * 1024u;
    const int aoff = lds_byte(wr * 64 + fr, fq * 8), boff = lds_byte(wc * 32 + fr, fq * 8);
#define PG8_SA(b, h) (((b) * 2 + (h)) * HTB)
#define PG8_SB(b, h) ((4 + (b) * 2 + (h)) * HTB)
#define PG8_STAGE(bufoff, gbase, voff) do { _Pragma("unroll") for (int _i = 0; _i < 2; ++_i) \
        __builtin_amdgcn_global_load_lds((const unsigned*)((const char*)(gbase) + (voff)[_i]), (LAS unsigned*)(lds + (bufoff) + ldsw + _i * 8192), 16, 0, 0); } while (0)
#define PG8_LDA(dst, b, h) do { _Pragma("unroll") for (int m = 0; m < 4; ++m) _Pragma("unroll") for (int k = 0; k < 2; ++k) dst[m][k] = *(const LAS bf16x8*)(lds + PG8_SA(b, h) + aoff + m * 2048 + k * 1024); } while (0)
#define PG8_LDB(dst, b, h) do { _Pragma("unroll") for (int n = 0; n < 2; ++n) _Pragma("unroll") for (int k = 0; k < 2; ++k) dst[n][k] = *(const LAS bf16x8*)(lds + PG8_SB(b, h) + boff + n * 2048 + k * 1024); } while (0)
#define PG8_MMA(ai, bj, At, Bt) do { __builtin_amdgcn_s_setprio(1); _Pragma("unroll") for (int m = 0; m < 4; ++m) _Pragma("unroll") for (int n = 0; n < 2; ++n) { \
        _Pragma("unroll") for (int k = 0; k < 2; ++k) { \
        if constexpr (I8) acc[ai][bj][m][n] = __builtin_bit_cast(f32x4, __builtin_amdgcn_mfma_i32_16x16x64_i8(__builtin_bit_cast(i32x4v, Bt[n][k]), __builtin_bit_cast(i32x4v, At[m][k]), __builtin_bit_cast(i32x4v, acc[ai][bj][m][n]), 0, 0, 0)); \
        else acc[ai][bj][m][n] = __builtin_amdgcn_mfma_f32_16x16x32_bf16(Bt[n][k], At[m][k], acc[ai][bj][m][n], 0, 0, 0); } } \
        __builtin_amdgcn_s_setprio(0); } while (0)
#define PG8_WAIT_V(n) asm volatile("s_waitcnt vmcnt(" #n ")" ::: "memory")
#define PG8_WAIT_L(n) asm volatile("s_waitcnt lgkmcnt(" #n ")" ::: "memory")
#define PG8_BAR __builtin_amdgcn_s_barrier()
#define PG8_SCHED __builtin_amdgcn_sched_barrier(0)
#define PG8_ZERO_ACC() do { _Pragma("unroll") for (int a = 0; a < 2; ++a) _Pragma("unroll") for (int b = 0; b < 2; ++b) _Pragma("unroll") for (int m = 0; m < 4; ++m) _Pragma("unroll") for (int n = 0; n < 2; ++n) acc[a][b][m][n] = (f32x4){0.f, 0.f, 0.f, 0.f}; } while (0)
#define PG8_RS_LOAD(un, par) do { if constexpr (Epi::RS_LDS) { if (wc == 0) { _Pragma("unroll") for (int _a = 0; _a < 2; ++_a) \
        __builtin_amdgcn_global_load_lds((const unsigned*)(E.rowss + (size_t)((un).pm * 256 + _a * 128 + wr * 64 + lane) * 4), (LAS unsigned*)(lds + RS_OFF + (par) * 4096 + wr * 2048 + _a * 1024), 16, 0, 0); } } } while (0)
    Unit cur, nxt; int ui = 0;
    if (!S.next(0, cur)) return;
    if (ZERO) PG8_ZERO_ACC();
    PG8_RS_LOAD(cur, 0);
    bf16x8 At[4][2], B0[2][2], B1[2][2];
    const char* cA = (const char*)g.A + (size_t)cur.sub * g.sA + (size_t)cur.pm * tstep; const char* cB = (const char*)g.Bt + (size_t)cur.sub * g.sB + (size_t)cur.pn * tstep;
    if constexpr (SP2) {
        PG8_STAGE(PG8_SB(0, 0), cB, voffB); PG8_STAGE(PG8_SB(0, 1), cB + hstep, voffB); PG8_STAGE(PG8_SA(0, 0), cA, voffA); PG8_STAGE(PG8_SA(0, 1), cA + hstep, voffA);
        if (wr == 1) PG8_BAR;
        PG8_WAIT_V(2); PG8_BAR;
        PG8_STAGE(PG8_SB(1, 0), cB + kstep, voffB); PG8_STAGE(PG8_SA(1, 0), cA + kstep, voffA); PG8_STAGE(PG8_SB(1, 1), cB + hstep + kstep, voffB);
        PG8_WAIT_V(6); PG8_BAR;
    } else {
        PG8_STAGE(PG8_SB(0, 0), cB, voffB); PG8_STAGE(PG8_SA(0, 0), cA, voffA); PG8_STAGE(PG8_SB(0, 1), cB + hstep, voffB); PG8_STAGE(PG8_SA(0, 1), cA + hstep, voffA);
        if (wr == 1) PG8_BAR;
        PG8_WAIT_V(4); PG8_BAR;
        PG8_STAGE(PG8_SB(1, 0), cB + kstep, voffB); PG8_STAGE(PG8_SA(1, 0), cA + kstep, voffA); PG8_STAGE(PG8_SB(1, 1), cB + hstep + kstep, voffB);
        PG8_WAIT_V(6); PG8_BAR;
    }
    for (;;) {
        const bool has_next = S.next(ui + 1, nxt);
        const char* nA = has_next ? (const char*)g.A + (size_t)nxt.sub * g.sA + (size_t)nxt.pm * tstep : cA; const char* nB = has_next ? (const char*)g.Bt + (size_t)nxt.sub * g.sB + (size_t)nxt.pn * tstep : cB;
        const bool do0 = !HALF_OK || cur.half != 2, do1 = !HALF_OK || cur.half != 1;
#pragma unroll 1
        for (int t = 0; t < nt; t += 2) {
            const bool last = (t == nt - 2);
            const char* a1 = cA + (size_t)(t + 1) * kstep;
            const char* a2 = last ? nA : cA + (size_t)(t + 2) * kstep; const char* b2 = last ? nB : cB + (size_t)(t + 2) * kstep;
            const char* a3 = a2 + kstep; const char* b3 = b2 + kstep;
            if constexpr (SP2) {
            PG8_LDB(B0, 0, 0); PG8_LDB(B1, 0, 1); PG8_SCHED; if (do0) PG8_LDA(At, 0, 0); PG8_STAGE(PG8_SA(1, 1), a1 + hstep, voffA);
            PG8_WAIT_V(8); PG8_WAIT_L(0); PG8_BAR; if (do0) { PG8_MMA(0, 0, At, B0); PG8_MMA(0, 1, At, B1); } PG8_BAR; PG8_SCHED;
            if (do1) PG8_LDA(At, 0, 1); PG8_STAGE(PG8_SB(0, 0), b2, voffB); PG8_STAGE(PG8_SB(0, 1), b2 + hstep, voffB); PG8_STAGE(PG8_SA(0, 0), a2, voffA);
            PG8_WAIT_V(8); PG8_WAIT_L(0); PG8_BAR; if (do1) { PG8_MMA(1, 0, At, B0); PG8_MMA(1, 1, At, B1); } PG8_BAR; PG8_SCHED;
            PG8_LDB(B0, 1, 0); PG8_LDB(B1, 1, 1); PG8_SCHED; if (do0) PG8_LDA(At, 1, 0); PG8_STAGE(PG8_SA(0, 1), a2 + hstep, voffA);
            PG8_WAIT_V(8); PG8_WAIT_L(0); PG8_BAR; if (do0) { PG8_MMA(0, 0, At, B0); PG8_MMA(0, 1, At, B1); } PG8_BAR; PG8_SCHED;
            if (do1) PG8_LDA(At, 1, 1); PG8_STAGE(PG8_SB(1, 0), b3, voffB); PG8_STAGE(PG8_SB(1, 1), b3 + hstep, voffB); PG8_STAGE(PG8_SA(1, 0), a3, voffA);
            PG8_WAIT_V(8); PG8_WAIT_L(0); PG8_BAR; if (do1) { PG8_MMA(1, 0, At, B0); PG8_MMA(1, 1, At, B1); } PG8_BAR; PG8_SCHED;
            } else {
            PG8_LDB(B0, 0, 0); PG8_SCHED; PG8_LDA(At, 0, 0); PG8_STAGE(PG8_SA(1, 1), a1 + hstep, voffA);
            PG8_WAIT_L(8); PG8_BAR; PG8_WAIT_L(0); PG8_MMA(0, 0, At, B0); PG8_BAR; PG8_SCHED;
            PG8_LDB(B1, 0, 1); PG8_STAGE(PG8_SB(0, 0), b2, voffB);
            PG8_BAR; PG8_WAIT_L(0); PG8_MMA(0, 1, At, B1); PG8_BAR;
            PG8_LDA(At, 0, 1); PG8_STAGE(PG8_SA(0, 0), a2, voffA);
            PG8_BAR; PG8_WAIT_L(0); PG8_MMA(1, 0, At, B0); PG8_BAR; PG8_SCHED;
            PG8_STAGE(PG8_SB(0, 1), b2 + hstep, voffB);
            PG8_WAIT_V(6); PG8_BAR; PG8_MMA(1, 1, At, B1); PG8_BAR;
            PG8_LDB(B0, 1, 0); PG8_SCHED; PG8_LDA(At, 1, 0); PG8_STAGE(PG8_SA(0, 1), a2 + hstep, voffA);
            PG8_WAIT_L(8); PG8_BAR; PG8_WAIT_L(0); PG8_MMA(0, 0, At, B0); PG8_BAR; PG8_SCHED;
            PG8_LDB(B1, 1, 1); PG8_STAGE(PG8_SB(1, 0), b3, voffB);
            PG8_BAR; PG8_WAIT_L(0); PG8_MMA(0, 1, At, B1); PG8_BAR;
            PG8_LDA(At, 1, 1); PG8_STAGE(PG8_SA(1, 0), a3, voffA);
            PG8_BAR; PG8_WAIT_L(0); PG8_MMA(1, 0, At, B0); PG8_BAR; PG8_SCHED;
            PG8_STAGE(PG8_SB(1, 1), b3 + hstep, voffB);
            PG8_WAIT_V(6); PG8_BAR; PG8_MMA(1, 1, At, B1); PG8_BAR;
            }
        }
        if constexpr (ALIGN_EPI) { if (wr == 0) PG8_BAR; }
        if constexpr (Epi::RS_LDS) E.rsl = (LAS const float*)(lds + RS_OFF + (ui & 1) * 4096 + wr * 2048);
        const bool keep = E(acc, cur, wr, wc, fr, fq);
        if (!has_next) break;
        if (!keep) PG8_ZERO_ACC();
        cur = nxt; cA = nA; cB = nB; ++ui;
        PG8_RS_LOAD(cur, ui & 1);
        if constexpr (ALIGN_EPI) { if (wr == 1) PG8_BAR; }
    }
    PG8_WAIT_V(0);
    if constexpr (!ALIGN_EPI) { if (wr == 0) PG8_BAR; }
    PG8_BAR;
#undef PG8_SA
#undef PG8_SB
#undef PG8_STAGE
#undef PG8_LDA
#undef PG8_LDB
#undef PG8_MMA
#undef PG8_WAIT_V
#undef PG8_WAIT_L
#undef PG8_BAR
#undef PG8_SCHED
#undef PG8_ZERO_ACC
#undef PG8_RS_LOAD
}
}

struct EpiInProj {
    static constexpr bool PERM = true, RS_LDS = true;
    LAS const float* rsl;
    const float* rowss; const unsigned* csT; const unsigned* gp;
    bf16_t *QA, *KA, *VA, *QC, *KC, *VC, *HY;
    __device__ __forceinline__ bool operator()(pg8::Acc& acc, const pg8::Unit& u, int wr, int wc, int fr, int fq) const {
        const int g = 4 * u.pn + wc;
        int kind, ld, hd, gty = 0; bf16_t* dst;
        if (g < 8)       { kind = 2; dst = QA; ld = 512; hd = g; gty = 0; }
        else if (g < 10) { kind = 1; dst = KA; ld = 128; hd = g - 8; gty = 1; }
        else if (g < 12) { kind = 0; dst = VA; ld = 128; hd = g - 10; }
        else if (g < 20) { kind = 2; dst = QC; ld = 512; hd = g - 12; gty = 2; }
        else if (g < 28) { kind = 1; dst = KC; ld = 512; hd = g - 20; gty = 3; }
        else if (g < 36) { kind = 0; dst = VC; ld = 512; hd = g - 28; }
        else             { kind = 0; dst = HY; ld = 1536; hd = g - 36; }
        const int col0 = 64 * hd + 8 * fq;
        const float qs = (kind == 2) ? QSCALE : 1.f;
        float rs8[8]; rows_rstd8_lds(rsl, fr, rs8);
        const int rowb = u.pm * 256 + wr * 64 + fr;
        if (kind == 0) {
#pragma unroll
            for (int ai = 0; ai < 2; ++ai)
#pragma unroll
                for (int m = 0; m < 4; ++m) {
                    const int row = rowb + ai * 128 + m * 16;
                    const float rstd = rs8[ai * 4 + m];
                    const f32x4 a0 = acc[ai][0][m][0] * rstd, a1 = acc[ai][0][m][1] * rstd, b0 = acc[ai][1][m][0] * rstd, b1 = acc[ai][1][m][1] * rstd;
                    u32x4 wa, wb;
                    wa.x = pk2(a0[0], a0[1]); wa.y = pk2(a0[2], a0[3]); wa.z = pk2(a1[0], a1[1]); wa.w = pk2(a1[2], a1[3]);
                    wb.x = pk2(b0[0], b0[1]); wb.y = pk2(b0[2], b0[3]); wb.z = pk2(b1[0], b1[1]); wb.w = pk2(b1[2], b1[3]);
                    if (g >= 36) {
                        bf16_t* rp = dst + ((size_t)(8 * hd + fq) * MTOK + row) * 8;
                        *(u32x4*)rp = wa; *(u32x4*)(rp + (size_t)4 * MTOK * 8) = wb;
                    } else {
                        bf16_t* rp = dst + (size_t)row * ld + col0;
                        *(u32x4*)rp = wa; *(u32x4*)(rp + 32) = wb;
                    }
                }
        } else {
            const u32x4 gq0 = *(const u32x4*)(gp + gty * 32 + 8 * fq), gq1 = *(const u32x4*)(gp + gty * 32 + 8 * fq + 4);
            u32x4 cs[2][2];
            { const unsigned* cp = csT + (rowb & (SEQ - 1)) * 32 + 8 * fq; cs[0][0] = *(const u32x4*)cp; cs[0][1] = *(const u32x4*)(cp + 4); }
#pragma unroll
            for (int it = 0; it < 8; ++it) {
                const int ai = it >> 2, m = it & 3;
                const int row = rowb + ai * 128 + m * 16;
                if (it + 1 < 8) { const int nrow = rowb + ((it + 1) >> 2) * 128 + ((it + 1) & 3) * 16; const unsigned* cp = csT + (nrow & (SEQ - 1)) * 32 + 8 * fq;
                    cs[(it + 1) & 1][0] = *(const u32x4*)cp; cs[(it + 1) & 1][1] = *(const u32x4*)(cp + 4); }
                const float rstd = rs8[it];
                float ss = 0.f;
#pragma unroll
                for (int n = 0; n < 2; ++n)
#pragma unroll
                    for (int i = 0; i < 4; ++i) { const float x = acc[ai][0][m][n][i], y = acc[ai][1][m][n][i]; ss += x * x + y * y; }
                ss += __shfl_xor(ss, 16); ss += __shfl_xor(ss, 32);
                const float f = rstd * rsqrtf(ss * rstd * rstd * (1.f / 64.f) + RMS_EPS) * qs;
                u32x4 wa, wb;
#pragma unroll
                for (int n = 0; n < 2; ++n) {
                    const u32x4 gq = n ? gq1 : gq0, cq = cs[it & 1][n];
                    float ra[4], rb[4];
#pragma unroll
                    for (int i = 0; i < 4; ++i) {
                        const float ga = (float)__builtin_bit_cast(_Float16, (unsigned short)(gq[i] & 0xffffu)), gb = (float)__builtin_bit_cast(_Float16, (unsigned short)(gq[i] >> 16));
                        const float c = (float)__builtin_bit_cast(_Float16, (unsigned short)(cq[i] & 0xffffu)), sn = (float)__builtin_bit_cast(_Float16, (unsigned short)(cq[i] >> 16));
                        const float x = acc[ai][0][m][n][i] * (f * ga), y = acc[ai][1][m][n][i] * (f * gb);
                        ra[i] = x * c - y * sn; rb[i] = y * c + x * sn;
                    }
                    if (n == 0) { wa.x = pk2(ra[0], ra[1]); wa.y = pk2(ra[2], ra[3]); wb.x = pk2(rb[0], rb[1]); wb.y = pk2(rb[2], rb[3]); }
                    else        { wa.z = pk2(ra[0], ra[1]); wa.w = pk2(ra[2], ra[3]); wb.z = pk2(rb[0], rb[1]); wb.w = pk2(rb[2], rb[3]); }
                }
                bf16_t* rp = dst + (size_t)row * ld + col0;
                *(u32x4*)rp = wa; *(u32x4*)(rp + 32) = wb;
                asm volatile("" ::: "memory");
            }
        }
        return false;
    }
};

#ifndef MERGE_PD
#define MERGE_PD 2
#endif
__device__ __forceinline__ unsigned gate_q(float a) {
    const float t = __builtin_amdgcn_fmed3f(__builtin_fmaf(__builtin_amdgcn_exp2f(a), 1.f / 255.f, 1.f / 255.f), 0.f, 1.f);
    return __builtin_bit_cast(unsigned, __builtin_amdgcn_rcpf(t) + 8388608.f);
}
__device__ __forceinline__ unsigned pack_b0(unsigned u0, unsigned u1, unsigned u2, unsigned u3) {
    return __builtin_amdgcn_perm(__builtin_amdgcn_perm(u3, u2, 0x0c0c0400u), __builtin_amdgcn_perm(u1, u0, 0x0c0c0400u), 0x05040100u);
}
struct EpiGate {
    static constexpr bool PERM = true, RS_LDS = true;
    LAS const float* rsl;
    int tid; const float* rowss; float wk; u32x4* scr0;
    __device__ __forceinline__ bool operator()(pg8::Acc& acc, const pg8::Unit& u, int wr, int wc, int fr, int fq) const {
        u32x4* scr = scr0 + ((size_t)(u.pm * 4 + u.pn) * 3 + u.sub) * 8 * 512 + tid;
        float rs8[8];
#pragma unroll
        for (int k = 0; k < 8; ++k) rs8[k] = rsl[(k >> 2) * 256 + ((k & 3) * 16 + fr) * 4];
#pragma unroll
        for (int ai = 0; ai < 2; ++ai)
#pragma unroll
            for (int m = 0; m < 4; ++m) {
                const float rs = rs8[ai * 4 + m] * (-LOG2E * wk);
                unsigned pw[4];
#pragma unroll
                for (int bj = 0; bj < 2; ++bj) {
                    const pg8::i32x4v i0 = __builtin_bit_cast(pg8::i32x4v, acc[ai][bj][m][0]), i1 = __builtin_bit_cast(pg8::i32x4v, acc[ai][bj][m][1]);
                    const f32x4 v0 = {(float)i0[0], (float)i0[1], (float)i0[2], (float)i0[3]}, v1 = {(float)i1[0], (float)i1[1], (float)i1[2], (float)i1[3]};
                    pw[bj * 2] = pack_b0(gate_q(v0[0] * rs), gate_q(v0[1] * rs), gate_q(v0[2] * rs), gate_q(v0[3] * rs));
                    pw[bj * 2 + 1] = pack_b0(gate_q(v1[0] * rs), gate_q(v1[1] * rs), gate_q(v1[2] * rs), gate_q(v1[3] * rs));
                }
                u32x4 w; w.x = pw[0]; w.y = pw[1]; w.z = pw[2]; w.w = pw[3];
                scr[(size_t)(ai * 4 + m) * 512] = w;
            }
        return false;
    }
};
__device__ __forceinline__ float ub(unsigned w, int k) { return (float)((w >> (8 * k)) & 0xffu); }
struct EpiMerge {
    static constexpr bool PERM = true, RS_LDS = false;
    static constexpr int PD = MERGE_PD;
    int tid; const u32x4* scr0; bf16_t* merged;
    __device__ __forceinline__ bool operator()(pg8::Acc& acc, const pg8::Unit& u, int wr, int wc, int fr, int fq) const {
        const int sub = u.sub;
        const u32x4* sa_p = scr0 + ((size_t)(u.pm * 4 + u.pn) * 3 + sub) * 8 * 512 + tid;
        u32x4 wa[8], wb[8];
#pragma unroll
        for (int it = 0; it < PD; ++it) { wa[it] = sa_p[(size_t)it * 512]; if (sub < 2) wb[it] = sa_p[(size_t)(8 + it) * 512]; }
#pragma unroll
        for (int it = 0; it < 8; ++it) {
            const int ai = it >> 2, m = it & 3;
            const int row = u.pm * 256 + ai * 128 + wr * 64 + m * 16 + fr;
            if (it + PD < 8) { wa[it + PD] = sa_p[(size_t)(it + PD) * 512]; if (sub < 2) wb[it + PD] = sa_p[(size_t)(8 + it + PD) * 512]; }
#pragma unroll
            for (int bj = 0; bj < 2; ++bj) {
                f32x4& v0 = acc[ai][bj][m][0]; f32x4& v1 = acc[ai][bj][m][1];
                const unsigned a0 = bj ? wa[it].z : wa[it].x, a1 = bj ? wa[it].w : wa[it].y;
                if (sub < 2) {
                    const unsigned b0 = bj ? wb[it].z : wb[it].x, b1 = bj ? wb[it].w : wb[it].y;
#pragma unroll
                    for (int i = 0; i < 4; ++i) { v0[i] *= ub(a0, i) * __builtin_amdgcn_rcpf(ub(b0, i)); v1[i] *= ub(a1, i) * __builtin_amdgcn_rcpf(ub(b1, i)); }
                } else {
                    constexpr float C = 1.f / 255.f;
                    u32x4 w; w.x = pk2(v0[0] * (ub(a0, 0) * C), v0[1] * (ub(a0, 1) * C)); w.y = pk2(v0[2] * (ub(a0, 2) * C), v0[3] * (ub(a0, 3) * C));
                    w.z = pk2(v1[0] * (ub(a1, 0) * C), v1[1] * (ub(a1, 1) * C)); w.w = pk2(v1[2] * (ub(a1, 2) * C), v1[3] * (ub(a1, 3) * C));
                    *(u32x4*)(merged + (size_t)row * DM + u.pn * 256 + bj * 128 + wc * 32 + 8 * fq) = w;
                }
            }
            asm volatile("" ::: "memory");
        }
        return sub < 2;
    }
};

template <bool FINAL> struct EpiResid {
    static constexpr bool PERM = true, RS_LDS = false;
    bf16_t* xb; float* xout; float* rowss; bool dry; LAS float* red; int tid;
    __device__ __forceinline__ bool operator()(pg8::Acc& acc, const pg8::Unit& u, int wr, int wc, int fr, int fq) const {
        if (dry) return false;
#pragma unroll
        for (int ai = 0; ai < 2; ++ai)
#pragma unroll
            for (int m = 0; m < 4; ++m) {
                const int row = u.pm * 256 + ai * 128 + wr * 64 + m * 16 + fr;
                float ss = 0.f;
#pragma unroll
                for (int bj = 0; bj < 2; ++bj) {
                    const size_t off = (size_t)row * DM + u.pn * 256 + bj * 128 + wc * 32 + 8 * fq;
                    const u32x4 xo = *(const u32x4*)(xb + off);
                    const f32x4 a0 = acc[ai][bj][m][0], a1 = acc[ai][bj][m][1];
                    float xn[8] = {bflo(xo.x) + a0[0], bfhi(xo.x) + a0[1], bflo(xo.y) + a0[2], bfhi(xo.y) + a0[3], bflo(xo.z) + a1[0], bfhi(xo.z) + a1[1], bflo(xo.w) + a1[2], bfhi(xo.w) + a1[3]};
                    if (FINAL) {
                        *(f32x4*)(xout + off) = (f32x4){xn[0], xn[1], xn[2], xn[3]}; *(f32x4*)(xout + off + 4) = (f32x4){xn[4], xn[5], xn[6], xn[7]};
                    } else {
                        u32x4 w; w.x = pk2(xn[0], xn[1]); w.y = pk2(xn[2], xn[3]); w.z = pk2(xn[4], xn[5]); w.w = pk2(xn[6], xn[7]);
                        *(u32x4*)(xb + off) = w;
                        const float r[8] = {bflo(w.x), bfhi(w.x), bflo(w.y), bfhi(w.y), bflo(w.z), bfhi(w.z), bflo(w.w), bfhi(w.w)};
#pragma unroll
                        for (int i = 0; i < 8; ++i) ss += r[i] * r[i];
                    }
                }
                if (!FINAL) { ss += __shfl_xor(ss, 16); ss += __shfl_xor(ss, 32); if (fq == 0) red[(ai * 128 + wr * 64 + m * 16 + fr) * 4 + wc] = ss; }
            }
        if (!FINAL) {
            asm volatile("s_waitcnt lgkmcnt(0)" ::: "memory"); __builtin_amdgcn_s_barrier(); asm volatile("" ::: "memory");
            if (tid < 256) { const f32x4 p = *(const LAS f32x4*)(red + tid * 4); rowss[(size_t)(u.pm * 256 + tid) * 4 + u.pn] = (p[0] + p[1]) + (p[2] + p[3]); }
            asm volatile("s_waitcnt lgkmcnt(0)" ::: "memory"); __builtin_amdgcn_s_barrier(); asm volatile("" ::: "memory");
        }
        return false;
    }
};

struct EpiSwiGLU {
    static constexpr bool PERM = true, RS_LDS = true;
    LAS const float* rsl;
    const float* rowss; float wk; bf16_t* act; bool dry;
    __device__ __forceinline__ bool operator()(pg8::Acc& acc, const pg8::Unit& u, int wr, int wc, int fr, int fq) const {
        if (dry) return false;
        float rs8[8];
#pragma unroll
        for (int k = 0; k < 8; ++k) rs8[k] = rsl[(k >> 2) * 256 + ((k & 3) * 16 + fr) * 4] * wk;
#pragma unroll
        for (int ai = 0; ai < 2; ++ai) {
            if (u.half == 2 - ai) continue;
#pragma unroll
            for (int m = 0; m < 4; ++m) {
                const int row = u.pm * 256 + ai * 128 + wr * 64 + m * 16 + fr;
                const float rstd = rs8[ai * 4 + m];
                float o[8];
#pragma unroll
                for (int n = 0; n < 2; ++n) {
                    const pg8::i32x4v ia = __builtin_bit_cast(pg8::i32x4v, acc[ai][0][m][n]), ib = __builtin_bit_cast(pg8::i32x4v, acc[ai][1][m][n]);
#pragma unroll
                    for (int i = 0; i < 4; ++i) {
                        const float a = (float)ia[i] * rstd, b = (float)ib[i] * rstd;
                        o[4 * n + i] = a * __builtin_amdgcn_rcpf(1.f + __builtin_amdgcn_exp2f(-a * LOG2E)) * b;
                    }
                }
                u32x4 w; w.x = pk2(o[0], o[1]); w.y = pk2(o[2], o[3]); w.z = pk2(o[4], o[5]); w.w = pk2(o[6], o[7]);
                *(u32x4*)(act + (size_t)row * DFF + u.pn * 128 + wc * 32 + 8 * fq) = w;
            }
        }
        return false;
    }
};

#define XB_TMO      128
#define XB_XCNT(j)  (256  + 64 * (j))
#define XB_XSUB(j)  (1280 + 64 * (j))
#define XB_XGEN(j)  (2304 + 64 * (j))
#define XB_TOP      3328
#define XB_TOPGEN   3392
#define XCD_BAR_WORDS 3456
#define XB_SPIN_CAP (1u << 18)
__device__ __forceinline__ unsigned xb_ld(unsigned* p)              { return __hip_atomic_load(p, __ATOMIC_RELAXED, __HIP_MEMORY_SCOPE_AGENT); }
__device__ __forceinline__ unsigned xb_add(unsigned* p, unsigned v) { return __hip_atomic_fetch_add(p, v, __ATOMIC_RELAXED, __HIP_MEMORY_SCOPE_AGENT); }
__device__ __forceinline__ unsigned xb_xcc_id() { return (unsigned)__builtin_amdgcn_s_getreg((3 << 11) | 20) & 0xFu; }
#define XB_SPIN(cond, bar) do { unsigned _sp = 0; while (cond) { __builtin_amdgcn_s_sleep(1); \
    if ((++_sp & 255u) == 0u) { if (xb_ld(&(bar)[XB_TMO])) break; if (_sp > XB_SPIN_CAP) { atomicAdd(&(bar)[XB_TMO], 1u); break; } } } } while (0)
struct XcdBarrier { unsigned* bar; unsigned x; volatile LAS unsigned* st; };
__device__ __forceinline__ XcdBarrier xcd_barrier_post(unsigned* bar, volatile LAS unsigned* st) {
    XcdBarrier b; b.bar = bar; b.x = xb_xcc_id(); b.st = st;
    if (threadIdx.x == 0) (void)xb_add(&bar[XB_XCNT(b.x)], 1u);
    return b;
}
__device__ __forceinline__ void xcd_barrier_complete(unsigned* bar, unsigned x, unsigned& nloc, unsigned& nx) {
    const unsigned G = gridDim.x * gridDim.y * gridDim.z;
    unsigned sum, cnt, mine, sp = 0u;
    for (;;) {
        sum = 0u; cnt = 0u; mine = 0u;
#pragma unroll
        for (unsigned j = 0; j < 16; ++j) { const unsigned c = xb_ld(&bar[XB_XCNT(j)]); sum += c; cnt += (c > 0u) ? 1u : 0u; mine = (j == x) ? c : mine; }
        if (sum == G) break;
        __builtin_amdgcn_s_sleep(1);
        if ((++sp & 255u) == 0u) { if (xb_ld(&bar[XB_TMO])) break; if (sp > XB_SPIN_CAP) { atomicAdd(&bar[XB_TMO], 1u); break; } }
    }
    nloc = mine > 0u ? mine : 1u; nx = cnt > 0u ? cnt : 1u;
}
__device__ __forceinline__ void xcd_barrier(const XcdBarrier& b) {
    asm volatile("s_waitcnt vmcnt(0)" ::: "memory");
    __syncthreads();
    if (threadIdx.x == 0) {
        unsigned* bar = b.bar;
        __builtin_amdgcn_s_waitcnt(0);
        unsigned nloc = b.st[0], nx = b.st[1];
        if (nloc == 0u) { xcd_barrier_complete(bar, b.x, nloc, nx); b.st[0] = nloc; b.st[1] = nx; }
        const unsigned old = xb_add(&bar[XB_XSUB(b.x)], 1u);
        const unsigned gen = old / nloc;
        if (old + 1u == (gen + 1u) * nloc) {
            __builtin_amdgcn_fence(__ATOMIC_RELEASE, "agent");
            asm volatile("s_waitcnt vmcnt(0)" ::: "memory");
            const unsigned og = xb_add(&bar[XB_TOP], 1u);
            const unsigned tg = og / nx;
            if (og + 1u == (tg + 1u) * nx) xb_add(&bar[XB_TOPGEN], 1u);
            else XB_SPIN(xb_ld(&bar[XB_TOPGEN]) == tg, bar);
            __builtin_amdgcn_fence(__ATOMIC_ACQUIRE, "agent");
            xb_add(&bar[XB_XGEN(b.x)], 1u);
            asm volatile("s_waitcnt vmcnt(0)" ::: "memory");
        } else {
            XB_SPIN(xb_ld(&bar[XB_XGEN(b.x)]) == gen, bar);
            __builtin_amdgcn_fence(__ATOMIC_ACQUIRE, "agent");
            asm volatile("s_waitcnt vmcnt(0)" ::: "memory");
        }
    }
    __syncthreads();
}

struct Frame {
    LAS unsigned char* lds;
    int tid, lane, wave, G, bid;
    bool dry;
    const Params* P;
};

template <bool WANTMAX = false>
__device__ __forceinline__ float transpose_item(const float* W, int N, int k0, int n0, bf16_t* WT, int K, int drow_lo, int drow_hi, const float* gain, LAS float* scr, int lane) {
    float mx = 0.f;
#pragma unroll
    for (int h = 0; h < 2; ++h) {
        f32x4 v[8];
#pragma unroll
        for (int i = 0; i < 8; ++i) { const int kk = 4 * (8 * h + i) + (lane >> 4); v[i] = __builtin_nontemporal_load((const f32x4*)(W + (size_t)(k0 + kk) * N + n0 + 4 * (lane & 15))); }
#pragma unroll
        for (int i = 0; i < 8; ++i) { const int kk = 4 * (8 * h + i) + (lane >> 4); f32x4 w = v[i]; if (gain) w = w * gain[k0 + kk];
            if (WANTMAX) mx = fmaxf(mx, fmaxf(fmaxf(fabsf(w[0]), fabsf(w[1])), fmaxf(fabsf(w[2]), fabsf(w[3]))));
            LAS float* d = scr + kk * 65 + 4 * (lane & 15); d[0] = w[0]; d[1] = w[1]; d[2] = w[2]; d[3] = w[3]; }
    }
    asm volatile("s_waitcnt lgkmcnt(0)" ::: "memory");
    const int c = lane & 7;
#pragma unroll
    for (int j = 0; j < 8; ++j) { const int n = (lane >> 3) + 8 * j; const LAS float* s = scr + (8 * c) * 65 + n;
        u32x4 o; o.x = pk2(s[0 * 65], s[1 * 65]); o.y = pk2(s[2 * 65], s[3 * 65]); o.z = pk2(s[4 * 65], s[5 * 65]); o.w = pk2(s[6 * 65], s[7 * 65]);
        const int drow = (n < 32) ? drow_lo + n : drow_hi + n - 32;
        *(u32x4*)(WT + (size_t)drow * K + k0 + 8 * c) = o; }
    asm volatile("s_waitcnt lgkmcnt(0)" ::: "memory");
    return mx;
}
__device__ __forceinline__ unsigned q8(float t) { return __builtin_bit_cast(unsigned, __builtin_amdgcn_fmed3f(t, -127.f, 127.f) + 12582912.f); }
__device__ __forceinline__ float absmax_item(const float* W, int N, int k0, int n0, const float* gain, int lane) {
    float mx = 0.f;
#pragma unroll
    for (int h = 0; h < 2; ++h) {
        f32x4 v[8];
#pragma unroll
        for (int i = 0; i < 8; ++i) { const int kk = 4 * (8 * h + i) + (lane >> 4); v[i] = *(const f32x4*)(W + (size_t)(k0 + kk) * N + n0 + 4 * (lane & 15)); }
#pragma unroll
        for (int i = 0; i < 8; ++i) { const int kk = 4 * (8 * h + i) + (lane >> 4); const float g = fabsf(gain[k0 + kk]);
            mx = fmaxf(mx, g * fmaxf(fmaxf(fabsf(v[i][0]), fabsf(v[i][1])), fmaxf(fabsf(v[i][2]), fabsf(v[i][3])))); }
    }
#pragma unroll
    for (int o = 32; o > 0; o >>= 1) mx = fmaxf(mx, __shfl_xor(mx, o));
    return mx;
}
__device__ __forceinline__ void transpose_item_i8(const float* W, int N, int k0, int n0, unsigned char* WT8, int K, int drow0, const float* gain, float scale, LAS float* scr, int lane) {
#pragma unroll
    for (int h = 0; h < 2; ++h) {
        f32x4 v[8];
#pragma unroll
        for (int i = 0; i < 8; ++i) { const int kk = 4 * (8 * h + i) + (lane >> 4); v[i] = __builtin_nontemporal_load((const f32x4*)(W + (size_t)(k0 + kk) * N + n0 + 4 * (lane & 15))); }
#pragma unroll
        for (int i = 0; i < 8; ++i) { const int kk = 4 * (8 * h + i) + (lane >> 4); const f32x4 w = v[i] * (gain[k0 + kk] * scale);
            LAS float* d = scr + kk * 65 + 4 * (lane & 15); d[0] = w[0]; d[1] = w[1]; d[2] = w[2]; d[3] = w[3]; }
    }
    asm volatile("s_waitcnt lgkmcnt(0)" ::: "memory");
    const int c = lane & 7;
#pragma unroll
    for (int j = 0; j < 8; ++j) { const int n = (lane >> 3) + 8 * j; const LAS float* s = scr + (8 * c) * 65 + n;
        const unsigned lo = pack_b0(q8(s[0 * 65]), q8(s[1 * 65]), q8(s[2 * 65]), q8(s[3 * 65])), hi = pack_b0(q8(s[4 * 65]), q8(s[5 * 65]), q8(s[6 * 65]), q8(s[7 * 65]));
        *(u32x2*)(WT8 + (size_t)(drow0 + n) * K + k0 + 8 * c) = (u32x2){lo, hi}; }
    asm volatile("s_waitcnt lgkmcnt(0)" ::: "memory");
}
__device__ __forceinline__ int inproj_base(int g) {
    if (g < 8) return 64 * g;
    if (g < 10) return 512 + 64 * (g - 8);
    if (g < 12) return 640 + 64 * (g - 10);
    if (g < 20) return 2304 + 64 * (g - 12);
    if (g < 28) return 2816 + 64 * (g - 20);
    if (g < 36) return 3328 + 64 * (g - 28);
    return 768 + 64 * (g - 36);
}
__device__ __forceinline__ void p0_weights(const Frame& F, int l) {
    const Params& P = *F.P;
    LAS float* scr = (LAS float*)(F.lds + F.wave * 16640);
    const int gw = F.bid * 8 + F.wave, NGW = F.G * 8;
    unsigned char* ws = P.ws + opaque_zero();
    const float* w_in = P.in[I_WIN] + (size_t)l * DM * INC;
    const float* n1g = P.in[I_N1G] + l * DM; const float* n2g = P.in[I_N2G] + l * DM;
    constexpr int N1 = 60 * 16, N2 = 48 * 16, N3 = 3 * 128, N4 = 256, N5 = 2 * 44 * 16, N6 = 44 * 16;
    constexpr int NIT = N1 + N2 + N3 + N4 + N5 + N6;
    for (int it = gw; it < NIT; it += NGW) {
        int r = it;
        if (r < N1) { const int g = r / 16, kb = r % 16; const int d0 = 256 * (g >> 2) + 32 * (g & 3);
            transpose_item(w_in, INC, 64 * kb, inproj_base(g), (bf16_t*)(ws + W_IN), DM, d0, d0 + 128, n1g, scr, F.lane); continue; }
        r -= N1;
        if (r < N2) { const int cb = r / 16, kb = r % 16;
            const float mx = absmax_item(w_in, INC, 64 * kb, NMAIN + 64 * cb, n1g, F.lane);
            if (F.lane == 0) atomicMax((unsigned*)(ws + CTL_BAR) + CTLW_GWMAX + 16 * l, __builtin_bit_cast(unsigned, mx)); continue; }
        r -= N2;
        if (r < N3) { const int w = r / 128, q = r % 128, cb = q / 8, kb = q % 8;
            const float* src = P.in[I_WOA + w] + (size_t)l * 512 * DM;
            transpose_item(src, DM, 64 * kb, 64 * cb, (bf16_t*)(ws + W_OA) + (size_t)w * DM * 512, 512, 64 * cb, 64 * cb + 32, nullptr, scr, F.lane); continue; }
        r -= N3;
        if (r < N4) { const int cb = r / 16, kb = r % 16;
            transpose_item(P.in[I_WOUT] + (size_t)l * DM * DM, DM, 64 * kb, 64 * cb, (bf16_t*)(ws + W_OUT), DM, 64 * cb, 64 * cb + 32, nullptr, scr, F.lane); continue; }
        r -= N4;
        if (r < N5) { const int which = r / (44 * 16), q = r % (44 * 16), cb = q / 16, kb = q % 16; const int c = 64 * cb;
            const float* src = P.in[which ? I_FFW3 : I_FFW1] + (size_t)l * DM * DFF; const int d0 = 256 * (c >> 7) + 128 * which + (c & 127);
            float mx = transpose_item<true>(src, DFF, 64 * kb, c, (bf16_t*)(ws + W_13), DM, d0, d0 + 32, n2g, scr, F.lane);
#pragma unroll
            for (int o = 32; o > 0; o >>= 1) mx = fmaxf(mx, __shfl_xor(mx, o));
            if (F.lane == 0) atomicMax((unsigned*)(ws + CTL_BAR) + CTLW_W13MAX + 16 * l, __builtin_bit_cast(unsigned, mx)); continue; }
        r -= N5;
        { const int cb = r / 44, kb = r % 44;
            transpose_item(P.in[I_FFW2] + (size_t)l * DFF * DM, DM, 64 * kb, 64 * cb, (bf16_t*)(ws + W_2), DFF, 64 * cb, 64 * cb + 32, nullptr, scr, F.lane); }
    }
}
__device__ __forceinline__ void p0_misc(const Frame& F) {
    const Params& P = *F.P;
    unsigned char* ws = P.ws + opaque_zero();
    const int gw = F.bid * 8 + F.wave, NGW = F.G * 8, lane = F.lane;
    const int gt = F.bid * NTHREADS + F.tid, NGT = F.G * NTHREADS;
    float* rowssA = (float*)(ws + WS_ROWSSA);
    const float* x = P.in[I_X]; bf16_t* xb = (bf16_t*)(ws + WS_XB);
    for (int m = gw; m < MTOK; m += NGW) {
        const f32x4* xr = (const f32x4*)(x + (size_t)m * DM) + lane;
        float s = 0.f; f32x4 v[4];
#pragma unroll
        for (int j = 0; j < 4; ++j) { v[j] = __builtin_nontemporal_load(xr + 64 * j); s += v[j][0] * v[j][0] + v[j][1] * v[j][1] + v[j][2] * v[j][2] + v[j][3] * v[j][3]; }
        s = wave_sum(s);
        u32x2* o = (u32x2*)(xb + (size_t)m * DM) + lane;
#pragma unroll
        for (int j = 0; j < 4; ++j) { u32x2 w; w.x = pk2(v[j][0], v[j][1]); w.y = pk2(v[j][2], v[j][3]); o[64 * j] = w; }
        if (lane < 4) rowssA[(size_t)m * 4 + lane] = (lane == 0) ? s : 0.f;
    }
    unsigned* csT = (unsigned*)(ws + CTL_COS);
    for (int i = gt; i < SEQ * 32; i += NGT) { const int pos = i >> 5, k = i & 31;
        const double inv = exp(-(double)k / 32.0 * log(10000.0)); const double ang = (double)pos * inv;
        const _Float16 ch = (_Float16)(float)cos(ang), sh = (_Float16)(float)sin(ang);
        csT[i] = (unsigned)__builtin_bit_cast(unsigned short, ch) | ((unsigned)__builtin_bit_cast(unsigned short, sh) << 16); }
    f32x2* tw = (f32x2*)(ws + CTL_TW);
    for (int i = gt; i < 2048; i += NGT) { float s, c; sincospif(-(float)i * (1.f / 2048.f), &s, &c); tw[i] = (f32x2){c, s}; }
    { unsigned* gp = (unsigned*)(ws + CTL_SIN);
      for (int i = gt; i < DEPTH * 4 * 32; i += NGT) { const int l = i >> 7, ty = (i >> 5) & 3, d = i & 31;
          const float* gsrc = P.in[ty == 0 ? I_QNA : (ty == 1 ? I_KNA : (ty == 2 ? I_QNC : I_KNC))] + l * 64;
          const _Float16 lo = (_Float16)gsrc[d], hi = (_Float16)gsrc[d + 32];
          gp[i] = (unsigned)__builtin_bit_cast(unsigned short, lo) | ((unsigned)__builtin_bit_cast(unsigned short, hi) << 16); } }
    if (gt < DEPTH) { const int l = gt; float a = 0.f, b = 0.f;
        for (int i = 0; i < 64; ++i) { a += P.in[I_LQ1][l * 64 + i] * P.in[I_LK1][l * 64 + i]; b += P.in[I_LQ2][l * 64 + i] * P.in[I_LK2][l * 64 + i]; }
        const float li = 0.8f - 0.6f * expf(-0.3f * (float)l);
        ((float*)(ws + CTL_LAM))[l] = expf(a) - expf(b) + li; }
    float* H2 = (float*)(ws + CTL_H2);
    for (int it = gw; it < DEPTH * SEQ; it += NGW) {
        const int l = it / SEQ, t = it % SEQ;
        const float* w1 = P.in[I_FW1] + l * 33 * 64; const float* w2 = P.in[I_FW2] + l * 64 * 64;
        const int band = (lane & 15) + 1; const int ph = (t * band) & 2047;
        float sv, cv; sincospif((float)ph * (1.f / 1024.f), &sv, &cv);
        float pre = P.in[I_FB1][l * 64 + lane] + ((float)t / (float)(SEQ - 1)) * w1[lane];
#pragma unroll
        for (int k = 0; k < 16; ++k) { pre += __shfl(cv, k) * w1[(1 + k) * 64 + lane]; pre += __shfl(sv, k) * w1[(17 + k) * 64 + lane]; }
        const float h1 = sinf(P.in[I_FF1][l * 64 + lane] * pre);
        float pre2 = P.in[I_FB2][l * 64 + lane];
        for (int j = 0; j < 64; ++j) pre2 += __shfl(h1, j) * w2[j * 64 + lane];
        ((bf16_t*)H2)[(size_t)it * 64 + lane] = f2bf(sinf(P.in[I_FF2][l * 64 + lane] * pre2));
    }
}

__device__ __forceinline__ f32x2 cmul(f32x2 a, f32x2 b) { return (f32x2){a.x * b.x - a.y * b.y, a.x * b.y + a.y * b.x}; }
__device__ __forceinline__ f32x2 cmulc(f32x2 a, f32x2 b) { return (f32x2){a.x * b.x + a.y * b.y, a.y * b.x - a.x * b.y}; }
__device__ __forceinline__ f32x2 mul_mi(f32x2 a) { return (f32x2){a.y, -a.x}; }
__device__ __forceinline__ f32x2 mul_pi(f32x2 a) { return (f32x2){-a.y, a.x}; }
constexpr float RS2 = 0.70710678118654752f;
__device__ __forceinline__ int pidx(int i) { return i + (i >> 3); }
struct Tw3 { f32x2 w1, w2, w3; };
struct TwF { f32x2 w1, s1, w2, s2, w3, s3; };
struct TwI { f32x2 c1, t1, c2, t2, c3, t3; };
__device__ __forceinline__ f32x2 cm2(f32x2 a, f32x2 w, f32x2 s) { const f32x2 t = (f32x2){a.x, a.x} * w; return __builtin_elementwise_fma((f32x2){a.y, a.y}, s, t); }
__device__ __forceinline__ TwF tw_fwd(const Tw3& t) { return TwF{t.w1, (f32x2){-t.w1.y, t.w1.x}, t.w2, (f32x2){-t.w2.y, t.w2.x}, t.w3, (f32x2){-t.w3.y, t.w3.x}}; }
__device__ __forceinline__ TwI tw_inv(const Tw3& t) { return TwI{(f32x2){t.w1.x, -t.w1.y}, (f32x2){t.w1.y, t.w1.x}, (f32x2){t.w2.x, -t.w2.y}, (f32x2){t.w2.y, t.w2.x}, (f32x2){t.w3.x, -t.w3.y}, (f32x2){t.w3.y, t.w3.x}}; }
template <bool UNIT> __device__ __forceinline__ void r8_fwd(f32x2 (&v)[8], const TwF& T) {
    {
        f32x2 d0 = v[0] - v[4], d1 = v[1] - v[5], d2 = v[2] - v[6], d3 = v[3] - v[7];
        v[0] = v[0] + v[4]; v[1] = v[1] + v[5]; v[2] = v[2] + v[6]; v[3] = v[3] + v[7];
        d1 = (f32x2){(d1.x + d1.y) * RS2, (d1.y - d1.x) * RS2};
        d2 = mul_mi(d2);
        d3 = (f32x2){(d3.y - d3.x) * RS2, -(d3.x + d3.y) * RS2};
        if (UNIT) { v[4] = d0; v[5] = d1; v[6] = d2; v[7] = d3; }
        else { v[4] = cm2(d0, T.w1, T.s1); v[5] = cm2(d1, T.w1, T.s1); v[6] = cm2(d2, T.w1, T.s1); v[7] = cm2(d3, T.w1, T.s1); }
    }
#pragma unroll
    for (int q = 0; q < 8; q += 4) {
        const f32x2 d0 = v[q] - v[q + 2], d1 = mul_mi(v[q + 1] - v[q + 3]);
        v[q] = v[q] + v[q + 2]; v[q + 1] = v[q + 1] + v[q + 3];
        if (UNIT) { v[q + 2] = d0; v[q + 3] = d1; } else { v[q + 2] = cm2(d0, T.w2, T.s2); v[q + 3] = cm2(d1, T.w2, T.s2); }
    }
#pragma unroll
    for (int q = 0; q < 8; q += 2) { const f32x2 d = v[q] - v[q + 1]; v[q] = v[q] + v[q + 1]; v[q + 1] = UNIT ? d : cm2(d, T.w3, T.s3); }
}
template <bool UNIT> __device__ __forceinline__ void r8_inv(f32x2 (&v)[8], const TwI& T) {
#pragma unroll
    for (int q = 0; q < 8; q += 2) { const f32x2 b = UNIT ? v[q + 1] : cm2(v[q + 1], T.c3, T.t3), a = v[q]; v[q] = a + b; v[q + 1] = a - b; }
#pragma unroll
    for (int q = 0; q < 8; q += 4) {
        const f32x2 b0 = UNIT ? v[q + 2] : cm2(v[q + 2], T.c2, T.t2), b1 = mul_pi(UNIT ? v[q + 3] : cm2(v[q + 3], T.c2, T.t2)), a0 = v[q], a1 = v[q + 1];
        v[q] = a0 + b0; v[q + 2] = a0 - b0; v[q + 1] = a1 + b1; v[q + 3] = a1 - b1;
    }
    {
        const f32x2 b0 = UNIT ? v[4] : cm2(v[4], T.c1, T.t1); f32x2 b1 = UNIT ? v[5] : cm2(v[5], T.c1, T.t1); const f32x2 b2 = mul_pi(UNIT ? v[6] : cm2(v[6], T.c1, T.t1)); f32x2 b3 = UNIT ? v[7] : cm2(v[7], T.c1, T.t1);
        b1 = (f32x2){(b1.x - b1.y) * RS2, (b1.x + b1.y) * RS2};
        b3 = (f32x2){-(b3.x + b3.y) * RS2, (b3.x - b3.y) * RS2};
        const f32x2 a0 = v[0], a1 = v[1], a2 = v[2], a3 = v[3];
        v[0] = a0 + b0; v[4] = a0 - b0; v[1] = a1 + b1; v[5] = a1 - b1; v[2] = a2 + b2; v[6] = a2 - b2; v[3] = a3 + b3; v[7] = a3 - b3;
    }
}
__device__ __forceinline__ void wave_lds_sync() { asm volatile("s_waitcnt lgkmcnt(0)" ::: "memory"); }
struct FftTw { Tw3 w512, w64, w8; };
__device__ __forceinline__ Tw3 tw3_make(int e) {
    Tw3 t; float s, c;
    sincospif(-(float)e * (1.f / 2048.f), &s, &c); t.w1 = (f32x2){c, s};
    sincospif(-(float)(2 * e) * (1.f / 2048.f), &s, &c); t.w2 = (f32x2){c, s};
    sincospif(-(float)(4 * e) * (1.f / 2048.f), &s, &c); t.w3 = (f32x2){c, s};
    return t;
}
__device__ __forceinline__ FftTw fft_twiddles(int tid) { FftTw t; t.w512 = tw3_make(tid); t.w64 = tw3_make(8 * (tid & 63)); t.w8 = tw3_make(64 * (tid & 7)); return t; }
template <int SP> __device__ __forceinline__ int fft_base(int tid) { return (tid / SP) * 8 * SP + (tid & (SP - 1)); }
template <int SP> __device__ __forceinline__ void fft_ld(const LAS f32x2* X, int tid, f32x2 (&v)[8]) {
    const int base = fft_base<SP>(tid);
#pragma unroll
    for (int j = 0; j < 8; ++j) v[j] = X[pidx(base + j * SP)];
}
template <int SP> __device__ __forceinline__ void fft_st(LAS f32x2* X, int tid, const f32x2 (&v)[8]) {
    const int base = fft_base<SP>(tid);
#pragma unroll
    for (int j = 0; j < 8; ++j) X[pidx(base + j * SP)] = v[j];
}
template <int SP> __device__ __forceinline__ void fft_pass_fwd(LAS f32x2* X, int tid, const Tw3& w) { const TwF T = tw_fwd(w); f32x2 v[8]; fft_ld<SP>(X, tid, v); r8_fwd<false>(v, T); fft_st<SP>(X, tid, v); }
template <int SP> __device__ __forceinline__ void fft_pass_inv(LAS f32x2* X, int tid, const Tw3& w) { const TwI T = tw_inv(w); f32x2 v[8]; fft_ld<SP>(X, tid, v); r8_inv<false>(v, T); fft_st<SP>(X, tid, v); }

constexpr int HY_STG = 0, HY_STG_BYTES = 2 * 2050 * 16, HY_X = 65664, HY_X_BYTES = 4608 * 8, HY_RED = HY_X + HY_X_BYTES;
static_assert(HY_STG_BYTES <= HY_X && HY_X + 2 * HY_X_BYTES <= LDS_BARST, "hyena lds");

constexpr int HM_RS = 192, HM_PLANE = 32 * HM_RS, HM_STG = 0, HM_STG_BYTES = 16 * HM_PLANE;
constexpr int HM_FT = HM_STG_BYTES, HM_FRS = 136, HM_FTBL = 64 * HM_FRS;
constexpr int HM_WT = HM_FT + 3 * HM_FTBL, HM_END = HM_WT + 4096 * 4;
static_assert(HM_END + 128 <= LDS_BARST, "hyena mfma lds");
__device__ __forceinline__ bf16x8 hm_ld_tr(const LAS unsigned char* p) {
    const s16x4 lo4 = __builtin_amdgcn_ds_read_tr16_b64_v4i16((LAS s16x4*)p);
    const s16x4 hi4 = __builtin_amdgcn_ds_read_tr16_b64_v4i16((LAS s16x4*)(p + 4 * HM_RS));
    return (bf16x8){lo4[0], lo4[1], lo4[2], lo4[3], hi4[0], hi4[1], hi4[2], hi4[3]};
}
__device__ __forceinline__ bf16x8 hm_ld2(const LAS unsigned char* p, int off2) {
    const u32x2 a = *(const LAS u32x2*)p, b = *(const LAS u32x2*)(p + off2);
    return __builtin_bit_cast(bf16x8, (u32x4){a.x, a.y, b.x, b.y});
}
__device__ __forceinline__ bf16x8 hm_pack(const f32x16& t, int s) {
    u32x4 w; w.x = pk2(t[8 * s + 0], t[8 * s + 1]); w.y = pk2(t[8 * s + 2], t[8 * s + 3]); w.z = pk2(t[8 * s + 4], t[8 * s + 5]); w.w = pk2(t[8 * s + 6], t[8 * s + 7]);
    return __builtin_bit_cast(bf16x8, w);
}
#define HM_MFMA(a, b, c) __builtin_amdgcn_mfma_f32_32x32x16_bf16(a, b, c, 0, 0, 0)
struct HmF3 { bf16x8 r, i, n; };
__device__ __forceinline__ HmF3 hm_ldf(const LAS unsigned char* fp, int off2) { HmF3 f; f.r = hm_ld2(fp, off2); f.i = hm_ld2(fp + HM_FTBL, off2); f.n = hm_ld2(fp + 2 * HM_FTBL, off2); return f; }
__device__ __forceinline__ void hm_conv_wave(LAS unsigned char* lds, int lane, int ch, const f32x2* H) {
    const int r32 = lane & 31, h = lane >> 5;
    LAS unsigned char* PR = lds + HM_STG + (ch * 2) * HM_PLANE; LAS unsigned char* PI = PR + HM_PLANE;
    const LAS unsigned char* FT = lds + HM_FT; const LAS unsigned* WT = (const LAS unsigned*)(lds + HM_WT);
    f32x16 xr[2], xi[2];
#pragma unroll
    for (int nt = 0; nt < 2; ++nt)
#pragma unroll
        for (int r = 0; r < 16; ++r) { xr[nt][r] = 0.f; xi[nt][r] = 0.f; }
    const int trow0 = 8 * h + ((lane & 15) >> 2), tcol0 = 16 * ((lane >> 4) & 1) + 4 * (lane & 3);
#pragma unroll 1
    for (int c1 = 0; c1 < 2; ++c1) {
        const int k1 = 32 * c1 + r32;
        bf16x8 yrB[4], yiB[4];
        {
            const LAS unsigned char* fb = FT + k1 * HM_FRS + 8 * h * 2;
            bf16x8 aR = hm_ld_tr(PR + trow0 * HM_RS + tcol0 * 2), aI = hm_ld_tr(PI + trow0 * HM_RS + tcol0 * 2);
            HmF3 f = hm_ldf(fb, 8);
#pragma unroll
            for (int rt = 0; rt < 2; ++rt) {
                f32x16 yr, yi;
#pragma unroll
                for (int r = 0; r < 16; ++r) { yr[r] = 0.f; yi[r] = 0.f; }
#pragma unroll
                for (int ks = 0; ks < 2; ++ks) {
                    const int g = 2 * rt + ks;
                    bf16x8 aRn = aR, aIn = aI; HmF3 fn = f;
                    if (g + 1 < 4) { const int rt2 = (g + 1) >> 1, ks2 = (g + 1) & 1;
                        aRn = hm_ld_tr(PR + (16 * ks2 + trow0) * HM_RS + (32 * rt2 + tcol0) * 2); aIn = hm_ld_tr(PI + (16 * ks2 + trow0) * HM_RS + (32 * rt2 + tcol0) * 2);
                        fn = hm_ldf(fb + 16 * ks2 * 2, 8); }
                    yr = HM_MFMA(aR, f.r, yr); yr = HM_MFMA(aI, f.n, yr);
                    yi = HM_MFMA(aR, f.i, yi); yi = HM_MFMA(aI, f.r, yi);
                    asm volatile("" ::: "memory");
                    aR = aRn; aI = aIn; f = fn;
                }
#pragma unroll
                for (int r = 0; r < 16; ++r) {
                    const int n2 = 32 * rt + (r & 3) + 8 * (r >> 2) + 4 * h;
                    const unsigned w = WT[k1 * n2];
                    const float wr = (float)__builtin_bit_cast(_Float16, (unsigned short)(w & 0xffffu)), wi = (float)__builtin_bit_cast(_Float16, (unsigned short)(w >> 16));
                    const float a = yr[r], b = yi[r];
                    yr[r] = a * wr - b * wi; yi[r] = a * wi + b * wr;
                }
#pragma unroll
                for (int s = 0; s < 2; ++s) { yrB[2 * rt + s] = hm_pack(yr, s); yiB[2 * rt + s] = hm_pack(yi, s); }
            }
        }
        bf16x8 zrA[4], ziA[4];
#pragma unroll
        for (int kt = 0; kt < 2; ++kt) {
            f32x16 zr, zi;
#pragma unroll
            for (int r = 0; r < 16; ++r) { zr[r] = 0.f; zi[r] = 0.f; }
            f32x2 hv[16];
#pragma unroll
            for (int r = 0; r < 16; ++r) hv[r] = H[(32 * kt + (r & 3) + 8 * (r >> 2) + 4 * h) * 64 + k1];
            const LAS unsigned char* fb = FT + (32 * kt + r32) * HM_FRS + 4 * h * 2;
            HmF3 f = hm_ldf(fb, 16);
#pragma unroll
            for (int q = 0; q < 4; ++q) {
                HmF3 fn = f; if (q + 1 < 4) fn = hm_ldf(fb + 16 * (q + 1) * 2, 16);
                zr = HM_MFMA(f.r, yrB[q], zr); zr = HM_MFMA(f.n, yiB[q], zr);
                zi = HM_MFMA(f.i, yrB[q], zi); zi = HM_MFMA(f.r, yiB[q], zi);
                asm volatile("" ::: "memory");
                f = fn;
            }
#pragma unroll
            for (int r = 0; r < 16; ++r) {
                const float a = zr[r], b = zi[r];
                zr[r] = a * hv[r].x - b * hv[r].y; zi[r] = a * hv[r].y + b * hv[r].x;
            }
#pragma unroll
            for (int s = 0; s < 2; ++s) { zrA[2 * kt + s] = hm_pack(zr, s); ziA[2 * kt + s] = hm_pack(zi, s); }
        }
#pragma unroll
        for (int nt = 0; nt < 2; ++nt) {
            const int n2 = 32 * nt + r32;
            f32x16 vr, vi;
#pragma unroll
            for (int r = 0; r < 16; ++r) { vr[r] = 0.f; vi[r] = 0.f; }
            const LAS unsigned char* fb = FT + n2 * HM_FRS + 4 * h * 2;
            HmF3 f = hm_ldf(fb, 16);
#pragma unroll
            for (int q = 0; q < 4; ++q) {
                HmF3 fn = f; if (q + 1 < 4) fn = hm_ldf(fb + 16 * (q + 1) * 2, 16);
                vr = HM_MFMA(zrA[q], f.r, vr); vr = HM_MFMA(ziA[q], f.i, vr);
                vi = HM_MFMA(ziA[q], f.r, vi); vi = HM_MFMA(zrA[q], f.n, vi);
                asm volatile("" ::: "memory");
                f = fn;
            }
            const LAS unsigned char* f4 = FT + r32 * HM_FRS + (32 * c1 + 4 * h) * 2;
            HmF3 g0 = hm_ldf(f4, 16), g1 = hm_ldf(f4 + 16 * 2, 16);
#pragma unroll
            for (int r = 0; r < 16; ++r) {
                const int kk = 32 * c1 + (r & 3) + 8 * (r >> 2) + 4 * h;
                const unsigned w = WT[kk * n2];
                const float wr = (float)__builtin_bit_cast(_Float16, (unsigned short)(w & 0xffffu)), wi = (float)__builtin_bit_cast(_Float16, (unsigned short)(w >> 16));
                const float a = vr[r], b = vi[r];
                vr[r] = a * wr + b * wi; vi[r] = b * wr - a * wi;
            }
            {
                const bf16x8 vrB = hm_pack(vr, 0), viB = hm_pack(vi, 0);
                xr[nt] = HM_MFMA(g0.r, vrB, xr[nt]); xr[nt] = HM_MFMA(g0.i, viB, xr[nt]);
                xi[nt] = HM_MFMA(g0.r, viB, xi[nt]); xi[nt] = HM_MFMA(g0.n, vrB, xi[nt]);
            }
            {
                const bf16x8 vrB = hm_pack(vr, 1), viB = hm_pack(vi, 1);
                xr[nt] = HM_MFMA(g1.r, vrB, xr[nt]); xr[nt] = HM_MFMA(g1.i, viB, xr[nt]);
                xi[nt] = HM_MFMA(g1.r, viB, xi[nt]); xi[nt] = HM_MFMA(g1.n, vrB, xi[nt]);
            }
            asm volatile("" ::: "memory");
        }
    }
    asm volatile("s_waitcnt lgkmcnt(0)" ::: "memory");
#pragma unroll
    for (int nt = 0; nt < 2; ++nt)
#pragma unroll
        for (int r = 0; r < 16; ++r) {
            const int n1 = (r & 3) + 8 * (r >> 2) + 4 * h, off = n1 * HM_RS + (32 * nt + r32) * 2;
            *(LAS unsigned short*)(PR + off) = f2bf(xr[nt][r]); *(LAS unsigned short*)(PI + off) = f2bf(xi[nt][r]);
        }
}
__device__ __forceinline__ void hm_init_tables(LAS unsigned char* lds, int tid) {
    for (int i = tid; i < 4096; i += NTHREADS) {
        const int a = i >> 6, b = i & 63; float s, c; sincospif(-(float)((a * b) & 63) * (1.f / 32.f), &s, &c);
        LAS unsigned short* fp = (LAS unsigned short*)(lds + HM_FT + a * HM_FRS + b * 2);
        fp[0] = f2bf(c); fp[HM_FTBL / 2] = f2bf(s); fp[HM_FTBL] = f2bf(-s);
        float s2, c2; sincospif(-(float)i * (1.f / 2048.f), &s2, &c2);
        const _Float16 ch_ = (_Float16)c2, sh_ = (_Float16)s2;
        ((LAS unsigned*)(lds + HM_WT))[i] = (unsigned)__builtin_bit_cast(unsigned short, ch_) | ((unsigned)__builtin_bit_cast(unsigned short, sh_) << 16);
    }
}
__device__ __forceinline__ void hm_spec_wave(const LAS unsigned char* lds, int lane, int cc, int c1, float scale, float dd, f32x2* dst) {
    const int r32 = lane & 31, h = lane >> 5, k1 = 32 * c1 + r32;
    const LAS unsigned char* PR = lds + HM_STG + cc * (64 * HM_RS);
    const LAS unsigned char* FT = lds + HM_FT; const LAS unsigned* WT = (const LAS unsigned*)(lds + HM_WT);
    const int trow0 = 8 * h + ((lane & 15) >> 2), tcol0 = 16 * ((lane >> 4) & 1) + 4 * (lane & 3);
    bf16x8 yrB[4], yiB[4];
#pragma unroll
    for (int rt = 0; rt < 2; ++rt) {
        f32x16 yr, yi;
#pragma unroll
        for (int r = 0; r < 16; ++r) { yr[r] = 0.f; yi[r] = 0.f; }
#pragma unroll
        for (int ks = 0; ks < 4; ++ks) {
            const bf16x8 aR = hm_ld_tr(PR + (16 * ks + trow0) * HM_RS + (32 * rt + tcol0) * 2);
            const LAS unsigned char* fp = FT + k1 * HM_FRS + (16 * ks + 8 * h) * 2;
            const bf16x8 bFr = hm_ld2(fp, 8), bFi = hm_ld2(fp + HM_FTBL, 8);
            yr = HM_MFMA(aR, bFr, yr); yi = HM_MFMA(aR, bFi, yi);
            asm volatile("" ::: "memory");
        }
#pragma unroll
        for (int r = 0; r < 16; ++r) {
            const int n2 = 32 * rt + (r & 3) + 8 * (r >> 2) + 4 * h;
            const unsigned w = WT[k1 * n2];
            const float wr = (float)__builtin_bit_cast(_Float16, (unsigned short)(w & 0xffffu)), wi = (float)__builtin_bit_cast(_Float16, (unsigned short)(w >> 16));
            const float a = yr[r], b = yi[r];
            yr[r] = a * wr - b * wi; yi[r] = a * wi + b * wr;
        }
#pragma unroll
        for (int s = 0; s < 2; ++s) { yrB[2 * rt + s] = hm_pack(yr, s); yiB[2 * rt + s] = hm_pack(yi, s); }
    }
#pragma unroll
    for (int kt = 0; kt < 2; ++kt) {
        f32x16 zr, zi;
#pragma unroll
        for (int r = 0; r < 16; ++r) { zr[r] = 0.f; zi[r] = 0.f; }
#pragma unroll
        for (int q = 0; q < 4; ++q) {
            const HmF3 f = hm_ldf(FT + (32 * kt + r32) * HM_FRS + (16 * q + 4 * h) * 2, 16);
            zr = HM_MFMA(f.r, yrB[q], zr); zr = HM_MFMA(f.n, yiB[q], zr);
            zi = HM_MFMA(f.i, yrB[q], zi); zi = HM_MFMA(f.r, yiB[q], zi);
            asm volatile("" ::: "memory");
        }
#pragma unroll
        for (int r = 0; r < 16; ++r) {
            const int k2 = 32 * kt + (r & 3) + 8 * (r >> 2) + 4 * h;
            dst[k2 * 64 + k1] = (f32x2){zr[r] * scale + dd, zi[r] * scale};
        }
    }
}
constexpr int HM_W3L = HM_END + 128;
static_assert(HM_W3L + 32 * HM_FRS <= LDS_BARST, "spectra lds");
__device__ __forceinline__ void spectra_phase(const Frame& F, int l) {
    const Params& P = *F.P; unsigned char* ws = P.ws + opaque_zero(); const int tid = F.tid, lane = F.lane, r32 = lane & 31, h = lane >> 5;
    LAS unsigned char* lds = F.lds; LAS float* red = (LAS float*)(lds + HM_END);
    hm_init_tables(lds, tid);
    const bf16_t* H2B = (const bf16_t*)(ws + CTL_H2) + (size_t)l * SEQ * 64;
    const float* w3 = P.in[I_FW3] + (size_t)l * 64 * 2048;
    f32x2* spec = (f32x2*)(ws + WS_S);
    const float min_decay = logf(0.01f) / 1.5f, max_decay = logf(0.01f) / 0.3f;
    for (int it = F.bid; it < 256; it += F.G) {
        const int o = it >> 7, c0 = (it & 127) * 4;
        { const int row = tid >> 6, j = tid & 63;
          *(LAS unsigned short*)(lds + HM_W3L + row * HM_FRS + j * 2) = f2bf(w3[(size_t)j * 2048 + (o * 2 + (row >> 2)) * 512 + c0 + (row & 3)]);
#pragma unroll
          for (int k = 0; k < 3; ++k) { const int e = tid + 512 * k; *(LAS unsigned short*)(lds + HM_W3L + (8 + (e >> 6)) * HM_FRS + (e & 63) * 2) = 0; } }
        __syncthreads();
        bf16x8 wA[4];
#pragma unroll
        for (int ks = 0; ks < 4; ++ks) wA[ks] = hm_ld2(lds + HM_W3L + r32 * HM_FRS + (16 * ks + 8 * h) * 2, 8);
        float dl[4];
#pragma unroll
        for (int cc = 0; cc < 4; ++cc) dl[cc] = fabsf(min_decay + (max_decay - min_decay) * ((float)(c0 + cc) / 511.f));
        float ss[4] = {0.f, 0.f, 0.f, 0.f};
#pragma unroll 2
        for (int tt = F.wave; tt < 64; tt += 8) {
            const int t = 32 * tt + r32;
            const bf16_t* hp = H2B + (size_t)t * 64 + 8 * h;
            f32x16 d;
#pragma unroll
            for (int r = 0; r < 16; ++r) d[r] = 0.f;
            bf16x8 hb[4];
#pragma unroll
            for (int ks = 0; ks < 4; ++ks) hb[ks] = *(const bf16x8*)(hp + 16 * ks);
#pragma unroll
            for (int ks = 0; ks < 4; ++ks) d = HM_MFMA(wA[ks], hb[ks], d);
            const float tn = (float)t / (float)(SEQ - 1);
#pragma unroll
            for (int cc = 0; cc < 4; ++cc) {
                float v = d[cc] * expf(-tn * dl[cc]);
                const float other = __shfl_xor(v, 32);
                LAS unsigned char* PR = lds + HM_STG + cc * (64 * HM_RS);
                int n;
                if (t == 0) { if (h == 0) { v += other; n = 0; } else { v = 0.f; n = 2048; } }
                else n = h ? 4096 - t : t;
                *(LAS unsigned short*)(PR + (n >> 6) * HM_RS + (n & 63) * 2) = f2bf(v);
                ss[cc] += v * v;
            }
        }
#pragma unroll
        for (int cc = 0; cc < 4; ++cc) ss[cc] = wave_sum(ss[cc]);
        if (lane == 0) *(LAS f32x4*)(red + F.wave * 4) = (f32x4){ss[0], ss[1], ss[2], ss[3]};
        __syncthreads();
        {
            const int cc = F.wave & 3, c = c0 + cc;
            float tot = 0.f;
#pragma unroll
            for (int w = 0; w < 8; ++w) tot += red[w * 4 + cc];
            const float scale = rsqrtf(tot + RMS_EPS) * (1.f / 4096.f);
            const float dd = P.in[I_HYD][(l * 2 + o) * 512 + c] * (1.f / 4096.f);
            hm_spec_wave(lds, lane, cc, F.wave >> 2, scale, dd, spec + (size_t)(o * 512 + c) * 4096);
        }
        __syncthreads();
    }
}

__device__ __forceinline__ int hm_addr(int ch, int pl, int t) { return ((ch * 2 + pl) * 32 + (t >> 6)) * HM_RS + (t & 63) * 2; }
template <int MODE> __device__ __forceinline__ void hm_elem_pass(const Frame& F, LAS unsigned char* lds, const bf16_t* HY, int b0, int coff, const float* cw, const float* cb, bf16_t* outp, int c0) {
    const int tid = F.tid, b = tid >> 8, t0 = (tid & 255) * 8;
    const bf16_t* rp = HY + ((size_t)(coff >> 3) * MTOK + (size_t)(b0 + b) * SEQ + t0) * 8;
    u32x4 x[10];
    const u32x4 z4 = {0u, 0u, 0u, 0u};
    x[0] = (t0 > 0) ? *(const u32x4*)(rp - 8) : z4;
#pragma unroll
    for (int i = 0; i < 8; ++i) x[1 + i] = *(const u32x4*)(rp + 8 * i);
    x[9] = (t0 + 8 < SEQ) ? *(const u32x4*)(rp + 64) : z4;
    u32x4 res[8];
#pragma unroll
    for (int kp = 0; kp < 4; ++kp) {
        const float wl0 = cw[coff + 2 * kp], wl1 = cw[1536 + coff + 2 * kp], wl2 = cw[2 * 1536 + coff + 2 * kp], bl = cb[coff + 2 * kp];
        const float wh0 = cw[coff + 2 * kp + 1], wh1 = cw[1536 + coff + 2 * kp + 1], wh2 = cw[2 * 1536 + coff + 2 * kp + 1], bh = cb[coff + 2 * kp + 1];
        float lo[8], hi[8];
#pragma unroll
        for (int i = 0; i < 8; ++i) {
            lo[i] = bflo(x[i][kp]) * wl0 + bflo(x[i + 1][kp]) * wl1 + bflo(x[i + 2][kp]) * wl2 + bl;
            hi[i] = bfhi(x[i][kp]) * wh0 + bfhi(x[i + 1][kp]) * wh1 + bfhi(x[i + 2][kp]) * wh2 + bh;
        }
        if (MODE != 0) {
            const u32x4 pl = *(const LAS u32x4*)(lds + HM_STG + hm_addr(2 * kp, b, t0)), ph = *(const LAS u32x4*)(lds + HM_STG + hm_addr(2 * kp + 1, b, t0));
#pragma unroll
            for (int i = 0; i < 4; ++i) { lo[2 * i] *= bflo(pl[i]); lo[2 * i + 1] *= bfhi(pl[i]); hi[2 * i] *= bflo(ph[i]); hi[2 * i + 1] *= bfhi(ph[i]); }
        }
        res[2 * kp] = (u32x4){pk2(lo[0], lo[1]), pk2(lo[2], lo[3]), pk2(lo[4], lo[5]), pk2(lo[6], lo[7])};
        res[2 * kp + 1] = (u32x4){pk2(hi[0], hi[1]), pk2(hi[2], hi[3]), pk2(hi[4], hi[5]), pk2(hi[6], hi[7])};
    }
    if (MODE == 2) {
#pragma unroll
        for (int i = 0; i < 8; ++i) {
            u32x4 w;
#pragma unroll
            for (int kp = 0; kp < 4; ++kp) {
                const unsigned a = res[2 * kp][i >> 1], c = res[2 * kp + 1][i >> 1];
                w[kp] = (i & 1) ? ((a >> 16) | (c & 0xffff0000u)) : ((a & 0xffffu) | (c << 16));
            }
            *(u32x4*)(outp + ((size_t)(b0 + b) * SEQ + t0 + i) * 512 + c0) = w;
        }
    } else {
#pragma unroll
        for (int k = 0; k < 8; ++k) *(LAS u32x4*)(lds + HM_STG + hm_addr(k, b, t0)) = res[k];
    }
    __syncthreads();
}
__device__ __forceinline__ void p2_gate_prep(const Frame& F, int l) {
    const Params& P = *F.P; unsigned char* ws = P.ws + opaque_zero();
    const int gw = F.bid * 8 + F.wave, NGW = F.G * 8, lane = F.lane;
    LAS float* scr = (LAS float*)(F.lds + F.wave * 16640);
    const float wmax = __builtin_bit_cast(float, ((const unsigned*)(ws + CTL_BAR))[CTLW_GWMAX + 16 * l]);
    const float wscale = wmax > 0.f ? 127.f / wmax : 0.f;
    const float* w_in = P.in[I_WIN] + (size_t)l * DM * INC; const float* n1g = P.in[I_N1G] + l * DM;
    for (int it = gw; it < 48 * 16; it += NGW) { const int cb = it / 16, kb = it % 16;
        transpose_item_i8(w_in, INC, 64 * kb, NMAIN + 64 * cb, ws + W_IN + (size_t)NMAIN * DM * 2, DM, 64 * cb, n1g, wscale, scr, lane); }
}
__device__ __forceinline__ void gate_rows_i8(const Frame& F, int wv, int nw, size_t rowss_off) {
    const Params& P = *F.P; unsigned char* ws = P.ws + opaque_zero(); const int lane = F.lane;
    const float* rowss = (const float*)(ws + rowss_off); float* fct = (float*)(ws + CTL_FCTA);
    for (int m0 = wv; m0 < MTOK; m0 += 4 * nw) {
        u32x4 v[4][2];
#pragma unroll
        for (int r = 0; r < 4; ++r) { const int m = m0 + r * nw; if (m < MTOK) { const u32x4* xr = (const u32x4*)(ws + WS_XB + (size_t)m * DM * 2) + lane; v[r][0] = xr[0]; v[r][1] = xr[64]; } }
#pragma unroll
        for (int r = 0; r < 4; ++r) { const int m = m0 + r * nw; if (m < MTOK) {
            float f[16];
#pragma unroll
            for (int h = 0; h < 2; ++h) { const u32x4 w = v[r][h]; f[8 * h + 0] = bflo(w.x); f[8 * h + 1] = bfhi(w.x); f[8 * h + 2] = bflo(w.y); f[8 * h + 3] = bfhi(w.y);
                f[8 * h + 4] = bflo(w.z); f[8 * h + 5] = bfhi(w.z); f[8 * h + 6] = bflo(w.w); f[8 * h + 7] = bfhi(w.w); }
            float mx = 0.f;
#pragma unroll
            for (int e = 0; e < 16; ++e) mx = fmaxf(mx, fabsf(f[e]));
#pragma unroll
            for (int o = 32; o > 0; o >>= 1) mx = fmaxf(mx, __shfl_xor(mx, o));
            const float sc = mx > 0.f ? 127.f / mx : 0.f;
            u32x2* o8 = (u32x2*)(ws + WS_XB8 + (size_t)m * DM) + lane;
#pragma unroll
            for (int h = 0; h < 2; ++h)
                o8[64 * h] = (u32x2){pack_b0(q8(f[8 * h] * sc), q8(f[8 * h + 1] * sc), q8(f[8 * h + 2] * sc), q8(f[8 * h + 3] * sc)), pack_b0(q8(f[8 * h + 4] * sc), q8(f[8 * h + 5] * sc), q8(f[8 * h + 6] * sc), q8(f[8 * h + 7] * sc))};
            if (lane == 0) { const f32x4 q = *(const f32x4*)(rowss + (size_t)m * 4);
                *(f32x4*)(fct + (size_t)m * 4) = (f32x4){rsqrtf(((q[0] + q[1]) + (q[2] + q[3])) * (1.f / DM) + RMS_EPS) * mx * (1.f / 127.f), 0.f, 0.f, 0.f}; }
        } }
    }
}
__device__ __forceinline__ void p5_prep(const Frame& F, int l) {
    const Params& P = *F.P; unsigned char* ws = P.ws + opaque_zero();
    gate_rows_i8(F, F.bid * 8 + F.wave, F.G * 8, WS_ROWSSB);
    const float wmax = __builtin_bit_cast(float, ((const unsigned*)(ws + CTL_BAR))[CTLW_W13MAX + 16 * l]);
    const float sc = wmax > 0.f ? 127.f / wmax : 0.f;
    const u32x4* src = (const u32x4*)(ws + W_13); u32x2* dst = (u32x2*)(ws + W_IN);
    const int gt = F.bid * NTHREADS + F.tid, NGT = F.G * NTHREADS;
    constexpr int TOT = 2 * DFF * DM / 8;
    for (int i0 = gt; i0 < TOT; i0 += 4 * NGT) {
        u32x4 v[4];
#pragma unroll
        for (int j = 0; j < 4; ++j) { const int i = i0 + j * NGT; if (i < TOT) v[j] = src[i]; }
#pragma unroll
        for (int j = 0; j < 4; ++j) { const int i = i0 + j * NGT; if (i < TOT) {
            const u32x4 w = v[j];
            dst[i] = (u32x2){pack_b0(q8(bflo(w.x) * sc), q8(bfhi(w.x) * sc), q8(bflo(w.y) * sc), q8(bfhi(w.y) * sc)), pack_b0(q8(bflo(w.z) * sc), q8(bfhi(w.z) * sc), q8(bflo(w.w) * sc), q8(bfhi(w.w) * sc))}; } }
    }
}
__device__ __forceinline__ void hyena_phase(const Frame& F, int l) {
    const Params& P = *F.P; unsigned char* ws = P.ws + opaque_zero(); const int tid = F.tid;
    LAS unsigned char* lds = F.lds;
    hm_init_tables(lds, tid);
    const bf16_t* HY = (const bf16_t*)(ws + G_HY); bf16_t* OB = (bf16_t*)(ws + WS_OB);
    const f32x2* spec = (const f32x2*)(ws + WS_S);
    const float* cw = P.in[I_CONVW] + (size_t)l * 3 * 1536; const float* cb = P.in[I_CONVB] + (size_t)l * 1536;
    for (int it = F.bid; it < 256; it += F.G) {
        const int combo = (it & 7) * 4 + (it >> 6), bp = combo >> 3, cg = (combo & 7) * 8 + ((it >> 3) & 7), b0 = 2 * bp, c0 = 8 * cg;
        hm_elem_pass<0>(F, lds, HY, b0, c0, cw, cb, nullptr, c0);
        hm_conv_wave(lds, F.lane, F.wave, spec + (size_t)(c0 + F.wave) * 4096);
        __syncthreads();
        hm_elem_pass<1>(F, lds, HY, b0, 512 + c0, cw, cb, nullptr, c0);
        hm_conv_wave(lds, F.lane, F.wave, spec + (size_t)(512 + c0 + F.wave) * 4096);
        __syncthreads();
        hm_elem_pass<2>(F, lds, HY, b0, 1024 + c0, cw, cb, OB, c0);
    }
}

template <int KW, int DV, bool WINDOW>
__device__ __forceinline__ void attn_core(LAS unsigned char* lds, int tid, const bf16_t* Qg, int ldq, const bf16_t* Kb, int ldk, const bf16_t* Vb, int ldv,
                                          int q0, int t_lo, int t_hi, float m_init, float l_init, int kcol, f32x16 (&o)[DV / 32], float& m_out, float& l_out) {
    constexpr int KSTR = (KW + 8) * 2, VSTR = (DV == 128) ? 320 : 192, KCH = KW / 8, VCH = DV / 8, NK = 64 * KCH / NTHREADS, NV = 64 * VCH / NTHREADS;
    constexpr int KBUF = 64 * KSTR, VBUF = 64 * VSTR, VOFF = 2 * KBUF;
    const int lane = tid & 63, wave = tid >> 6, w4 = wave & 3, r32 = lane & 31, h = lane >> 5;
    const int qrow = q0 + 32 * w4 + r32;
    bf16x8 qf[4];
#pragma unroll
    for (int ds = 0; ds < 4; ++ds) qf[ds] = *(const bf16x8*)(Qg + (size_t)qrow * ldq + 16 * ds + 8 * h);
#pragma unroll
    for (int db = 0; db < DV / 32; ++db)
#pragma unroll
        for (int r = 0; r < 16; ++r) o[db][r] = 0.f;
    float m = m_init, l = l_init;
    u32x4 kreg[NK], vreg[NV];
    auto kload = [&](int t) {
#pragma unroll
        for (int i = 0; i < NK; ++i) { const int c = tid + NTHREADS * i, row = c / KCH, ch = c % KCH; kreg[i] = *(const u32x4*)(Kb + (size_t)(64 * t + row) * ldk + ch * 8); }
    };
    auto vload = [&](int t) {
#pragma unroll
        for (int i = 0; i < NV; ++i) { const int c = tid + NTHREADS * i, row = c / VCH, ch = c % VCH; vreg[i] = *(const u32x4*)(Vb + (size_t)(64 * t + row) * ldv + ch * 8); }
    };
    auto kstore = [&](int buf) {
#pragma unroll
        for (int i = 0; i < NK; ++i) { const int c = tid + NTHREADS * i, row = c / KCH, ch = c % KCH; *(LAS u32x4*)(lds + buf * KBUF + row * KSTR + ch * 16) = kreg[i]; }
    };
    auto vstore = [&](int buf) {
#pragma unroll
        for (int i = 0; i < NV; ++i) { const int c = tid + NTHREADS * i, row = c / VCH, ch = c % VCH; *(LAS u32x4*)(lds + VOFF + buf * VBUF + row * VSTR + ch * 16) = vreg[i]; }
    };
    auto qk = [&](int buf, f32x16& S0, f32x16& S1) {
#pragma unroll
        for (int r = 0; r < 16; ++r) { S0[r] = 0.f; S1[r] = 0.f; }
        const LAS unsigned char* kb = lds + buf * KBUF + r32 * KSTR + (kcol + 8 * h) * 2;
#pragma unroll
        for (int ds = 0; ds < 4; ++ds) {
            const bf16x8 k0 = *(const LAS bf16x8*)(kb + ds * 32);
            const bf16x8 k1 = *(const LAS bf16x8*)(kb + 32 * KSTR + ds * 32);
            S0 = __builtin_amdgcn_mfma_f32_32x32x16_bf16(k0, qf[ds], S0, 0, 0, 0);
            S1 = __builtin_amdgcn_mfma_f32_32x32x16_bf16(k1, qf[ds], S1, 0, 0, 0);
        }
    };
    kload(t_lo); vload(t_lo); kstore(0); vstore(0);
    if (t_lo < t_hi) kload(t_lo + 1);
    __syncthreads();
    f32x16 Sa0, Sa1, Sb0, Sb1;
    qk(0, Sa0, Sa1);
    if (t_lo < t_hi) kstore(1);
    __syncthreads();
    auto step = [&](int t, f32x16& S0, f32x16& S1, f32x16& N0, f32x16& N1) {
        const int i = t - t_lo, vcur = i & 1, knext = (i + 1) & 1;
        if (t + 2 <= t_hi) kload(t + 2);
        if (t + 1 <= t_hi) { vload(t + 1); qk(knext, N0, N1); }
        if (WINDOW) {
            const int kbase = 64 * t + 4 * h - qrow;
#pragma unroll
            for (int r = 0; r < 16; ++r) {
                const int d0 = kbase + (r & 3) + 8 * (r >> 2), d1 = d0 + 32;
                if (d0 > 128 || d0 < -128) S0[r] = -1e30f;
                if (d1 > 128 || d1 < -128) S1[r] = -1e30f;
            }
        }
        float mx0 = fmaxf(fmaxf(S0[0], S0[1]), S0[2]), mx1 = fmaxf(fmaxf(S1[0], S1[1]), S1[2]);
#pragma unroll
        for (int r = 3; r < 15; r += 2) { mx0 = fmaxf(fmaxf(mx0, S0[r]), S0[r + 1]); mx1 = fmaxf(fmaxf(mx1, S1[r]), S1[r + 1]); }
        float mx = fmaxf(fmaxf(mx0, S0[15]), fmaxf(mx1, S1[15]));
        mx = fmaxf(mx, __shfl_xor(mx, 32));
        if (__any(mx > m + 6.0f)) {
            const float mnew = fmaxf(m, mx);
            const float alpha = __builtin_amdgcn_exp2f(m - mnew);
            m = mnew; l *= alpha;
#pragma unroll
            for (int db = 0; db < DV / 32; ++db)
#pragma unroll
                for (int r = 0; r < 16; ++r) o[db][r] *= alpha;
        }
        float ps0 = 0.f, ps1 = 0.f, ps2 = 0.f, ps3 = 0.f;
#pragma unroll
        for (int r = 0; r < 16; r += 2) {
            S0[r] = __builtin_amdgcn_exp2f(S0[r] - m); S0[r + 1] = __builtin_amdgcn_exp2f(S0[r + 1] - m); S1[r] = __builtin_amdgcn_exp2f(S1[r] - m); S1[r + 1] = __builtin_amdgcn_exp2f(S1[r + 1] - m);
            ps0 += S0[r]; ps1 += S0[r + 1]; ps2 += S1[r]; ps3 += S1[r + 1];
        }
        l += (ps0 + ps1) + (ps2 + ps3);
        bf16x8 pf[2][2];
#pragma unroll
        for (int s = 0; s < 2; ++s) {
            u32x4 w0, w1;
            w0.x = pk2(S0[8 * s + 0], S0[8 * s + 1]); w0.y = pk2(S0[8 * s + 2], S0[8 * s + 3]); w0.z = pk2(S0[8 * s + 4], S0[8 * s + 5]); w0.w = pk2(S0[8 * s + 6], S0[8 * s + 7]);
            w1.x = pk2(S1[8 * s + 0], S1[8 * s + 1]); w1.y = pk2(S1[8 * s + 2], S1[8 * s + 3]); w1.z = pk2(S1[8 * s + 4], S1[8 * s + 5]); w1.w = pk2(S1[8 * s + 6], S1[8 * s + 7]);
            pf[0][s] = __builtin_bit_cast(bf16x8, w0); pf[1][s] = __builtin_bit_cast(bf16x8, w1);
        }
        const LAS unsigned char* vb = lds + VOFF + vcur * VBUF + (4 * h + ((lane & 15) >> 2)) * VSTR + (16 * ((lane >> 4) & 1) + 4 * (lane & 3)) * 2;
#pragma unroll
        for (int kh = 0; kh < 2; ++kh)
#pragma unroll
            for (int s = 0; s < 2; ++s)
#pragma unroll
                for (int db = 0; db < DV / 32; ++db) {
                    const LAS unsigned char* p = vb + (32 * kh + 16 * s) * VSTR + db * 64;
                    const s16x4 lo4 = __builtin_amdgcn_ds_read_tr16_b64_v4i16((LAS s16x4*)p);
                    const s16x4 hi4 = __builtin_amdgcn_ds_read_tr16_b64_v4i16((LAS s16x4*)(p + 8 * VSTR));
                    const bf16x8 vf = {lo4[0], lo4[1], lo4[2], lo4[3], hi4[0], hi4[1], hi4[2], hi4[3]};
                    o[db] = __builtin_amdgcn_mfma_f32_32x32x16_bf16(vf, pf[kh][s], o[db], 0, 0, 0);
                }
        if (t + 2 <= t_hi) kstore(i & 1);
        if (t + 1 <= t_hi) vstore((i + 1) & 1);
        __syncthreads();
    };
    int t = t_lo;
    for (; t + 1 <= t_hi; t += 2) { step(t, Sa0, Sa1, Sb0, Sb1); step(t + 1, Sb0, Sb1, Sa0, Sa1); }
    if (t <= t_hi) step(t, Sa0, Sa1, Sb0, Sb1);
    m_out = m; l_out = l;
}

constexpr int ATT_CMB = 75776;
template <int WHICH> __device__ __forceinline__ void attn_phase(const Frame& F, int l) {
    const Params& P = *F.P; unsigned char* ws = P.ws + opaque_zero(); const int tid = F.tid, lane = F.lane, wave = F.wave, g = wave >> 2, w4 = wave & 3, r32 = lane & 31, h = lane >> 5;
    if constexpr (WHICH == 0) {
        const bf16_t* QC = (const bf16_t*)(ws + WS_QC); const bf16_t* KC = (const bf16_t*)(ws + G_KC); const bf16_t* VC = (const bf16_t*)(ws + G_VC); bf16_t* OC = (bf16_t*)(ws + WS_QC);
        const float lam = ((const float*)(ws + CTL_LAM))[l];
        const float lam_init = 0.8f - 0.6f * expf(-0.3f * (float)l);
        const float* subln = P.in[I_SUBLN] + l * 128;
        for (int u = F.bid; u < 512; u += F.G) {
            const int b = u >> 6, head = (u >> 4) & 3, qblk = u & 15, q0 = qblk * 128;
            const size_t rb = (size_t)b * SEQ;
            f32x16 o[4]; float m, lsum;
            attn_core<128, 128, false>(F.lds, tid, QC + rb * 512 + head * 128 + g * 64, 512, KC + rb * 512 + head * 128, 512, VC + rb * 512 + head * 128, 512,
                                       q0, 0, 31, -1e30f, 0.f, g * 64, o, m, lsum);
            lsum += __shfl_xor(lsum, 32);
            const float inv = 1.f / lsum;
            LAS f32x4* cmb = (LAS f32x4*)(F.lds + ATT_CMB);
            if (g == 1) {
#pragma unroll
                for (int db = 0; db < 4; ++db)
#pragma unroll
                    for (int rq = 0; rq < 4; ++rq) cmb[((w4 * 16 + db * 4 + rq) * 64) + lane] = (f32x4){o[db][4 * rq] * inv, o[db][4 * rq + 1] * inv, o[db][4 * rq + 2] * inv, o[db][4 * rq + 3] * inv};
            }
            __syncthreads();
            if (g == 0 && !F.dry) {
                float ss = 0.f;
#pragma unroll
                for (int db = 0; db < 4; ++db)
#pragma unroll
                    for (int rq = 0; rq < 4; ++rq) {
                        const f32x4 o2 = cmb[((w4 * 16 + db * 4 + rq) * 64) + lane];
#pragma unroll
                        for (int i = 0; i < 4; ++i) { const float v = o[db][4 * rq + i] * inv - lam * o2[i]; o[db][4 * rq + i] = v; ss += v * v; }
                    }
                ss += __shfl_xor(ss, 32);
                const float rn = rsqrtf(ss * (1.f / 128.f) + RMS_EPS) * (1.f - lam_init);
                const int qrow = q0 + 32 * w4 + r32;
                bf16_t* op = OC + (rb + qrow) * 512 + head * 128;
#pragma unroll
                for (int db = 0; db < 4; ++db)
#pragma unroll
                    for (int rp = 0; rp < 2; ++rp) {
                        u32x2 w[2];
#pragma unroll
                        for (int k = 0; k < 2; ++k) { const int rq = 2 * rp + k, d = 32 * db + 8 * rq + 4 * h; const f32x4 sg = *(const f32x4*)(subln + d);
                            w[k].x = pk2(o[db][4 * rq] * rn * sg[0], o[db][4 * rq + 1] * rn * sg[1]); w[k].y = pk2(o[db][4 * rq + 2] * rn * sg[2], o[db][4 * rq + 3] * rn * sg[3]); }
                        { auto r = __builtin_amdgcn_permlane32_swap(w[0].x, w[1].x, false, false); w[0].x = r[0]; w[1].x = r[1]; }
                        { auto r = __builtin_amdgcn_permlane32_swap(w[0].y, w[1].y, false, false); w[0].y = r[0]; w[1].y = r[1]; }
                        *(u32x4*)(op + 32 * db + 16 * rp + 8 * h) = (u32x4){w[0].x, w[0].y, w[1].x, w[1].y};
                    }
            }
        }
    }
    if constexpr (WHICH == 1) {
        const bf16_t* QA = (const bf16_t*)(ws + WS_QA); const bf16_t* KA = (const bf16_t*)(ws + G_KA); const bf16_t* VA = (const bf16_t*)(ws + G_VA); bf16_t* OA = (bf16_t*)(ws + WS_QA);
        const float* sink = P.in[I_SINK] + l * 8;
        for (int u = F.bid; u < 512; u += F.G) {
            const int b = u >> 6, kvh = (u >> 5) & 1, qblk = (u >> 1) & 15, hp = u & 1, q0 = qblk * 128;
            const int qh = kvh * 4 + hp * 2 + g;
            const size_t rb = (size_t)b * SEQ;
            int t_lo = (q0 - 128) / 64; if (t_lo < 0) t_lo = 0;
            int t_hi = (q0 + 255) / 64; if (t_hi > 31) t_hi = 31;
            f32x16 o[2]; float m, lsum;
            attn_core<64, 64, true>(F.lds, tid, QA + rb * 512 + qh * 64, 512, KA + rb * 128 + kvh * 64, 128, VA + rb * 128 + kvh * 64, 128,
                                    q0, t_lo, t_hi, sink[qh] * LOG2E, (h == 0) ? 1.f : 0.f, 0, o, m, lsum);
            lsum += __shfl_xor(lsum, 32);
            const float inv = 1.f / lsum;
            const int qrow = q0 + 32 * w4 + r32;
            bf16_t* op = OA + (rb + qrow) * 512 + qh * 64;
            if (!F.dry)
#pragma unroll
            for (int db = 0; db < 2; ++db)
#pragma unroll
                for (int rp = 0; rp < 2; ++rp) {
                    u32x2 w[2];
#pragma unroll
                    for (int k = 0; k < 2; ++k) { const int rq = 2 * rp + k;
                        w[k].x = pk2(o[db][4 * rq] * inv, o[db][4 * rq + 1] * inv); w[k].y = pk2(o[db][4 * rq + 2] * inv, o[db][4 * rq + 3] * inv); }
                    { auto r = __builtin_amdgcn_permlane32_swap(w[0].x, w[1].x, false, false); w[0].x = r[0]; w[1].x = r[1]; }
                    { auto r = __builtin_amdgcn_permlane32_swap(w[0].y, w[1].y, false, false); w[0].y = r[0]; w[1].y = r[1]; }
                    *(u32x4*)(op + 32 * db + 16 * rp + 8 * h) = (u32x4){w[0].x, w[0].y, w[1].x, w[1].y};
                }
        }
    }
}

__device__ __forceinline__ void p1_inproj(const Frame& F, int l) {
    const Params& P = *F.P; unsigned char* ws = P.ws + opaque_zero();
    pg8::Gemm g{(const bf16_t*)(ws + WS_XB), (const bf16_t*)(ws + W_IN), MTOK, NMAIN, DM, 0, 0};
    pg8::StaticOrder S; S.init(MTOK, NMAIN, F.G, F.bid);
    EpiInProj E{nullptr, (const float*)(ws + WS_ROWSSA), (const unsigned*)(ws + CTL_COS), (const unsigned*)(ws + CTL_SIN) + l * 128,
                (bf16_t*)(ws + WS_QA), (bf16_t*)(ws + G_KA), (bf16_t*)(ws + G_VA), (bf16_t*)(ws + WS_QC), (bf16_t*)(ws + G_KC), (bf16_t*)(ws + G_VC), (bf16_t*)(ws + G_HY)};
    pg8::Acc acc;
    {
        const int U = (MTOK / 256) * (NMAIN / 256), R = (U + F.G - 1) / F.G; int ns = R * F.G - U, si = F.bid - (F.G - ns);
        if (ns == 0) { ns = F.G; si = F.bid; }
        if (si >= 0) gate_rows_i8(F, si * 8 + F.wave, ns * 8, WS_ROWSSA);
        __syncthreads();
    }
    pg8::gemm_phase<EpiInProj, pg8::StaticOrder, true, true, true>(F.lds, F.tid, g, S, E, acc);
}
__device__ __forceinline__ void p3_merge(const Frame& F, int l) {
    const Params& P = *F.P; unsigned char* ws = P.ws + opaque_zero();
    pg8::ChainOrder3 S; S.S.init(MTOK, DM, F.G, F.bid);
    {
        pg8::Gemm g{(const bf16_t*)(ws + WS_XB8), (const bf16_t*)(ws + W_IN + (size_t)NMAIN * DM * 2), MTOK, DM, DM, 0, (size_t)DM * DM};
        EpiGate E{nullptr, F.tid, (const float*)(ws + CTL_FCTA), __builtin_bit_cast(float, ((const unsigned*)(ws + CTL_BAR))[CTLW_GWMAX + 16 * l]) * (1.f / 127.f), (u32x4*)(ws + WS_G)};
        pg8::Acc acc;
        pg8::gemm_phase<EpiGate, pg8::ChainOrder3, true, true, true, false, true>(F.lds, F.tid, g, S, E, acc);
    }
    {
        pg8::Gemm g{(const bf16_t*)(ws + WS_QA), (const bf16_t*)(ws + W_OA), MTOK, DM, 512, (size_t)16 * MiB, (size_t)DM * 512 * 2};
        EpiMerge E{F.tid, (const u32x4*)(ws + WS_G), (bf16_t*)(ws + WS_S)};
        pg8::Acc acc;
        pg8::gemm_phase<EpiMerge, pg8::ChainOrder3, true, true, true>(F.lds, F.tid, g, S, E, acc);
    }
}
__device__ __forceinline__ void p4_wout(const Frame& F, int l) {
    const Params& P = *F.P; unsigned char* ws = P.ws + opaque_zero();
    pg8::Gemm g{(const bf16_t*)(ws + WS_S), (const bf16_t*)(ws + W_OUT), MTOK, DM, DM, 0, 0};
    pg8::StaticOrder S; S.init(MTOK, DM, F.G, F.bid);
    EpiResid<false> E{(bf16_t*)(ws + WS_XB), P.out, (float*)(ws + WS_ROWSSB), F.dry, (LAS float*)(F.lds + pg8::STAGE_BYTES), F.tid};
    pg8::Acc acc;
    pg8::gemm_phase<EpiResid<false>, pg8::StaticOrder, true, true, true>(F.lds, F.tid, g, S, E, acc);
}
__device__ __forceinline__ void p5_ffn_up(const Frame& F, int l) {
    const Params& P = *F.P; unsigned char* ws = P.ws + opaque_zero();
    pg8::Gemm g{(const bf16_t*)(ws + WS_XB8), (const bf16_t*)(ws + W_IN), MTOK, 2 * DFF, DM, 0, 0};
    pg8::TailSplitOrder S; S.init(MTOK, 2 * DFF, F.G, F.bid);
    EpiSwiGLU E{nullptr, (const float*)(ws + CTL_FCTA), __builtin_bit_cast(float, ((const unsigned*)(ws + CTL_BAR))[CTLW_W13MAX + 16 * l]) * (1.f / 127.f), (bf16_t*)(ws + WS_G), F.dry && (P.pad == 12)};
    pg8::Acc acc;
    pg8::gemm_phase<EpiSwiGLU, pg8::TailSplitOrder, true, true, true, true, true>(F.lds, F.tid, g, S, E, acc);
}
template <int L> __device__ __forceinline__ void p6_ffn_down(const Frame& F) {
    const Params& P = *F.P; unsigned char* ws = P.ws + opaque_zero();
    pg8::Gemm g{(const bf16_t*)(ws + WS_G), (const bf16_t*)(ws + W_2), MTOK, DM, DFF, 0, 0};
    pg8::StaticOrder S; S.init(MTOK, DM, F.G, F.bid);
    constexpr bool FINAL = (L + 1 >= DEPTH);
    EpiResid<FINAL> E{(bf16_t*)(ws + WS_XB), P.out, (float*)(ws + WS_ROWSSA), F.dry, (LAS float*)(F.lds + pg8::STAGE_BYTES), F.tid};
    pg8::Acc acc;
    pg8::gemm_phase<EpiResid<FINAL>, pg8::StaticOrder, true, true, true>(F.lds, F.tid, g, S, E, acc);
}

constexpr int PH_PER_LAYER = 8, NPHASE = PH_PER_LAYER * DEPTH;
#define PH_IN(k) (P.lo <= (k) && (k) < P.hi)
#define PH_FRAME() do { int t_ = threadIdx.x; asm volatile("" : "+v"(t_)); F.tid = t_; F.lane = t_ & 63; F.wave = __builtin_amdgcn_readfirstlane(t_ >> 6); \
                        int b_ = blockIdx.x; asm volatile("" : "+s"(b_)); F.bid = b_; } while (0)
#define PH_SEAM(k) do { if (PH_IN(k) && PH_IN((k) + 1)) { if (P.coop) { xcd_barrier(xbar); if (P.pad == 11) xcd_barrier(xbar); } } __syncthreads(); } while (0)
#define PH_RUN(code, call) do { const int nrep_ = (P.pad == (code)) ? 2 : 1; for (int rep_ = 0; rep_ < nrep_; ++rep_) { PH_FRAME(); F.dry = (rep_ + 1 < nrep_); call; __syncthreads(); } } while (0)
template <int L> __device__ __forceinline__ void run_layer(Frame& F, const Params& P, cg::grid_group& grid, const XcdBarrier& xbar) {
    constexpr int B = PH_PER_LAYER * L;
    if (PH_IN(B + 0)) { PH_RUN(1, (p0_weights(F, L), (L == 0 ? p0_misc(F) : (void)0))); }
    PH_SEAM(B + 0);
    if (PH_IN(B + 1)) { PH_RUN(2, spectra_phase(F, L)); PH_RUN(3, p1_inproj(F, L)); }
    PH_SEAM(B + 1);
    if (PH_IN(B + 2)) { PH_RUN(13, p2_gate_prep(F, L)); PH_RUN(4, hyena_phase(F, L)); PH_RUN(5, attn_phase<0>(F, L)); PH_RUN(6, attn_phase<1>(F, L)); }
    PH_SEAM(B + 2);
    if (PH_IN(B + 3)) { PH_RUN(7, p3_merge(F, L)); }
    PH_SEAM(B + 3);
    if (PH_IN(B + 4)) { PH_RUN(8, p4_wout(F, L)); }
    PH_SEAM(B + 4);
    if (PH_IN(B + 5)) { PH_RUN(14, p5_prep(F, L)); }
    PH_SEAM(B + 5);
    if (PH_IN(B + 6)) { PH_RUN((P.pad == 12 ? 12 : 9), p5_ffn_up(F, L)); }
    PH_SEAM(B + 6);
    if (PH_IN(B + 7)) { PH_RUN(10, p6_ffn_down<L>(F)); }
    PH_SEAM(B + 7);
}
__global__ void __launch_bounds__(NTHREADS, 2) mega_fwd(Params P) {
    extern __shared__ __attribute__((aligned(16))) unsigned char lds_raw[];
    cg::grid_group grid = cg::this_grid();
    Frame F;
    F.lds = (LAS unsigned char*)lds_raw;
    F.G = gridDim.x; F.P = &P;
    volatile LAS unsigned* bst = (volatile LAS unsigned*)(F.lds + LDS_BARST);
    if (threadIdx.x < 4) bst[threadIdx.x] = 0u;
    __syncthreads();
    XcdBarrier xbar; xbar.bar = (unsigned*)(P.ws + CTL_BAR); xbar.x = 0; xbar.st = bst;
    if (P.coop) xbar = xcd_barrier_post((unsigned*)(P.ws + CTL_BAR), bst);
    if (P.coop == 2) grid.sync();
    run_layer<0>(F, P, grid, xbar);
    run_layer<1>(F, P, grid, xbar);
}

#ifndef PROBE_CODE
#define PROBE_CODE 0
#endif
#ifndef N_LAUNCH_MODE
#define N_LAUNCH_MODE 1
#endif
extern "C" void kernel_launch(void* const* d_in, const int* in_sizes, int n_in, void* d_out, int out_size, void* d_ws, size_t ws_size, hipStream_t stream) {
    static int grid = 0;
    if (grid == 0) {
        int dev = 0, cus = 0, per_cu = 0;
        if (hipGetDevice(&dev) != hipSuccess || hipDeviceGetAttribute(&cus, hipDeviceAttributeMultiprocessorCount, dev) != hipSuccess) { fprintf(stderr, "kernel_launch: device query failed\n"); grid = -1; return; }
        if (hipFuncSetAttribute((const void*)mega_fwd, hipFuncAttributeMaxDynamicSharedMemorySize, LDS_BYTES) != hipSuccess) { fprintf(stderr, "kernel_launch: hipFuncSetAttribute failed\n"); grid = -1; return; }
        if (hipOccupancyMaxActiveBlocksPerMultiprocessor(&per_cu, (const void*)mega_fwd, NTHREADS, LDS_BYTES) != hipSuccess || per_cu < 1) { fprintf(stderr, "kernel_launch: occupancy query failed (%d)\n", per_cu); per_cu = 1; }
        (void)hipGetLastError();
        if (per_cu > 1) per_cu = 1;
        grid = cus * per_cu;
        if (n_in != 31 || ws_size < WS_END) fprintf(stderr, "kernel_launch: unexpected n_in %d / ws_size %zu (need %zu)\n", n_in, ws_size, (size_t)WS_END);
    }
    if (grid < 0) return;
    Params p{};
    for (int i = 0; i < 31; ++i) p.in[i] = (const float*)d_in[i];
    p.out = (float*)d_out; p.ws = (unsigned char*)d_ws;
#if N_LAUNCH_MODE == 1
    p.lo = 0; p.hi = NPHASE; p.coop = 1; p.pad = PROBE_CODE;
    if (hipMemsetAsync((char*)d_ws + CTL_BAR, 0, CTL_BAR_BYTES, stream) != hipSuccess) { fprintf(stderr, "kernel_launch: memset of barrier words failed\n"); return; }
    void* args[] = {&p};
    hipError_t e = hipLaunchCooperativeKernel((const void*)mega_fwd, dim3(grid), dim3(NTHREADS), args, LDS_BYTES, stream);
    if (e != hipSuccess) fprintf(stderr, "cooperative launch failed: %s (grid %d)\n", hipGetErrorString(e), grid);
#else
    for (int ph = 0; ph < NPHASE; ++ph) {
        p.lo = ph; p.hi = ph + 1; p.coop = 0;
        hipLaunchKernelGGL(mega_fwd, dim3(grid), dim3(NTHREADS), LDS_BYTES, stream, p);
    }
#endif
}
```

```cpp
#include <hip/hip_runtime.h>
#include <hip/hip_cooperative_groups.h>
#include <cstdint>
#include <cstdio>
namespace cg = cooperative_groups;

#define LAS __attribute__((address_space(3)))
typedef unsigned short bf16_t;
typedef short bf16x8 __attribute__((ext_vector_type(8)));
typedef short s16x4 __attribute__((ext_vector_type(4)));
typedef float f32x2 __attribute__((ext_vector_type(2)));
typedef float f32x4 __attribute__((ext_vector_type(4)));
typedef float f32x16 __attribute__((ext_vector_type(16)));
typedef unsigned u32x2 __attribute__((ext_vector_type(2)));
typedef unsigned u32x4 __attribute__((ext_vector_type(4)));
typedef __bf16 bf16x2_t __attribute__((ext_vector_type(2)));

constexpr int DM = 1024, NBATCH = 8, SEQ = 2048, MTOK = NBATCH * SEQ, DEPTH = 2;
constexpr int INC = 6912, NMAIN = 3840, DFF = 2816;
constexpr float RMS_EPS = 1e-6f;
constexpr float LOG2E = 1.4426950408889634f;
constexpr float QSCALE = 0.125f * LOG2E;
constexpr int NTHREADS = 512;
constexpr int LDS_BYTES = 147456;

constexpr size_t MiB = 1u << 20;
constexpr size_t WS_CTL = 0;
constexpr size_t CTL_ROWSSA = 0;
constexpr size_t CTL_ROWSSB = 128 * 1024;
constexpr size_t CTL_COS = 256 * 1024;
constexpr size_t CTL_SIN = 512 * 1024;
constexpr size_t CTL_LAM = 768 * 1024;
constexpr size_t CTL_TW = 768 * 1024 + 256;
constexpr size_t CTL_H2 = 1 * MiB;
constexpr size_t CTL_BAR = 2 * MiB;
constexpr size_t CTL_BAR_BYTES = 40960;
constexpr int LDS_BARST = LDS_BYTES - 64;
constexpr size_t WS_W = 4 * MiB;
constexpr size_t W_IN = WS_W;
constexpr size_t W_OA = W_IN + (size_t)INC * DM * 2;
constexpr size_t W_OUT = W_OA + 3 * (size_t)DM * 512 * 2;
constexpr size_t W_13 = W_OUT + (size_t)DM * DM * 2;
constexpr size_t W_2 = W_13 + (size_t)2 * DFF * DM * 2;
constexpr size_t WS_XB = 39 * MiB;
constexpr size_t WS_QA = 71 * MiB;
constexpr size_t WS_OB = 87 * MiB;
constexpr size_t WS_QC = 103 * MiB;
constexpr size_t WS_G = 119 * MiB;
constexpr size_t G_KA = WS_G, G_VA = WS_G + 4 * MiB, G_HY = WS_G + 8 * MiB, G_KC = WS_G + 56 * MiB, G_VC = WS_G + 72 * MiB;
constexpr size_t WS_S = 207 * MiB;
constexpr size_t WS_XB8 = 239 * MiB;
constexpr size_t CTL_FCTA = 3 * MiB + 512 * 1024;
constexpr size_t WS_ROWSSA = 2 * MiB + 512 * 1024;
constexpr size_t WS_ROWSSB = 3 * MiB;
constexpr size_t WS_END = 255 * MiB + 512 * 1024;
constexpr size_t CTL_CS = 3 * MiB + 768 * 1024;
constexpr size_t CS_IN = CTL_CS, CS_G = CTL_CS + 16384, CS_13 = CTL_CS + 32768;
constexpr int CTLW_XQCNT = 8192;
constexpr size_t WS_XSLOT = 255 * MiB;
constexpr int CTLW_W13MAX = 4096 + 256;
constexpr int CTLW_GWMAX = 4096;
static_assert(W_2 + (size_t)DM * DFF * 2 <= WS_XB, "weights fit");

struct Params {
    const float* in[31];
    float* out;
    unsigned char* ws;
    int lo, hi, coop, pad;
};
enum { I_X = 0, I_N1G, I_WIN, I_SINK, I_QNA, I_KNA, I_CONVW, I_CONVB, I_FW1, I_FB1, I_FF1, I_FW2, I_FB2, I_FF2, I_FW3, I_HYD, I_QNC, I_KNC, I_LQ1, I_LK1, I_LQ2, I_LK2, I_SUBLN,
       I_WOA, I_WOB, I_WOC, I_WOUT, I_N2G, I_FFW1, I_FFW3, I_FFW2 };

__device__ __forceinline__ unsigned pk2(float lo, float hi) { f32x2 v = {lo, hi}; bf16x2_t b = __builtin_convertvector(v, bf16x2_t); return __builtin_bit_cast(unsigned, b); }
__device__ __forceinline__ float bf2f(unsigned short b) { return __uint_as_float(((unsigned)b) << 16); }
__device__ __forceinline__ float bflo(unsigned w) { return __uint_as_float(w << 16); }
__device__ __forceinline__ float bfhi(unsigned w) { return __uint_as_float(w & 0xffff0000u); }
__device__ __forceinline__ unsigned short f2bf(float f) { return (unsigned short)(pk2(f, 0.f) & 0xffffu); }
__device__ __forceinline__ size_t opaque_zero() { unsigned z = 0; asm volatile("" : "+s"(z)); return (size_t)z; }
__device__ __forceinline__ float wave_sum(float v) {
#pragma unroll
    for (int o = 1; o < 64; o <<= 1) v += __shfl_xor(v, o);
    return v;
}
__device__ __forceinline__ void rows_rstd8(const float* rowss, int row0, float (&rs)[8]) {
    f32x4 q[8];
#pragma unroll
    for (int k = 0; k < 8; ++k) q[k] = *(const f32x4*)(rowss + (size_t)(row0 + (k >> 2) * 128 + (k & 3) * 16) * 4);
#pragma unroll
    for (int k = 0; k < 8; ++k) rs[k] = rsqrtf(((q[k][0] + q[k][1]) + (q[k][2] + q[k][3])) * (1.f / DM) + RMS_EPS);
}
__device__ __forceinline__ void rows_rstd8_lds(LAS const float* p, int fr, float (&rs)[8]) {
    f32x4 q[8];
#pragma unroll
    for (int k = 0; k < 8; ++k) q[k] = *(LAS const f32x4*)(p + (k >> 2) * 256 + ((k & 3) * 16 + fr) * 4);
#pragma unroll
    for (int k = 0; k < 8; ++k) rs[k] = rsqrtf(((q[k][0] + q[k][1]) + (q[k][2] + q[k][3])) * (1.f / DM) + RMS_EPS);
}
__device__ __forceinline__ int crow(int r, int hi) { return (r & 3) + 8 * (r >> 2) + 4 * hi; }

namespace pg8 {
constexpr int BM = 256, BK = 64, HALF = 128, HTB = HALF * BK * 2, STAGE_BYTES = 8 * HTB, NXCD = 8, WGM = 8;
constexpr int CS_OFF = STAGE_BYTES + 4096 + 8192;
constexpr int RS_OFF = STAGE_BYTES + 4096;
__host__ __device__ __forceinline__ int lds_byte(int r, int c) { const int st = (r >> 4) * 2 + (c >> 5), rr = r & 15, cc = c & 31, ob = rr * 64 + cc * 2; return st * 1024 + (ob ^ (((ob >> 9) & 1) << 5)); }
__host__ __device__ __forceinline__ void stage_rc(int b, int& R, int& C) { const int st = b / 1024, sb = b % 1024, swz = sb ^ (((sb >> 9) & 1) << 5); R = (st >> 1) * 16 + swz / 64; C = (st & 1) * 32 + (swz % 64) / 2; }
__host__ __device__ __forceinline__ int perm32(int rho) { const int n = rho >> 4, i = rho & 15; return 8 * (i >> 2) + 4 * n + (i & 3); }

struct Unit { int pm, pn, sub, half; };
struct Gemm { const bf16_t* A; const bf16_t* Bt; int M, N, K; size_t sA, sB; };

struct StaticOrder {
    int nM, nN, nwg, G, c;
    __host__ __device__ void init(int M, int N, int G_, int c_) { nM = M / BM; nN = N / BM; nwg = nM * nN; G = G_; c = c_; }
    __host__ __device__ void map(int L, Unit& u) const {
        int wgid = L; { const int q = nwg / NXCD, r = nwg % NXCD, xcd = wgid % NXCD, off = wgid / NXCD; wgid = (xcd < r ? xcd * (q + 1) : r * (q + 1) + (xcd - r) * q) + off; }
        const int nig = WGM * nN, gid = wgid / nig, fm = gid * WGM, gsz = (nM - fm) < WGM ? (nM - fm) : WGM;
        u.pm = fm + ((wgid % nig) % gsz); u.pn = (wgid % nig) / gsz; u.sub = 0; u.half = 0;
    }
    __host__ __device__ bool next(int i, Unit& u) const {
        const long L = (long)i * G + c; if (L >= nwg) return false;
        map((int)L, u); return true;
    }
};
struct TailSplitOrder {
    StaticOrder S; int full, rem;
    __device__ __forceinline__ void init(int M, int N, int G_, int c_) { S.init(M, N, G_, c_); full = (S.nwg / G_) * G_; rem = S.nwg - full; }
    __device__ __forceinline__ bool next(int i, Unit& u) const {
        const long L = (long)i * S.G + S.c;
        if (2 * rem != S.G || L < full) return S.next(i, u);
        if (i != full / S.G) return false;
        S.map(full + (S.c >> 1), u); u.half = 1 + (S.c & 1); return true;
    }
};
struct ChainOrder3 {
    StaticOrder S;
    __device__ __forceinline__ bool next(int i, Unit& u) const { const int q = i / 3; if (!S.next(q, u)) return false; u.sub = i - 3 * q; return true; }
};

typedef f32x4 Acc[2][2][4][2];
typedef int i32x4v __attribute__((ext_vector_type(4)));

template <class Epi, class Sched, bool ALIGN_EPI, bool SP2, bool ZERO, bool HALF_OK = false, bool I8 = false>
__device__ __forceinline__ void gemm_phase(LAS unsigned char* lds, const int tid, const Gemm g, const Sched& S, Epi& E, Acc& acc) {
    const int wid = __builtin_amdgcn_readfirstlane(tid >> 6), lane = tid & 63, wr = wid >> 2, wc = wid & 3, fr = lane & 15, fq = lane >> 4;
    constexpr int ES = I8 ? 1 : 2;
    const int K = g.K, nt = K * ES / (BK * 2);
    unsigned voffA[2], voffB[2];
#pragma unroll
    for (int i = 0; i < 2; ++i) { int R, C; stage_rc(tid * 16 + i * 8192, R, C); const int Rb = Epi::PERM ? ((R & ~31) + perm32(R & 31)) : R;
        voffA[i] = (unsigned)(R * K * ES + C * 2); voffB[i] = (unsigned)(Rb * K * ES + C * 2); }
    const size_t kstep = (size_t)(BK * 2);
    const size_t hstep = (size_t)HALF * K * ES;
    const size_t tstep = 2 * hstep;
    const unsigned ldsw = (unsigned)wid * 1024u;
    const int aoff = lds_byte(wr * 64 + fr, fq * 8), boff = lds_byte(wc * 32 + fr, fq * 8);
#define PG8_SA(b, h) (((b) * 2 + (h)) * HTB)
#define PG8_SB(b, h) ((4 + (b) * 2 + (h)) * HTB)
#define PG8_STAGE(bufoff, gbase, voff) do { _Pragma("unroll") for (int _i = 0; _i < 2; ++_i) \
        __builtin_amdgcn_global_load_lds((const unsigned*)((const char*)(gbase) + (voff)[_i]), (LAS unsigned*)(lds + (bufoff) + ldsw + _i * 8192), 16, 0, 0); } while (0)
#define PG8_LDA(dst, b, h) do { _Pragma("unroll") for (int m = 0; m < 4; ++m) _Pragma("unroll") for (int k = 0; k < 2; ++k) dst[m][k] = *(const LAS bf16x8*)(lds + PG8_SA(b, h) + aoff + m * 2048 + k * 1024); } while (0)
#define PG8_LDB(dst, b, h) do { _Pragma("unroll") for (int n = 0; n < 2; ++n) _Pragma("unroll") for (int k = 0; k < 2; ++k) dst[n][k] = *(const LAS bf16x8*)(lds + PG8_SB(b, h) + boff + n * 2048 + k * 1024); } while (0)
#define PG8_MMA(ai, bj, At, Bt) do { __builtin_amdgcn_s_setprio(1); _Pragma("unroll") for (int m = 0; m < 4; ++m) _Pragma("unroll") for (int n = 0; n < 2; ++n) { \
        _Pragma("unroll") for (int k = 0; k < 2; ++k) { \
        if constexpr (I8) acc[ai][bj][m][n] = __builtin_bit_cast(f32x4, __builtin_amdgcn_mfma_i32_16x16x64_i8(__builtin_bit_cast(i32x4v, Bt[n][k]), __builtin_bit_cast(i32x4v, At[m][k]), __builtin_bit_cast(i32x4v, acc[ai][bj][m][n]), 0, 0, 0)); \
        else acc[ai][bj][m][n] = __builtin_amdgcn_mfma_f32_16x16x32_bf16(Bt[n][k], At[m][k], acc[ai][bj][m][n], 0, 0, 0); } } \
        __builtin_amdgcn_s_setprio(0); } while (0)
#define PG8_WAIT_V(n) asm volatile("s_waitcnt vmcnt(" #n ")" ::: "memory")
#define PG8_WAIT_L(n) asm volatile("s_waitcnt lgkmcnt(" #n ")" ::: "memory")
#define PG8_BAR __builtin_amdgcn_s_barrier()
#define PG8_SCHED __builtin_amdgcn_sched_barrier(0)
#define PG8_ZERO_ACC() do { _Pragma("unroll") for (int a = 0; a < 2; ++a) _Pragma("unroll") for (int b = 0; b < 2; ++b) _Pragma("unroll") for (int m = 0; m < 4; ++m) _Pragma("unroll") for (int n = 0; n < 2; ++n) acc[a][b][m][n] = (f32x4){0.f, 0.f, 0.f, 0.f}; } while (0)
#define PG8_RS_LOAD(un, par) do { if constexpr (Epi::RS_LDS) { if (wc == 0) { _Pragma("unroll") for (int _a = 0; _a < 2; ++_a) \
        __builtin_amdgcn_global_load_lds((const unsigned*)(E.rowss + (size_t)((un).pm * 256 + _a * 128 + wr * 64 + lane) * 4), (LAS unsigned*)(lds + RS_OFF + (par) * 4096 + wr * 2048 + _a * 1024), 16, 0, 0); } } } while (0)
#define PG8_CS_LOAD(un, par) do { if constexpr (Epi::CS_LDS) { if (wid == 1) \
        __builtin_amdgcn_global_load_lds((const unsigned*)(E.cs_ptr(un) + 4 * lane), (LAS unsigned*)(lds + CS_OFF + (par) * 1024), 16, 0, 0); } } while (0)
    Unit cur, nxt; int ui = 0;
    if (!S.next(0, cur)) return;
    if (ZERO) PG8_ZERO_ACC();
    PG8_RS_LOAD(cur, 0); PG8_CS_LOAD(cur, 0);
    bf16x8 At[4][2], B0[2][2], B1[2][2];
    const char* cA = (const char*)g.A + (size_t)cur.sub * g.sA + (size_t)cur.pm * tstep; const char* cB = (const char*)g.Bt + (size_t)cur.sub * g.sB + (size_t)cur.pn * tstep;
    if constexpr (SP2) {
        PG8_STAGE(PG8_SB(0, 0), cB, voffB); PG8_STAGE(PG8_SB(0, 1), cB + hstep, voffB); PG8_STAGE(PG8_SA(0, 0), cA, voffA); PG8_STAGE(PG8_SA(0, 1), cA + hstep, voffA);
        if (wr == 1) PG8_BAR;
        PG8_WAIT_V(2); PG8_BAR;
        PG8_STAGE(PG8_SB(1, 0), cB + kstep, voffB); PG8_STAGE(PG8_SA(1, 0), cA + kstep, voffA); PG8_STAGE(PG8_SB(1, 1), cB + hstep + kstep, voffB);
        PG8_WAIT_V(6); PG8_BAR;
    } else {
        PG8_STAGE(PG8_SB(0, 0), cB, voffB); PG8_STAGE(PG8_SA(0, 0), cA, voffA); PG8_STAGE(PG8_SB(0, 1), cB + hstep, voffB); PG8_STAGE(PG8_SA(0, 1), cA + hstep, voffA);
        if (wr == 1) PG8_BAR;
        PG8_WAIT_V(4); PG8_BAR;
        PG8_STAGE(PG8_SB(1, 0), cB + kstep, voffB); PG8_STAGE(PG8_SA(1, 0), cA + kstep, voffA); PG8_STAGE(PG8_SB(1, 1), cB + hstep + kstep, voffB);
        PG8_WAIT_V(6); PG8_BAR;
    }
    for (;;) {
        const bool has_next = S.next(ui + 1, nxt);
        const char* nA = has_next ? (const char*)g.A + (size_t)nxt.sub * g.sA + (size_t)nxt.pm * tstep : cA; const char* nB = has_next ? (const char*)g.Bt + (size_t)nxt.sub * g.sB + (size_t)nxt.pn * tstep : cB;
        const bool do0 = !HALF_OK || cur.half != 2, do1 = !HALF_OK || cur.half != 1;
#pragma unroll 1
        for (int t = 0; t < nt; t += 2) {
            const bool last = (t == nt - 2);
            const char* a1 = cA + (size_t)(t + 1) * kstep;
            const char* a2 = last ? nA : cA + (size_t)(t + 2) * kstep; const char* b2 = last ? nB : cB + (size_t)(t + 2) * kstep;
            const char* a3 = a2 + kstep; const char* b3 = b2 + kstep;
            if constexpr (SP2) {
            PG8_LDB(B0, 0, 0); PG8_LDB(B1, 0, 1); PG8_SCHED; if (do0) PG8_LDA(At, 0, 0); PG8_STAGE(PG8_SA(1, 1), a1 + hstep, voffA);
            PG8_WAIT_V(8); PG8_WAIT_L(0); PG8_BAR; if (do0) { PG8_MMA(0, 0, At, B0); PG8_MMA(0, 1, At, B1); } PG8_BAR; PG8_SCHED;
            if (do1) PG8_LDA(At, 0, 1); PG8_STAGE(PG8_SB(0, 0), b2, voffB); PG8_STAGE(PG8_SB(0, 1), b2 + hstep, voffB); PG8_STAGE(PG8_SA(0, 0), a2, voffA);
            PG8_WAIT_V(8); PG8_WAIT_L(0); PG8_BAR; if (do1) { PG8_MMA(1, 0, At, B0); PG8_MMA(1, 1, At, B1); } PG8_BAR; PG8_SCHED;
            PG8_LDB(B0, 1, 0); PG8_LDB(B1, 1, 1); PG8_SCHED; if (do0) PG8_LDA(At, 1, 0); PG8_STAGE(PG8_SA(0, 1), a2 + hstep, voffA);
            PG8_WAIT_V(8); PG8_WAIT_L(0); PG8_BAR; if (do0) { PG8_MMA(0, 0, At, B0); PG8_MMA(0, 1, At, B1); } PG8_BAR; PG8_SCHED;
            if (do1) PG8_LDA(At, 1, 1); PG8_STAGE(PG8_SB(1, 0), b3, voffB); PG8_STAGE(PG8_SB(1, 1), b3 + hstep, voffB); PG8_STAGE(PG8_SA(1, 0), a3, voffA);
            PG8_WAIT_V(8); PG8_WAIT_L(0); PG8_BAR; if (do1) { PG8_MMA(1, 0, At, B0); PG8_MMA(1, 1, At, B1); } PG8_BAR; PG8_SCHED;
            } else {
            PG8_LDB(B0, 0, 0); PG8_SCHED; PG8_LDA(At, 0, 0); PG8_STAGE(PG8_SA(1, 1), a1 + hstep, voffA);
            PG8_WAIT_L(8); PG8_BAR; PG8_WAIT_L(0); PG8_MMA(0, 0, At, B0); PG8_BAR; PG8_SCHED;
            PG8_LDB(B1, 0, 1); PG8_STAGE(PG8_SB(0, 0), b2, voffB);
            PG8_BAR; PG8_WAIT_L(0); PG8_MMA(0, 1, At, B1); PG8_BAR;
            PG8_LDA(At, 0, 1); PG8_STAGE(PG8_SA(0, 0), a2, voffA);
            PG8_BAR; PG8_WAIT_L(0); PG8_MMA(1, 0, At, B0); PG8_BAR; PG8_SCHED;
            PG8_STAGE(PG8_SB(0, 1), b2 + hstep, voffB);
            PG8_WAIT_V(6); PG8_BAR; PG8_MMA(1, 1, At, B1); PG8_BAR;
            PG8_LDB(B0, 1, 0); PG8_SCHED; PG8_LDA(At, 1, 0); PG8_STAGE(PG8_SA(0, 1), a2 + hstep, voffA);
            PG8_WAIT_L(8); PG8_BAR; PG8_WAIT_L(0); PG8_MMA(0, 0, At, B0); PG8_BAR; PG8_SCHED;
            PG8_LDB(B1, 1, 1); PG8_STAGE(PG8_SB(1, 0), b3, voffB);
            PG8_BAR; PG8_WAIT_L(0); PG8_MMA(0, 1, At, B1); PG8_BAR;
            PG8_LDA(At, 1, 1); PG8_STAGE(PG8_SA(1, 0), a3, voffA);
            PG8_BAR; PG8_WAIT_L(0); PG8_MMA(1, 0, At, B0); PG8_BAR; PG8_SCHED;
            PG8_STAGE(PG8_SB(1, 1), b3 + hstep, voffB);
            PG8_WAIT_V(6); PG8_BAR; PG8_MMA(1, 1, At, B1); PG8_BAR;
            }
        }
        if constexpr (ALIGN_EPI) { if (wr == 0) PG8_BAR; }
        if constexpr (Epi::RS_LDS) E.rsl = (LAS const float*)(lds + RS_OFF + (ui & 1) * 4096 + wr * 2048);
        if constexpr (Epi::CS_LDS) E.csl = (LAS const float*)(lds + CS_OFF + (ui & 1) * 1024);
        const bool keep = E(acc, cur, wr, wc, fr, fq);
        if (!has_next) break;
        if (!keep) PG8_ZERO_ACC();
        cur = nxt; cA = nA; cB = nB; ++ui;
        PG8_RS_LOAD(cur, ui & 1); PG8_CS_LOAD(cur, ui & 1);
        if constexpr (ALIGN_EPI) { if (wr == 1) PG8_BAR; }
    }
    PG8_WAIT_V(0);
    if constexpr (!ALIGN_EPI) { if (wr == 0) PG8_BAR; }
    PG8_BAR;
#undef PG8_SA
#undef PG8_SB
#undef PG8_STAGE
#undef PG8_LDA
#undef PG8_LDB
#undef PG8_MMA
#undef PG8_WAIT_V
#undef PG8_WAIT_L
#undef PG8_BAR
#undef PG8_SCHED
#undef PG8_ZERO_ACC
#undef PG8_RS_LOAD
#undef PG8_CS_LOAD
}
}

#define XB_TMO      128
#define XB_XCNT(j)  (256  + 64 * (j))
#define XB_XSUB(j)  (1280 + 64 * (j))
#define XB_XGEN(j)  (2304 + 64 * (j))
#define XB_TOP      3328
#define XB_TOPGEN   3392
#define XCD_BAR_WORDS 3456
#define XB_SPIN_CAP (1u << 18)
__device__ __forceinline__ unsigned xb_ld(unsigned* p)              { return __hip_atomic_load(p, __ATOMIC_RELAXED, __HIP_MEMORY_SCOPE_AGENT); }
__device__ __forceinline__ unsigned xb_add(unsigned* p, unsigned v) { return __hip_atomic_fetch_add(p, v, __ATOMIC_RELAXED, __HIP_MEMORY_SCOPE_AGENT); }
__device__ __forceinline__ unsigned xb_xcc_id() { return (unsigned)__builtin_amdgcn_s_getreg((3 << 11) | 20) & 0xFu; }
#define XB_SPIN(cond, bar) do { unsigned _sp = 0; while (cond) { __builtin_amdgcn_s_sleep(1); \
    if ((++_sp & 255u) == 0u) { if (xb_ld(&(bar)[XB_TMO])) break; if (_sp > XB_SPIN_CAP) { atomicAdd(&(bar)[XB_TMO], 1u); break; } } } } while (0)
__device__ __forceinline__ unsigned q8(float t) { return __builtin_bit_cast(unsigned, __builtin_amdgcn_fmed3f(t, -127.f, 127.f) + 12582912.f); }
struct EpiInProj {
    static constexpr bool PERM = true, RS_LDS = true, CS_LDS = false;
    LAS const float* rsl;
    const float* rowss; const unsigned* csT; const unsigned* gp;
    bf16_t *QA, *KA, *VA, *QC, *KC, *VC, *HY;
    __device__ __forceinline__ bool operator()(pg8::Acc& acc, const pg8::Unit& u, int wr, int wc, int fr, int fq) const {
        const int g = 4 * u.pn + wc;
        int kind, ld, hd, gty = 0; bf16_t* dst;
        if (g < 8)       { kind = 2; dst = QA; ld = 512; hd = g; gty = 0; }
        else if (g < 10) { kind = 1; dst = KA; ld = 128; hd = g - 8; gty = 1; }
        else if (g < 12) { kind = 0; dst = VA; ld = 128; hd = g - 10; }
        else if (g < 20) { kind = 2; dst = QC; ld = 512; hd = g - 12; gty = 2; }
        else if (g < 28) { kind = 1; dst = KC; ld = 512; hd = g - 20; gty = 3; }
        else if (g < 36) { kind = 0; dst = VC; ld = 512; hd = g - 28; }
        else             { kind = 0; dst = HY; ld = 1536; hd = g - 36; }
        const int col0 = 64 * hd + 8 * fq;
        const float qs = (kind == 2) ? QSCALE : 1.f;
        float rs8[8]; rows_rstd8_lds(rsl, fr, rs8);
        const int rowb = u.pm * 256 + wr * 64 + fr;
        if (kind == 0) {
#pragma unroll
            for (int ai = 0; ai < 2; ++ai)
#pragma unroll
                for (int m = 0; m < 4; ++m) {
                    const int row = rowb + ai * 128 + m * 16;
                    const float rstd = rs8[ai * 4 + m];
                    const f32x4 a0 = acc[ai][0][m][0] * rstd, a1 = acc[ai][0][m][1] * rstd, b0 = acc[ai][1][m][0] * rstd, b1 = acc[ai][1][m][1] * rstd;
                    u32x4 wa, wb;
                    wa.x = pk2(a0[0], a0[1]); wa.y = pk2(a0[2], a0[3]); wa.z = pk2(a1[0], a1[1]); wa.w = pk2(a1[2], a1[3]);
                    wb.x = pk2(b0[0], b0[1]); wb.y = pk2(b0[2], b0[3]); wb.z = pk2(b1[0], b1[1]); wb.w = pk2(b1[2], b1[3]);
                    if (g >= 36) {
                        bf16_t* rp = dst + ((size_t)(8 * hd + fq) * MTOK + row) * 8;
                        *(u32x4*)rp = wa; *(u32x4*)(rp + (size_t)4 * MTOK * 8) = wb;
                    } else {
                        bf16_t* rp = dst + (size_t)row * ld + col0;
                        *(u32x4*)rp = wa; *(u32x4*)(rp + 32) = wb;
                    }
                }
        } else {
            const u32x4 gq0 = *(const u32x4*)(gp + gty * 32 + 8 * fq), gq1 = *(const u32x4*)(gp + gty * 32 + 8 * fq + 4);
            u32x4 cs[2][2];
            { const unsigned* cp = csT + (rowb & (SEQ - 1)) * 32 + 8 * fq; cs[0][0] = *(const u32x4*)cp; cs[0][1] = *(const u32x4*)(cp + 4); }
#pragma unroll
            for (int it = 0; it < 8; ++it) {
                const int ai = it >> 2, m = it & 3;
                const int row = rowb + ai * 128 + m * 16;
                if (it + 1 < 8) { const int nrow = rowb + ((it + 1) >> 2) * 128 + ((it + 1) & 3) * 16; const unsigned* cp = csT + (nrow & (SEQ - 1)) * 32 + 8 * fq;
                    cs[(it + 1) & 1][0] = *(const u32x4*)cp; cs[(it + 1) & 1][1] = *(const u32x4*)(cp + 4); }
                const float rstd = rs8[it];
                float ss = 0.f;
#pragma unroll
                for (int n = 0; n < 2; ++n)
#pragma unroll
                    for (int i = 0; i < 4; ++i) { const float x = acc[ai][0][m][n][i], y = acc[ai][1][m][n][i]; ss += x * x + y * y; }
                ss += __shfl_xor(ss, 16); ss += __shfl_xor(ss, 32);
                const float f = rstd * rsqrtf(ss * rstd * rstd * (1.f / 64.f) + RMS_EPS) * qs;
                u32x4 wa, wb;
#pragma unroll
                for (int n = 0; n < 2; ++n) {
                    const u32x4 gq = n ? gq1 : gq0, cq = cs[it & 1][n];
                    float ra[4], rb[4];
#pragma unroll
                    for (int i = 0; i < 4; ++i) {
                        const float ga = (float)__builtin_bit_cast(_Float16, (unsigned short)(gq[i] & 0xffffu)), gb = (float)__builtin_bit_cast(_Float16, (unsigned short)(gq[i] >> 16));
                        const float c = (float)__builtin_bit_cast(_Float16, (unsigned short)(cq[i] & 0xffffu)), sn = (float)__builtin_bit_cast(_Float16, (unsigned short)(cq[i] >> 16));
                        const float x = acc[ai][0][m][n][i] * (f * ga), y = acc[ai][1][m][n][i] * (f * gb);
                        ra[i] = x * c - y * sn; rb[i] = y * c + x * sn;
                    }
                    if (n == 0) { wa.x = pk2(ra[0], ra[1]); wa.y = pk2(ra[2], ra[3]); wb.x = pk2(rb[0], rb[1]); wb.y = pk2(rb[2], rb[3]); }
                    else        { wa.z = pk2(ra[0], ra[1]); wa.w = pk2(ra[2], ra[3]); wb.z = pk2(rb[0], rb[1]); wb.w = pk2(rb[2], rb[3]); }
                }
                bf16_t* rp = dst + (size_t)row * ld + col0;
                *(u32x4*)rp = wa; *(u32x4*)(rp + 32) = wb;
                asm volatile("" ::: "memory");
            }
        }
        return false;
    }
};

#ifndef MERGE_PD
#define MERGE_PD 2
#endif
__device__ __forceinline__ unsigned gate_q(float a) {
    const float t = __builtin_amdgcn_fmed3f(__builtin_fmaf(__builtin_amdgcn_exp2f(a), 1.f / 255.f, 1.f / 255.f), 0.f, 1.f);
    return __builtin_bit_cast(unsigned, __builtin_amdgcn_rcpf(t) + 8388608.f);
}
__device__ __forceinline__ unsigned pack_b0(unsigned u0, unsigned u1, unsigned u2, unsigned u3) {
    return __builtin_amdgcn_perm(__builtin_amdgcn_perm(u3, u2, 0x0c0c0400u), __builtin_amdgcn_perm(u1, u0, 0x0c0c0400u), 0x05040100u);
}
struct EpiGate {
    static constexpr bool PERM = true, RS_LDS = true, CS_LDS = true;
    LAS const float* rsl; LAS const float* csl;
    int tid; const float* rowss; const float* cs; u32x4* scr0;
    __device__ __forceinline__ const float* cs_ptr(const pg8::Unit& u) const { return cs + u.sub * DM + u.pn * 256; }
    __device__ __forceinline__ bool operator()(pg8::Acc& acc, const pg8::Unit& u, int wr, int wc, int fr, int fq) const {
        u32x4* scr = scr0 + ((size_t)(u.pm * 4 + u.pn) * 3 + u.sub) * 8 * 512 + tid;
        float rs8[8];
#pragma unroll
        for (int k = 0; k < 8; ++k) rs8[k] = rsl[(k >> 2) * 256 + ((k & 3) * 16 + fr) * 4];
        f32x4 cq[2][2];
#pragma unroll
        for (int bj = 0; bj < 2; ++bj)
#pragma unroll
            for (int n = 0; n < 2; ++n) cq[bj][n] = *(const LAS f32x4*)(csl + bj * 128 + wc * 32 + 8 * fq + 4 * n) * (-LOG2E);
#pragma unroll
        for (int ai = 0; ai < 2; ++ai)
#pragma unroll
            for (int m = 0; m < 4; ++m) {
                const float rs = rs8[ai * 4 + m];
                unsigned pw[4];
#pragma unroll
                for (int bj = 0; bj < 2; ++bj) {
                    const pg8::i32x4v i0 = __builtin_bit_cast(pg8::i32x4v, acc[ai][bj][m][0]), i1 = __builtin_bit_cast(pg8::i32x4v, acc[ai][bj][m][1]);
                    const f32x4 v0 = (f32x4){(float)i0[0], (float)i0[1], (float)i0[2], (float)i0[3]} * cq[bj][0], v1 = (f32x4){(float)i1[0], (float)i1[1], (float)i1[2], (float)i1[3]} * cq[bj][1];
                    pw[bj * 2] = pack_b0(gate_q(v0[0] * rs), gate_q(v0[1] * rs), gate_q(v0[2] * rs), gate_q(v0[3] * rs));
                    pw[bj * 2 + 1] = pack_b0(gate_q(v1[0] * rs), gate_q(v1[1] * rs), gate_q(v1[2] * rs), gate_q(v1[3] * rs));
                }
                u32x4 w; w.x = pw[0]; w.y = pw[1]; w.z = pw[2]; w.w = pw[3];
                scr[(size_t)(ai * 4 + m) * 512] = w;
            }
        return false;
    }
};
__device__ __forceinline__ float ub(unsigned w, int k) { return (float)((w >> (8 * k)) & 0xffu); }
struct EpiMerge {
    static constexpr bool PERM = true, RS_LDS = false, CS_LDS = false;
    static constexpr int PD = MERGE_PD;
    int tid; const u32x4* scr0; bf16_t* merged;
    __device__ __forceinline__ bool operator()(pg8::Acc& acc, const pg8::Unit& u, int wr, int wc, int fr, int fq) const {
        const int sub = u.sub;
        const u32x4* sa_p = scr0 + ((size_t)(u.pm * 4 + u.pn) * 3 + sub) * 8 * 512 + tid;
        u32x4 wa[8], wb[8];
#pragma unroll
        for (int it = 0; it < PD; ++it) { wa[it] = sa_p[(size_t)it * 512]; if (sub < 2) wb[it] = sa_p[(size_t)(8 + it) * 512]; }
#pragma unroll
        for (int it = 0; it < 8; ++it) {
            const int ai = it >> 2, m = it & 3;
            const int row = u.pm * 256 + ai * 128 + wr * 64 + m * 16 + fr;
            if (it + PD < 8) { wa[it + PD] = sa_p[(size_t)(it + PD) * 512]; if (sub < 2) wb[it + PD] = sa_p[(size_t)(8 + it + PD) * 512]; }
#pragma unroll
            for (int bj = 0; bj < 2; ++bj) {
                f32x4& v0 = acc[ai][bj][m][0]; f32x4& v1 = acc[ai][bj][m][1];
                const unsigned a0 = bj ? wa[it].z : wa[it].x, a1 = bj ? wa[it].w : wa[it].y;
                if (sub < 2) {
                    const unsigned b0 = bj ? wb[it].z : wb[it].x, b1 = bj ? wb[it].w : wb[it].y;
#pragma unroll
                    for (int i = 0; i < 4; ++i) { v0[i] *= ub(a0, i) * __builtin_amdgcn_rcpf(ub(b0, i)); v1[i] *= ub(a1, i) * __builtin_amdgcn_rcpf(ub(b1, i)); }
                } else {
                    constexpr float C = 1.f / 255.f;
                    u32x4 w; w.x = pk2(v0[0] * (ub(a0, 0) * C), v0[1] * (ub(a0, 1) * C)); w.y = pk2(v0[2] * (ub(a0, 2) * C), v0[3] * (ub(a0, 3) * C));
                    w.z = pk2(v1[0] * (ub(a1, 0) * C), v1[1] * (ub(a1, 1) * C)); w.w = pk2(v1[2] * (ub(a1, 2) * C), v1[3] * (ub(a1, 3) * C));
                    *(u32x4*)(merged + (size_t)row * DM + u.pn * 256 + bj * 128 + wc * 32 + 8 * fq) = w;
                }
            }
            asm volatile("" ::: "memory");
        }
        return sub < 2;
    }
};

template <bool FINAL> struct EpiResid {
    static constexpr bool PERM = true, RS_LDS = false, CS_LDS = false;
    bf16_t* xb; float* xout; float* rowss; bool dry; LAS float* red; int tid;
    unsigned char* xq; float* fct; unsigned long long* xslot; unsigned* xcnt; unsigned* bar; unsigned want;
    __device__ __forceinline__ bool operator()(pg8::Acc& acc, const pg8::Unit& u, int wr, int wc, int fr, int fq) const {
        if (dry) return false;
        const bool qz = !FINAL && xq != nullptr;
#pragma unroll
        for (int ai = 0; ai < 2; ++ai)
#pragma unroll
            for (int m = 0; m < 4; ++m) {
                const int row = u.pm * 256 + ai * 128 + wr * 64 + m * 16 + fr;
                float ss = 0.f, am = 0.f;
#pragma unroll
                for (int bj = 0; bj < 2; ++bj) {
                    const size_t off = (size_t)row * DM + u.pn * 256 + bj * 128 + wc * 32 + 8 * fq;
                    const u32x4 xo = *(const u32x4*)(xb + off);
                    const f32x4 a0 = acc[ai][bj][m][0], a1 = acc[ai][bj][m][1];
                    float xn[8] = {bflo(xo.x) + a0[0], bfhi(xo.x) + a0[1], bflo(xo.y) + a0[2], bfhi(xo.y) + a0[3], bflo(xo.z) + a1[0], bfhi(xo.z) + a1[1], bflo(xo.w) + a1[2], bfhi(xo.w) + a1[3]};
                    if (FINAL) {
                        *(f32x4*)(xout + off) = (f32x4){xn[0], xn[1], xn[2], xn[3]}; *(f32x4*)(xout + off + 4) = (f32x4){xn[4], xn[5], xn[6], xn[7]};
                    } else {
                        u32x4 w; w.x = pk2(xn[0], xn[1]); w.y = pk2(xn[2], xn[3]); w.z = pk2(xn[4], xn[5]); w.w = pk2(xn[6], xn[7]);
                        *(u32x4*)(xb + off) = w;
                        const float r[8] = {bflo(w.x), bfhi(w.x), bflo(w.y), bfhi(w.y), bflo(w.z), bfhi(w.z), bflo(w.w), bfhi(w.w)};
#pragma unroll
                        for (int i = 0; i < 8; ++i) { ss += r[i] * r[i]; am = fmaxf(am, fabsf(r[i])); }
                        acc[ai][bj][m][0] = (f32x4){r[0], r[1], r[2], r[3]}; acc[ai][bj][m][1] = (f32x4){r[4], r[5], r[6], r[7]};
                    }
                }
                if (!FINAL) { ss += __shfl_xor(ss, 16); ss += __shfl_xor(ss, 32); am = fmaxf(am, __shfl_xor(am, 16)); am = fmaxf(am, __shfl_xor(am, 32));
                    if (fq == 0) { const int rl = ai * 128 + wr * 64 + m * 16 + fr; red[rl * 4 + wc] = ss; red[1024 + rl * 4 + wc] = am; } }
            }
        if (!FINAL) {
            asm volatile("s_waitcnt lgkmcnt(0)" ::: "memory"); __builtin_amdgcn_s_barrier(); asm volatile("" ::: "memory");
            if (tid < 256) { const f32x4 p = *(const LAS f32x4*)(red + tid * 4); const float st = (p[0] + p[1]) + (p[2] + p[3]);
                rowss[(size_t)(u.pm * 256 + tid) * 4 + u.pn] = st;
                if (qz) { const f32x4 a = *(const LAS f32x4*)(red + 1024 + tid * 4); const float at = fmaxf(fmaxf(a[0], a[1]), fmaxf(a[2], a[3]));
                    __hip_atomic_store(xslot + (size_t)(u.pm * 256 + tid) * 4 + u.pn, ((unsigned long long)__builtin_bit_cast(unsigned, at) << 32) | __builtin_bit_cast(unsigned, st), __ATOMIC_RELAXED, __HIP_MEMORY_SCOPE_AGENT); } }
            if (qz) {
                asm volatile("s_waitcnt vmcnt(0)" ::: "memory");
                if (tid < 256 && (tid & 63) == 0) (void)xb_add(xcnt + 16 * u.pm, 1u);
                if (tid == 0) XB_SPIN(xb_ld(xcnt + 16 * u.pm) < want, bar);
                asm volatile("s_waitcnt vmcnt(0) lgkmcnt(0)" ::: "memory"); __builtin_amdgcn_s_barrier(); asm volatile("" ::: "memory");
                if (tid < 256) {
                    const unsigned long long* sl = xslot + (size_t)(u.pm * 256 + tid) * 4; float st[4], at[4];
#pragma unroll
                    for (int t = 0; t < 4; ++t) { const unsigned long long w = __hip_atomic_load(sl + t, __ATOMIC_RELAXED, __HIP_MEMORY_SCOPE_AGENT); st[t] = __builtin_bit_cast(float, (unsigned)w); at[t] = __builtin_bit_cast(float, (unsigned)(w >> 32)); }
                    const float amax = fmaxf(fmaxf(at[0], at[1]), fmaxf(at[2], at[3]));
                    red[2048 + tid] = amax > 0.f ? 127.f / amax : 0.f;
                    if (u.pn == 0) *(f32x4*)(fct + (size_t)(u.pm * 256 + tid) * 4) = (f32x4){rsqrtf(((st[0] + st[1]) + (st[2] + st[3])) * (1.f / DM) + RMS_EPS) * amax * (1.f / 127.f), 0.f, 0.f, 0.f};
                }
                asm volatile("s_waitcnt lgkmcnt(0)" ::: "memory"); __builtin_amdgcn_s_barrier(); asm volatile("" ::: "memory");
#pragma unroll
                for (int ai = 0; ai < 2; ++ai)
#pragma unroll
                    for (int m = 0; m < 4; ++m) {
                        const int rl = ai * 128 + wr * 64 + m * 16 + fr; const float sc = red[2048 + rl];
#pragma unroll
                        for (int bj = 0; bj < 2; ++bj) {
                            const f32x4 v0 = acc[ai][bj][m][0] * sc, v1 = acc[ai][bj][m][1] * sc;
                            *(u32x2*)(xq + (size_t)(u.pm * 256 + rl) * DM + u.pn * 256 + bj * 128 + wc * 32 + 8 * fq) = (u32x2){pack_b0(q8(v0[0]), q8(v0[1]), q8(v0[2]), q8(v0[3])), pack_b0(q8(v1[0]), q8(v1[1]), q8(v1[2]), q8(v1[3]))};
                        }
                    }
            }
            asm volatile("s_waitcnt lgkmcnt(0)" ::: "memory"); __builtin_amdgcn_s_barrier(); asm volatile("" ::: "memory");
        }
        return false;
    }
};

struct EpiSwiGLU {
    static constexpr bool PERM = true, RS_LDS = true, CS_LDS = true;
    LAS const float* rsl; LAS const float* csl;
    const float* rowss; const float* cs; bf16_t* act; bool dry;
    __device__ __forceinline__ const float* cs_ptr(const pg8::Unit& u) const { return cs + u.pn * 256; }
    __device__ __forceinline__ bool operator()(pg8::Acc& acc, const pg8::Unit& u, int wr, int wc, int fr, int fq) const {
        if (dry) return false;
        float rs8[8];
#pragma unroll
        for (int k = 0; k < 8; ++k) rs8[k] = rsl[(k >> 2) * 256 + ((k & 3) * 16 + fr) * 4];
        f32x4 cq[2][2];
#pragma unroll
        for (int bj = 0; bj < 2; ++bj)
#pragma unroll
            for (int n = 0; n < 2; ++n) cq[bj][n] = *(const LAS f32x4*)(csl + bj * 128 + wc * 32 + 8 * fq + 4 * n);
#pragma unroll
        for (int ai = 0; ai < 2; ++ai) {
            if (u.half == 2 - ai) continue;
#pragma unroll
            for (int m = 0; m < 4; ++m) {
                const int row = u.pm * 256 + ai * 128 + wr * 64 + m * 16 + fr;
                const float rstd = rs8[ai * 4 + m];
                float o[8];
#pragma unroll
                for (int n = 0; n < 2; ++n) {
                    const pg8::i32x4v ia = __builtin_bit_cast(pg8::i32x4v, acc[ai][0][m][n]), ib = __builtin_bit_cast(pg8::i32x4v, acc[ai][1][m][n]);
#pragma unroll
                    for (int i = 0; i < 4; ++i) {
                        const float a = (float)ia[i] * (rstd * cq[0][n][i]), b = (float)ib[i] * (rstd * cq[1][n][i]);
                        o[4 * n + i] = a * __builtin_amdgcn_rcpf(1.f + __builtin_amdgcn_exp2f(-a * LOG2E)) * b;
                    }
                }
                u32x4 w; w.x = pk2(o[0], o[1]); w.y = pk2(o[2], o[3]); w.z = pk2(o[4], o[5]); w.w = pk2(o[6], o[7]);
                *(u32x4*)(act + (size_t)row * DFF + u.pn * 128 + wc * 32 + 8 * fq) = w;
            }
        }
        return false;
    }
};

struct XcdBarrier { unsigned* bar; unsigned x; volatile LAS unsigned* st; };
__device__ __forceinline__ XcdBarrier xcd_barrier_post(unsigned* bar, volatile LAS unsigned* st) {
    XcdBarrier b; b.bar = bar; b.x = xb_xcc_id(); b.st = st;
    if (threadIdx.x == 0) (void)xb_add(&bar[XB_XCNT(b.x)], 1u);
    return b;
}
__device__ __forceinline__ void xcd_barrier_complete(unsigned* bar, unsigned x, unsigned& nloc, unsigned& nx) {
    const unsigned G = gridDim.x * gridDim.y * gridDim.z;
    unsigned sum, cnt, mine, sp = 0u;
    for (;;) {
        sum = 0u; cnt = 0u; mine = 0u;
#pragma unroll
        for (unsigned j = 0; j < 16; ++j) { const unsigned c = xb_ld(&bar[XB_XCNT(j)]); sum += c; cnt += (c > 0u) ? 1u : 0u; mine = (j == x) ? c : mine; }
        if (sum == G) break;
        __builtin_amdgcn_s_sleep(1);
        if ((++sp & 255u) == 0u) { if (xb_ld(&bar[XB_TMO])) break; if (sp > XB_SPIN_CAP) { atomicAdd(&bar[XB_TMO], 1u); break; } }
    }
    nloc = mine > 0u ? mine : 1u; nx = cnt > 0u ? cnt : 1u;
}
__device__ __forceinline__ void xcd_barrier(const XcdBarrier& b) {
    asm volatile("s_waitcnt vmcnt(0)" ::: "memory");
    __syncthreads();
    if (threadIdx.x == 0) {
        unsigned* bar = b.bar;
        __builtin_amdgcn_s_waitcnt(0);
        unsigned nloc = b.st[0], nx = b.st[1];
        if (nloc == 0u) { xcd_barrier_complete(bar, b.x, nloc, nx); b.st[0] = nloc; b.st[1] = nx; }
        const unsigned old = xb_add(&bar[XB_XSUB(b.x)], 1u);
        const unsigned gen = old / nloc;
        if (old + 1u == (gen + 1u) * nloc) {
            __builtin_amdgcn_fence(__ATOMIC_RELEASE, "agent");
            asm volatile("s_waitcnt vmcnt(0)" ::: "memory");
            const unsigned og = xb_add(&bar[XB_TOP], 1u);
            const unsigned tg = og / nx;
            if (og + 1u == (tg + 1u) * nx) xb_add(&bar[XB_TOPGEN], 1u);
            else XB_SPIN(xb_ld(&bar[XB_TOPGEN]) == tg, bar);
            __builtin_amdgcn_fence(__ATOMIC_ACQUIRE, "agent");
            xb_add(&bar[XB_XGEN(b.x)], 1u);
            asm volatile("s_waitcnt vmcnt(0)" ::: "memory");
        } else {
            XB_SPIN(xb_ld(&bar[XB_XGEN(b.x)]) == gen, bar);
            __builtin_amdgcn_fence(__ATOMIC_ACQUIRE, "agent");
            asm volatile("s_waitcnt vmcnt(0)" ::: "memory");
        }
    }
    __syncthreads();
}

#define FUSE_XQ(F) ((F).G == (MTOK / 256) * (DM / 256))
struct Frame {
    LAS unsigned char* lds;
    int tid, lane, wave, G, bid;
    bool dry;
    const Params* P;
};

template <bool WANTMAX = false>
__device__ __forceinline__ float transpose_item(const float* W, int N, int k0, int n0, bf16_t* WT, int K, int drow_lo, int drow_hi, const float* gain, LAS float* scr, int lane) {
    float mx = 0.f;
#pragma unroll
    for (int h = 0; h < 2; ++h) {
        f32x4 v[8];
#pragma unroll
        for (int i = 0; i < 8; ++i) { const int kk = 4 * (8 * h + i) + (lane >> 4); v[i] = __builtin_nontemporal_load((const f32x4*)(W + (size_t)(k0 + kk) * N + n0 + 4 * (lane & 15))); }
#pragma unroll
        for (int i = 0; i < 8; ++i) { const int kk = 4 * (8 * h + i) + (lane >> 4); f32x4 w = v[i]; if (gain) w = w * gain[k0 + kk];
            if (WANTMAX) mx = fmaxf(mx, fmaxf(fmaxf(fabsf(w[0]), fabsf(w[1])), fmaxf(fabsf(w[2]), fabsf(w[3]))));
            LAS float* d = scr + kk * 65 + 4 * (lane & 15); d[0] = w[0]; d[1] = w[1]; d[2] = w[2]; d[3] = w[3]; }
    }
    asm volatile("s_waitcnt lgkmcnt(0)" ::: "memory");
    const int c = lane & 7;
#pragma unroll
    for (int j = 0; j < 8; ++j) { const int n = (lane >> 3) + 8 * j; const LAS float* s = scr + (8 * c) * 65 + n;
        u32x4 o; o.x = pk2(s[0 * 65], s[1 * 65]); o.y = pk2(s[2 * 65], s[3 * 65]); o.z = pk2(s[4 * 65], s[5 * 65]); o.w = pk2(s[6 * 65], s[7 * 65]);
        const int drow = (n < 32) ? drow_lo + n : drow_hi + n - 32;
        *(u32x4*)(WT + (size_t)drow * K + k0 + 8 * c) = o; }
    asm volatile("s_waitcnt lgkmcnt(0)" ::: "memory");
    return mx;
}
__device__ __forceinline__ float absmax_item(const float* W, int N, int k0, int n0, const float* gain, int lane) {
    float mx = 0.f;
#pragma unroll
    for (int h = 0; h < 2; ++h) {
        f32x4 v[8];
#pragma unroll
        for (int i = 0; i < 8; ++i) { const int kk = 4 * (8 * h + i) + (lane >> 4); v[i] = *(const f32x4*)(W + (size_t)(k0 + kk) * N + n0 + 4 * (lane & 15)); }
#pragma unroll
        for (int i = 0; i < 8; ++i) { const int kk = 4 * (8 * h + i) + (lane >> 4); const float g = fabsf(gain[k0 + kk]);
            mx = fmaxf(mx, g * fmaxf(fmaxf(fabsf(v[i][0]), fabsf(v[i][1])), fmaxf(fabsf(v[i][2]), fabsf(v[i][3])))); }
    }
#pragma unroll
    for (int o = 32; o > 0; o >>= 1) mx = fmaxf(mx, __shfl_xor(mx, o));
    return mx;
}
__device__ __forceinline__ void transpose_item_i8(const float* W, int N, int k0, int n0, unsigned char* WT8, int K, int drow0, const float* gain, float scale, LAS float* scr, int lane) {
#pragma unroll
    for (int h = 0; h < 2; ++h) {
        f32x4 v[8];
#pragma unroll
        for (int i = 0; i < 8; ++i) { const int kk = 4 * (8 * h + i) + (lane >> 4); v[i] = __builtin_nontemporal_load((const f32x4*)(W + (size_t)(k0 + kk) * N + n0 + 4 * (lane & 15))); }
#pragma unroll
        for (int i = 0; i < 8; ++i) { const int kk = 4 * (8 * h + i) + (lane >> 4); const f32x4 w = v[i] * (gain[k0 + kk] * scale);
            LAS float* d = scr + kk * 65 + 4 * (lane & 15); d[0] = w[0]; d[1] = w[1]; d[2] = w[2]; d[3] = w[3]; }
    }
    asm volatile("s_waitcnt lgkmcnt(0)" ::: "memory");
    const int c = lane & 7;
#pragma unroll
    for (int j = 0; j < 8; ++j) { const int n = (lane >> 3) + 8 * j; const LAS float* s = scr + (8 * c) * 65 + n;
        const unsigned lo = pack_b0(q8(s[0 * 65]), q8(s[1 * 65]), q8(s[2 * 65]), q8(s[3 * 65])), hi = pack_b0(q8(s[4 * 65]), q8(s[5 * 65]), q8(s[6 * 65]), q8(s[7 * 65]));
        *(u32x2*)(WT8 + (size_t)(drow0 + n) * K + k0 + 8 * c) = (u32x2){lo, hi}; }
    asm volatile("s_waitcnt lgkmcnt(0)" ::: "memory");
}
__device__ __forceinline__ void colgroup_i8(const Frame& F, const float* W, int N, int n0, unsigned char* WT8, int drow_lo, int drow_hi, const float* gain, float* cscale) {
    LAS float* scr = (LAS float*)(F.lds + F.wave * 16640);
    LAS float* cmx = (LAS float*)(F.lds + 8 * 16640);
    const int lane = F.lane, wave = F.wave;
    float cm[4] = {0.f, 0.f, 0.f, 0.f};
#pragma unroll 1
    for (int b = 0; b < 2; ++b) { const int k0 = 64 * (2 * wave + b);
#pragma unroll
        for (int h = 0; h < 2; ++h) {
            f32x4 v[8];
#pragma unroll
            for (int i = 0; i < 8; ++i) { const int kk = 4 * (8 * h + i) + (lane >> 4); v[i] = *(const f32x4*)(W + (size_t)(k0 + kk) * N + n0 + 4 * (lane & 15)); }
#pragma unroll
            for (int i = 0; i < 8; ++i) { const int kk = 4 * (8 * h + i) + (lane >> 4); const float g = fabsf(gain[k0 + kk]);
#pragma unroll
                for (int j = 0; j < 4; ++j) cm[j] = fmaxf(cm[j], g * fabsf(v[i][j])); }
        }
    }
#pragma unroll
    for (int j = 0; j < 4; ++j) { cm[j] = fmaxf(cm[j], __shfl_xor(cm[j], 16)); cm[j] = fmaxf(cm[j], __shfl_xor(cm[j], 32)); }
    if (lane < 16) *(LAS f32x4*)(cmx + wave * 64 + 4 * lane) = (f32x4){cm[0], cm[1], cm[2], cm[3]};
    asm volatile("s_waitcnt lgkmcnt(0)" ::: "memory"); __syncthreads();
    f32x4 mxv = *(const LAS f32x4*)(cmx + 4 * (lane & 15));
#pragma unroll
    for (int w = 1; w < 8; ++w) { const f32x4 t = *(const LAS f32x4*)(cmx + w * 64 + 4 * (lane & 15)); mxv = (f32x4){fmaxf(mxv[0], t[0]), fmaxf(mxv[1], t[1]), fmaxf(mxv[2], t[2]), fmaxf(mxv[3], t[3])}; }
    float sc[4];
#pragma unroll
    for (int j = 0; j < 4; ++j) sc[j] = mxv[j] > 0.f ? 127.f / mxv[j] : 0.f;
    if (wave == 0 && lane < 16) {
#pragma unroll
        for (int j = 0; j < 4; ++j) { const int n = 4 * lane + j; cscale[n < 32 ? drow_lo + n : drow_hi + n - 32] = mxv[j] * (1.f / 127.f); } }
#pragma unroll 1
    for (int b = 0; b < 2; ++b) { const int k0 = 64 * (2 * wave + b);
#pragma unroll
        for (int h = 0; h < 2; ++h) {
            f32x4 v[8];
#pragma unroll
            for (int i = 0; i < 8; ++i) { const int kk = 4 * (8 * h + i) + (lane >> 4); v[i] = __builtin_nontemporal_load((const f32x4*)(W + (size_t)(k0 + kk) * N + n0 + 4 * (lane & 15))); }
#pragma unroll
            for (int i = 0; i < 8; ++i) { const int kk = 4 * (8 * h + i) + (lane >> 4); const float g = gain[k0 + kk];
                LAS float* d = scr + kk * 65 + 4 * (lane & 15); d[0] = v[i][0] * (g * sc[0]); d[1] = v[i][1] * (g * sc[1]); d[2] = v[i][2] * (g * sc[2]); d[3] = v[i][3] * (g * sc[3]); }
        }
        asm volatile("s_waitcnt lgkmcnt(0)" ::: "memory");
        const int c = lane & 7;
#pragma unroll
        for (int j = 0; j < 8; ++j) { const int n = (lane >> 3) + 8 * j; const LAS float* s = scr + (8 * c) * 65 + n;
            const unsigned lo = pack_b0(q8(s[0 * 65]), q8(s[1 * 65]), q8(s[2 * 65]), q8(s[3 * 65])), hi = pack_b0(q8(s[4 * 65]), q8(s[5 * 65]), q8(s[6 * 65]), q8(s[7 * 65]));
            *(u32x2*)(WT8 + (size_t)(n < 32 ? drow_lo + n : drow_hi + n - 32) * DM + k0 + 8 * c) = (u32x2){lo, hi}; }
        asm volatile("s_waitcnt lgkmcnt(0)" ::: "memory");
    }
    __syncthreads();
}
__device__ __forceinline__ int inproj_base(int g) {
    if (g < 8) return 64 * g;
    if (g < 10) return 512 + 64 * (g - 8);
    if (g < 12) return 640 + 64 * (g - 10);
    if (g < 20) return 2304 + 64 * (g - 12);
    if (g < 28) return 2816 + 64 * (g - 20);
    if (g < 36) return 3328 + 64 * (g - 28);
    return 768 + 64 * (g - 36);
}
__device__ __forceinline__ void p0_weights(const Frame& F, int l) {
    const Params& P = *F.P;
    LAS float* scr = (LAS float*)(F.lds + F.wave * 16640);
    const int gw = F.bid * 8 + F.wave, NGW = F.G * 8;
    unsigned char* ws = P.ws + opaque_zero();
    const float* w_in = P.in[I_WIN] + (size_t)l * DM * INC;
    const float* n1g = P.in[I_N1G] + l * DM; const float* n2g = P.in[I_N2G] + l * DM;
    constexpr int NCG = 48 + 88;
    for (int it = F.G - 1 - F.bid; it < NCG; it += F.G) {
        if (it < 48) colgroup_i8(F, w_in, INC, NMAIN + 64 * it, ws + W_IN + (size_t)NMAIN * DM * 2, 64 * it, 64 * it + 32, n1g, (float*)(ws + CS_G));
        else { const int r = it - 48, which = r / 44, c = 64 * (r % 44), d0 = 256 * (c >> 7) + 128 * which + (c & 127);
            colgroup_i8(F, P.in[which ? I_FFW3 : I_FFW1] + (size_t)l * DM * DFF, DFF, c, ws + W_13, d0, d0 + 32, n2g, (float*)(ws + CS_13)); }
    }
    constexpr int N1 = 60 * 16, N2 = 0, N3 = 3 * 128, N4 = 256, N5 = 0, N6 = 44 * 16;
    constexpr int NIT = N1 + N2 + N3 + N4 + N5 + N6;
    for (int it = gw; it < NIT; it += NGW) {
        int r = it;
        if (r < N1) { const int g = r / 16, kb = r % 16; const int d0 = 256 * (g >> 2) + 32 * (g & 3);
            transpose_item(w_in, INC, 64 * kb, inproj_base(g), (bf16_t*)(ws + W_IN), DM, d0, d0 + 128, n1g, scr, F.lane); continue; }
        r -= N1;
        r -= N2;
        if (r < N3) { const int w = r / 128, q = r % 128, cb = q / 8, kb = q % 8;
            const float* src = P.in[I_WOA + w] + (size_t)l * 512 * DM;
            transpose_item(src, DM, 64 * kb, 64 * cb, (bf16_t*)(ws + W_OA) + (size_t)w * DM * 512, 512, 64 * cb, 64 * cb + 32, nullptr, scr, F.lane); continue; }
        r -= N3;
        if (r < N4) { const int cb = r / 16, kb = r % 16;
            transpose_item(P.in[I_WOUT] + (size_t)l * DM * DM, DM, 64 * kb, 64 * cb, (bf16_t*)(ws + W_OUT), DM, 64 * cb, 64 * cb + 32, nullptr, scr, F.lane); continue; }
        r -= N4;
        r -= N5;
        { const int cb = r / 44, kb = r % 44;
            transpose_item(P.in[I_FFW2] + (size_t)l * DFF * DM, DM, 64 * kb, 64 * cb, (bf16_t*)(ws + W_2), DFF, 64 * cb, 64 * cb + 32, nullptr, scr, F.lane); }
    }
}
__device__ __forceinline__ void p0_misc(const Frame& F) {
    const Params& P = *F.P;
    unsigned char* ws = P.ws + opaque_zero();
    const int gw = F.bid * 8 + F.wave, NGW = F.G * 8, lane = F.lane;
    const int gt = F.bid * NTHREADS + F.tid, NGT = F.G * NTHREADS;
    float* rowssA = (float*)(ws + WS_ROWSSA);
    const float* x = P.in[I_X]; bf16_t* xb = (bf16_t*)(ws + WS_XB);
    for (int m = gw; m < MTOK; m += NGW) {
        const f32x4* xr = (const f32x4*)(x + (size_t)m * DM) + lane;
        float s = 0.f; f32x4 v[4];
#pragma unroll
        for (int j = 0; j < 4; ++j) { v[j] = __builtin_nontemporal_load(xr + 64 * j); s += v[j][0] * v[j][0] + v[j][1] * v[j][1] + v[j][2] * v[j][2] + v[j][3] * v[j][3]; }
        s = wave_sum(s);
        u32x2* o = (u32x2*)(xb + (size_t)m * DM) + lane;
        float mx = 0.f; u32x2 wv[4];
#pragma unroll
        for (int j = 0; j < 4; ++j) { u32x2 w; w.x = pk2(v[j][0], v[j][1]); w.y = pk2(v[j][2], v[j][3]); o[64 * j] = w; wv[j] = w;
            mx = fmaxf(mx, fmaxf(fmaxf(fabsf(bflo(w.x)), fabsf(bfhi(w.x))), fmaxf(fabsf(bflo(w.y)), fabsf(bfhi(w.y))))); }
        if (lane < 4) rowssA[(size_t)m * 4 + lane] = (lane == 0) ? s : 0.f;
#pragma unroll
        for (int o2 = 32; o2 > 0; o2 >>= 1) mx = fmaxf(mx, __shfl_xor(mx, o2));
        { const float sc = mx > 0.f ? 127.f / mx : 0.f; unsigned* q = (unsigned*)(ws + WS_XB8 + (size_t)m * DM) + lane;
#pragma unroll
          for (int j = 0; j < 4; ++j) q[64 * j] = pack_b0(q8(bflo(wv[j].x) * sc), q8(bfhi(wv[j].x) * sc), q8(bflo(wv[j].y) * sc), q8(bfhi(wv[j].y) * sc));
          if (lane == 0) *(f32x4*)((float*)(ws + CTL_FCTA) + (size_t)m * 4) = (f32x4){rsqrtf(s * (1.f / DM) + RMS_EPS) * mx * (1.f / 127.f), 0.f, 0.f, 0.f}; }
    }
    unsigned* csT = (unsigned*)(ws + CTL_COS);
    for (int i = gt; i < SEQ * 32; i += NGT) { const int pos = i >> 5, k = i & 31;
        const double inv = exp(-(double)k / 32.0 * log(10000.0)); const double ang = (double)pos * inv;
        const _Float16 ch = (_Float16)(float)cos(ang), sh = (_Float16)(float)sin(ang);
        csT[i] = (unsigned)__builtin_bit_cast(unsigned short, ch) | ((unsigned)__builtin_bit_cast(unsigned short, sh) << 16); }
    f32x2* tw = (f32x2*)(ws + CTL_TW);
    for (int i = gt; i < 2048; i += NGT) { float s, c; sincospif(-(float)i * (1.f / 2048.f), &s, &c); tw[i] = (f32x2){c, s}; }
    { unsigned* gp = (unsigned*)(ws + CTL_SIN);
      for (int i = gt; i < DEPTH * 4 * 32; i += NGT) { const int l = i >> 7, ty = (i >> 5) & 3, d = i & 31;
          const float* gsrc = P.in[ty == 0 ? I_QNA : (ty == 1 ? I_KNA : (ty == 2 ? I_QNC : I_KNC))] + l * 64;
          const _Float16 lo = (_Float16)gsrc[d], hi = (_Float16)gsrc[d + 32];
          gp[i] = (unsigned)__builtin_bit_cast(unsigned short, lo) | ((unsigned)__builtin_bit_cast(unsigned short, hi) << 16); } }
    if (gt < DEPTH) { const int l = gt; float a = 0.f, b = 0.f;
        for (int i = 0; i < 64; ++i) { a += P.in[I_LQ1][l * 64 + i] * P.in[I_LK1][l * 64 + i]; b += P.in[I_LQ2][l * 64 + i] * P.in[I_LK2][l * 64 + i]; }
        const float li = 0.8f - 0.6f * expf(-0.3f * (float)l);
        ((float*)(ws + CTL_LAM))[l] = expf(a) - expf(b) + li; }
    float* H2 = (float*)(ws + CTL_H2);
    for (int it = gw; it < DEPTH * SEQ; it += NGW) {
        const int l = it / SEQ, t = it % SEQ;
        const float* w1 = P.in[I_FW1] + l * 33 * 64; const float* w2 = P.in[I_FW2] + l * 64 * 64;
        const int band = (lane & 15) + 1; const int ph = (t * band) & 2047;
        float sv, cv; sincospif((float)ph * (1.f / 1024.f), &sv, &cv);
        float pre = P.in[I_FB1][l * 64 + lane] + ((float)t / (float)(SEQ - 1)) * w1[lane];
#pragma unroll
        for (int k = 0; k < 16; ++k) { pre += __shfl(cv, k) * w1[(1 + k) * 64 + lane]; pre += __shfl(sv, k) * w1[(17 + k) * 64 + lane]; }
        const float h1 = sinf(P.in[I_FF1][l * 64 + lane] * pre);
        float pre2 = P.in[I_FB2][l * 64 + lane];
        for (int j = 0; j < 64; ++j) pre2 += __shfl(h1, j) * w2[j * 64 + lane];
        ((bf16_t*)H2)[(size_t)it * 64 + lane] = f2bf(sinf(P.in[I_FF2][l * 64 + lane] * pre2));
    }
}

__device__ __forceinline__ f32x2 cmul(f32x2 a, f32x2 b) { return (f32x2){a.x * b.x - a.y * b.y, a.x * b.y + a.y * b.x}; }
__device__ __forceinline__ f32x2 cmulc(f32x2 a, f32x2 b) { return (f32x2){a.x * b.x + a.y * b.y, a.y * b.x - a.x * b.y}; }
__device__ __forceinline__ f32x2 mul_mi(f32x2 a) { return (f32x2){a.y, -a.x}; }
__device__ __forceinline__ f32x2 mul_pi(f32x2 a) { return (f32x2){-a.y, a.x}; }
constexpr float RS2 = 0.70710678118654752f;
__device__ __forceinline__ int pidx(int i) { return i + (i >> 3); }
struct Tw3 { f32x2 w1, w2, w3; };
struct TwF { f32x2 w1, s1, w2, s2, w3, s3; };
struct TwI { f32x2 c1, t1, c2, t2, c3, t3; };
__device__ __forceinline__ f32x2 cm2(f32x2 a, f32x2 w, f32x2 s) { const f32x2 t = (f32x2){a.x, a.x} * w; return __builtin_elementwise_fma((f32x2){a.y, a.y}, s, t); }
__device__ __forceinline__ TwF tw_fwd(const Tw3& t) { return TwF{t.w1, (f32x2){-t.w1.y, t.w1.x}, t.w2, (f32x2){-t.w2.y, t.w2.x}, t.w3, (f32x2){-t.w3.y, t.w3.x}}; }
__device__ __forceinline__ TwI tw_inv(const Tw3& t) { return TwI{(f32x2){t.w1.x, -t.w1.y}, (f32x2){t.w1.y, t.w1.x}, (f32x2){t.w2.x, -t.w2.y}, (f32x2){t.w2.y, t.w2.x}, (f32x2){t.w3.x, -t.w3.y}, (f32x2){t.w3.y, t.w3.x}}; }
template <bool UNIT> __device__ __forceinline__ void r8_fwd(f32x2 (&v)[8], const TwF& T) {
    {
        f32x2 d0 = v[0] - v[4], d1 = v[1] - v[5], d2 = v[2] - v[6], d3 = v[3] - v[7];
        v[0] = v[0] + v[4]; v[1] = v[1] + v[5]; v[2] = v[2] + v[6]; v[3] = v[3] + v[7];
        d1 = (f32x2){(d1.x + d1.y) * RS2, (d1.y - d1.x) * RS2};
        d2 = mul_mi(d2);
        d3 = (f32x2){(d3.y - d3.x) * RS2, -(d3.x + d3.y) * RS2};
        if (UNIT) { v[4] = d0; v[5] = d1; v[6] = d2; v[7] = d3; }
        else { v[4] = cm2(d0, T.w1, T.s1); v[5] = cm2(d1, T.w1, T.s1); v[6] = cm2(d2, T.w1, T.s1); v[7] = cm2(d3, T.w1, T.s1); }
    }
#pragma unroll
    for (int q = 0; q < 8; q += 4) {
        const f32x2 d0 = v[q] - v[q + 2], d1 = mul_mi(v[q + 1] - v[q + 3]);
        v[q] = v[q] + v[q + 2]; v[q + 1] = v[q + 1] + v[q + 3];
        if (UNIT) { v[q + 2] = d0; v[q + 3] = d1; } else { v[q + 2] = cm2(d0, T.w2, T.s2); v[q + 3] = cm2(d1, T.w2, T.s2); }
    }
#pragma unroll
    for (int q = 0; q < 8; q += 2) { const f32x2 d = v[q] - v[q + 1]; v[q] = v[q] + v[q + 1]; v[q + 1] = UNIT ? d : cm2(d, T.w3, T.s3); }
}
template <bool UNIT> __device__ __forceinline__ void r8_inv(f32x2 (&v)[8], const TwI& T) {
#pragma unroll
    for (int q = 0; q < 8; q += 2) { const f32x2 b = UNIT ? v[q + 1] : cm2(v[q + 1], T.c3, T.t3), a = v[q]; v[q] = a + b; v[q + 1] = a - b; }
#pragma unroll
    for (int q = 0; q < 8; q += 4) {
        const f32x2 b0 = UNIT ? v[q + 2] : cm2(v[q + 2], T.c2, T.t2), b1 = mul_pi(UNIT ? v[q + 3] : cm2(v[q + 3], T.c2, T.t2)), a0 = v[q], a1 = v[q + 1];
        v[q] = a0 + b0; v[q + 2] = a0 - b0; v[q + 1] = a1 + b1; v[q + 3] = a1 - b1;
    }
    {
        const f32x2 b0 = UNIT ? v[4] : cm2(v[4], T.c1, T.t1); f32x2 b1 = UNIT ? v[5] : cm2(v[5], T.c1, T.t1); const f32x2 b2 = mul_pi(UNIT ? v[6] : cm2(v[6], T.c1, T.t1)); f32x2 b3 = UNIT ? v[7] : cm2(v[7], T.c1, T.t1);
        b1 = (f32x2){(b1.x - b1.y) * RS2, (b1.x + b1.y) * RS2};
        b3 = (f32x2){-(b3.x + b3.y) * RS2, (b3.x - b3.y) * RS2};
        const f32x2 a0 = v[0], a1 = v[1], a2 = v[2], a3 = v[3];
        v[0] = a0 + b0; v[4] = a0 - b0; v[1] = a1 + b1; v[5] = a1 - b1; v[2] = a2 + b2; v[6] = a2 - b2; v[3] = a3 + b3; v[7] = a3 - b3;
    }
}
__device__ __forceinline__ void wave_lds_sync() { asm volatile("s_waitcnt lgkmcnt(0)" ::: "memory"); }
struct FftTw { Tw3 w512, w64, w8; };
__device__ __forceinline__ Tw3 tw3_make(int e) {
    Tw3 t; float s, c;
    sincospif(-(float)e * (1.f / 2048.f), &s, &c); t.w1 = (f32x2){c, s};
    sincospif(-(float)(2 * e) * (1.f / 2048.f), &s, &c); t.w2 = (f32x2){c, s};
    sincospif(-(float)(4 * e) * (1.f / 2048.f), &s, &c); t.w3 = (f32x2){c, s};
    return t;
}
__device__ __forceinline__ FftTw fft_twiddles(int tid) { FftTw t; t.w512 = tw3_make(tid); t.w64 = tw3_make(8 * (tid & 63)); t.w8 = tw3_make(64 * (tid & 7)); return t; }
template <int SP> __device__ __forceinline__ int fft_base(int tid) { return (tid / SP) * 8 * SP + (tid & (SP - 1)); }
template <int SP> __device__ __forceinline__ void fft_ld(const LAS f32x2* X, int tid, f32x2 (&v)[8]) {
    const int base = fft_base<SP>(tid);
#pragma unroll
    for (int j = 0; j < 8; ++j) v[j] = X[pidx(base + j * SP)];
}
template <int SP> __device__ __forceinline__ void fft_st(LAS f32x2* X, int tid, const f32x2 (&v)[8]) {
    const int base = fft_base<SP>(tid);
#pragma unroll
    for (int j = 0; j < 8; ++j) X[pidx(base + j * SP)] = v[j];
}
template <int SP> __device__ __forceinline__ void fft_pass_fwd(LAS f32x2* X, int tid, const Tw3& w) { const TwF T = tw_fwd(w); f32x2 v[8]; fft_ld<SP>(X, tid, v); r8_fwd<false>(v, T); fft_st<SP>(X, tid, v); }
template <int SP> __device__ __forceinline__ void fft_pass_inv(LAS f32x2* X, int tid, const Tw3& w) { const TwI T = tw_inv(w); f32x2 v[8]; fft_ld<SP>(X, tid, v); r8_inv<false>(v, T); fft_st<SP>(X, tid, v); }

constexpr int HY_STG = 0, HY_STG_BYTES = 2 * 2050 * 16, HY_X = 65664, HY_X_BYTES = 4608 * 8, HY_RED = HY_X + HY_X_BYTES;
static_assert(HY_STG_BYTES <= HY_X && HY_X + 2 * HY_X_BYTES <= LDS_BARST, "hyena lds");

constexpr int HM_RS = 192, HM_PLANE = 32 * HM_RS, HM_STG = 0, HM_STG_BYTES = 16 * HM_PLANE;
constexpr int HM_FT = HM_STG_BYTES, HM_FRS = 136, HM_FTBL = 64 * HM_FRS;
constexpr int HM_WT = HM_FT + 3 * HM_FTBL, HM_END = HM_WT + 4096 * 4;
static_assert(HM_END + 128 <= LDS_BARST, "hyena mfma lds");
__device__ __forceinline__ bf16x8 hm_ld_tr(const LAS unsigned char* p) {
    const s16x4 lo4 = __builtin_amdgcn_ds_read_tr16_b64_v4i16((LAS s16x4*)p);
    const s16x4 hi4 = __builtin_amdgcn_ds_read_tr16_b64_v4i16((LAS s16x4*)(p + 4 * HM_RS));
    return (bf16x8){lo4[0], lo4[1], lo4[2], lo4[3], hi4[0], hi4[1], hi4[2], hi4[3]};
}
__device__ __forceinline__ bf16x8 hm_ld2(const LAS unsigned char* p, int off2) {
    const u32x2 a = *(const LAS u32x2*)p, b = *(const LAS u32x2*)(p + off2);
    return __builtin_bit_cast(bf16x8, (u32x4){a.x, a.y, b.x, b.y});
}
__device__ __forceinline__ bf16x8 hm_pack(const f32x16& t, int s) {
    u32x4 w; w.x = pk2(t[8 * s + 0], t[8 * s + 1]); w.y = pk2(t[8 * s + 2], t[8 * s + 3]); w.z = pk2(t[8 * s + 4], t[8 * s + 5]); w.w = pk2(t[8 * s + 6], t[8 * s + 7]);
    return __builtin_bit_cast(bf16x8, w);
}
#define HM_MFMA(a, b, c) __builtin_amdgcn_mfma_f32_32x32x16_bf16(a, b, c, 0, 0, 0)
struct HmF3 { bf16x8 r, i, n; };
__device__ __forceinline__ HmF3 hm_ldf(const LAS unsigned char* fp, int off2) { HmF3 f; f.r = hm_ld2(fp, off2); f.i = hm_ld2(fp + HM_FTBL, off2); f.n = hm_ld2(fp + 2 * HM_FTBL, off2); return f; }
__device__ __forceinline__ void hm_conv_wave(LAS unsigned char* lds, int lane, int ch, const f32x2* H) {
    const int r32 = lane & 31, h = lane >> 5;
    LAS unsigned char* PR = lds + HM_STG + (ch * 2) * HM_PLANE; LAS unsigned char* PI = PR + HM_PLANE;
    const LAS unsigned char* FT = lds + HM_FT; const LAS unsigned* WT = (const LAS unsigned*)(lds + HM_WT);
    f32x16 xr[2], xi[2];
#pragma unroll
    for (int nt = 0; nt < 2; ++nt)
#pragma unroll
        for (int r = 0; r < 16; ++r) { xr[nt][r] = 0.f; xi[nt][r] = 0.f; }
    const int trow0 = 8 * h + ((lane & 15) >> 2), tcol0 = 16 * ((lane >> 4) & 1) + 4 * (lane & 3);
#pragma unroll 1
    for (int c1 = 0; c1 < 2; ++c1) {
        const int k1 = 32 * c1 + r32;
        bf16x8 yrB[4], yiB[4];
        {
            const LAS unsigned char* fb = FT + k1 * HM_FRS + 8 * h * 2;
            bf16x8 aR = hm_ld_tr(PR + trow0 * HM_RS + tcol0 * 2), aI = hm_ld_tr(PI + trow0 * HM_RS + tcol0 * 2);
            HmF3 f = hm_ldf(fb, 8);
#pragma unroll
            for (int rt = 0; rt < 2; ++rt) {
                f32x16 yr, yi;
#pragma unroll
                for (int r = 0; r < 16; ++r) { yr[r] = 0.f; yi[r] = 0.f; }
#pragma unroll
                for (int ks = 0; ks < 2; ++ks) {
                    const int g = 2 * rt + ks;
                    bf16x8 aRn = aR, aIn = aI; HmF3 fn = f;
                    if (g + 1 < 4) { const int rt2 = (g + 1) >> 1, ks2 = (g + 1) & 1;
                        aRn = hm_ld_tr(PR + (16 * ks2 + trow0) * HM_RS + (32 * rt2 + tcol0) * 2); aIn = hm_ld_tr(PI + (16 * ks2 + trow0) * HM_RS + (32 * rt2 + tcol0) * 2);
                        fn = hm_ldf(fb + 16 * ks2 * 2, 8); }
                    yr = HM_MFMA(aR, f.r, yr); yr = HM_MFMA(aI, f.n, yr);
                    yi = HM_MFMA(aR, f.i, yi); yi = HM_MFMA(aI, f.r, yi);
                    asm volatile("" ::: "memory");
                    aR = aRn; aI = aIn; f = fn;
                }
#pragma unroll
                for (int r = 0; r < 16; ++r) {
                    const int n2 = 32 * rt + (r & 3) + 8 * (r >> 2) + 4 * h;
                    const unsigned w = WT[k1 * n2];
                    const float wr = (float)__builtin_bit_cast(_Float16, (unsigned short)(w & 0xffffu)), wi = (float)__builtin_bit_cast(_Float16, (unsigned short)(w >> 16));
                    const float a = yr[r], b = yi[r];
                    yr[r] = a * wr - b * wi; yi[r] = a * wi + b * wr;
                }
#pragma unroll
                for (int s = 0; s < 2; ++s) { yrB[2 * rt + s] = hm_pack(yr, s); yiB[2 * rt + s] = hm_pack(yi, s); }
            }
        }
        bf16x8 zrA[4], ziA[4];
#pragma unroll
        for (int kt = 0; kt < 2; ++kt) {
            f32x16 zr, zi;
#pragma unroll
            for (int r = 0; r < 16; ++r) { zr[r] = 0.f; zi[r] = 0.f; }
            f32x2 hv[16];
#pragma unroll
            for (int r = 0; r < 16; ++r) hv[r] = H[(32 * kt + (r & 3) + 8 * (r >> 2) + 4 * h) * 64 + k1];
            const LAS unsigned char* fb = FT + (32 * kt + r32) * HM_FRS + 4 * h * 2;
            HmF3 f = hm_ldf(fb, 16);
#pragma unroll
            for (int q = 0; q < 4; ++q) {
                HmF3 fn = f; if (q + 1 < 4) fn = hm_ldf(fb + 16 * (q + 1) * 2, 16);
                zr = HM_MFMA(f.r, yrB[q], zr); zr = HM_MFMA(f.n, yiB[q], zr);
                zi = HM_MFMA(f.i, yrB[q], zi); zi = HM_MFMA(f.r, yiB[q], zi);
                asm volatile("" ::: "memory");
                f = fn;
            }
#pragma unroll
            for (int r = 0; r < 16; ++r) {
                const float a = zr[r], b = zi[r];
                zr[r] = a * hv[r].x - b * hv[r].y; zi[r] = a * hv[r].y + b * hv[r].x;
            }
#pragma unroll
            for (int s = 0; s < 2; ++s) { zrA[2 * kt + s] = hm_pack(zr, s); ziA[2 * kt + s] = hm_pack(zi, s); }
        }
#pragma unroll
        for (int nt = 0; nt < 2; ++nt) {
            const int n2 = 32 * nt + r32;
            f32x16 vr, vi;
#pragma unroll
            for (int r = 0; r < 16; ++r) { vr[r] = 0.f; vi[r] = 0.f; }
            const LAS unsigned char* fb = FT + n2 * HM_FRS + 4 * h * 2;
            HmF3 f = hm_ldf(fb, 16);
#pragma unroll
            for (int q = 0; q < 4; ++q) {
                HmF3 fn = f; if (q + 1 < 4) fn = hm_ldf(fb + 16 * (q + 1) * 2, 16);
                vr = HM_MFMA(zrA[q], f.r, vr); vr = HM_MFMA(ziA[q], f.i, vr);
                vi = HM_MFMA(ziA[q], f.r, vi); vi = HM_MFMA(zrA[q], f.n, vi);
                asm volatile("" ::: "memory");
                f = fn;
            }
            const LAS unsigned char* f4 = FT + r32 * HM_FRS + (32 * c1 + 4 * h) * 2;
            HmF3 g0 = hm_ldf(f4, 16), g1 = hm_ldf(f4 + 16 * 2, 16);
#pragma unroll
            for (int r = 0; r < 16; ++r) {
                const int kk = 32 * c1 + (r & 3) + 8 * (r >> 2) + 4 * h;
                const unsigned w = WT[kk * n2];
                const float wr = (float)__builtin_bit_cast(_Float16, (unsigned short)(w & 0xffffu)), wi = (float)__builtin_bit_cast(_Float16, (unsigned short)(w >> 16));
                const float a = vr[r], b = vi[r];
                vr[r] = a * wr + b * wi; vi[r] = b * wr - a * wi;
            }
            {
                const bf16x8 vrB = hm_pack(vr, 0), viB = hm_pack(vi, 0);
                xr[nt] = HM_MFMA(g0.r, vrB, xr[nt]); xr[nt] = HM_MFMA(g0.i, viB, xr[nt]);
                xi[nt] = HM_MFMA(g0.r, viB, xi[nt]); xi[nt] = HM_MFMA(g0.n, vrB, xi[nt]);
            }
            {
                const bf16x8 vrB = hm_pack(vr, 1), viB = hm_pack(vi, 1);
                xr[nt] = HM_MFMA(g1.r, vrB, xr[nt]); xr[nt] = HM_MFMA(g1.i, viB, xr[nt]);
                xi[nt] = HM_MFMA(g1.r, viB, xi[nt]); xi[nt] = HM_MFMA(g1.n, vrB, xi[nt]);
            }
            asm volatile("" ::: "memory");
        }
    }
    asm volatile("s_waitcnt lgkmcnt(0)" ::: "memory");
#pragma unroll
    for (int nt = 0; nt < 2; ++nt)
#pragma unroll
        for (int r = 0; r < 16; ++r) {
            const int n1 = (r & 3) + 8 * (r >> 2) + 4 * h, off = n1 * HM_RS + (32 * nt + r32) * 2;
            *(LAS unsigned short*)(PR + off) = f2bf(xr[nt][r]); *(LAS unsigned short*)(PI + off) = f2bf(xi[nt][r]);
        }
}
__device__ __forceinline__ void hm_init_tables(LAS unsigned char* lds, int tid) {
    for (int i = tid; i < 4096; i += NTHREADS) {
        const int a = i >> 6, b = i & 63; float s, c; sincospif(-(float)((a * b) & 63) * (1.f / 32.f), &s, &c);
        LAS unsigned short* fp = (LAS unsigned short*)(lds + HM_FT + a * HM_FRS + b * 2);
        fp[0] = f2bf(c); fp[HM_FTBL / 2] = f2bf(s); fp[HM_FTBL] = f2bf(-s);
        float s2, c2; sincospif(-(float)i * (1.f / 2048.f), &s2, &c2);
        const _Float16 ch_ = (_Float16)c2, sh_ = (_Float16)s2;
        ((LAS unsigned*)(lds + HM_WT))[i] = (unsigned)__builtin_bit_cast(unsigned short, ch_) | ((unsigned)__builtin_bit_cast(unsigned short, sh_) << 16);
    }
}
__device__ __forceinline__ void hm_spec_wave(const LAS unsigned char* lds, int lane, int cc, int c1, float scale, float dd, f32x2* dst) {
    const int r32 = lane & 31, h = lane >> 5, k1 = 32 * c1 + r32;
    const LAS unsigned char* PR = lds + HM_STG + cc * (64 * HM_RS);
    const LAS unsigned char* FT = lds + HM_FT; const LAS unsigned* WT = (const LAS unsigned*)(lds + HM_WT);
    const int trow0 = 8 * h + ((lane & 15) >> 2), tcol0 = 16 * ((lane >> 4) & 1) + 4 * (lane & 3);
    bf16x8 yrB[4], yiB[4];
#pragma unroll
    for (int rt = 0; rt < 2; ++rt) {
        f32x16 yr, yi;
#pragma unroll
        for (int r = 0; r < 16; ++r) { yr[r] = 0.f; yi[r] = 0.f; }
#pragma unroll
        for (int ks = 0; ks < 4; ++ks) {
            const bf16x8 aR = hm_ld_tr(PR + (16 * ks + trow0) * HM_RS + (32 * rt + tcol0) * 2);
            const LAS unsigned char* fp = FT + k1 * HM_FRS + (16 * ks + 8 * h) * 2;
            const bf16x8 bFr = hm_ld2(fp, 8), bFi = hm_ld2(fp + HM_FTBL, 8);
            yr = HM_MFMA(aR, bFr, yr); yi = HM_MFMA(aR, bFi, yi);
            asm volatile("" ::: "memory");
        }
#pragma unroll
        for (int r = 0; r < 16; ++r) {
            const int n2 = 32 * rt + (r & 3) + 8 * (r >> 2) + 4 * h;
            const unsigned w = WT[k1 * n2];
            const float wr = (float)__builtin_bit_cast(_Float16, (unsigned short)(w & 0xffffu)), wi = (float)__builtin_bit_cast(_Float16, (unsigned short)(w >> 16));
            const float a = yr[r], b = yi[r];
            yr[r] = a * wr - b * wi; yi[r] = a * wi + b * wr;
        }
#pragma unroll
        for (int s = 0; s < 2; ++s) { yrB[2 * rt + s] = hm_pack(yr, s); yiB[2 * rt + s] = hm_pack(yi, s); }
    }
#pragma unroll
    for (int kt = 0; kt < 2; ++kt) {
        f32x16 zr, zi;
#pragma unroll
        for (int r = 0; r < 16; ++r) { zr[r] = 0.f; zi[r] = 0.f; }
#pragma unroll
        for (int q = 0; q < 4; ++q) {
            const HmF3 f = hm_ldf(FT + (32 * kt + r32) * HM_FRS + (16 * q + 4 * h) * 2, 16);
            zr = HM_MFMA(f.r, yrB[q], zr); zr = HM_MFMA(f.n, yiB[q], zr);
            zi = HM_MFMA(f.i, yrB[q], zi); zi = HM_MFMA(f.r, yiB[q], zi);
            asm volatile("" ::: "memory");
        }
#pragma unroll
        for (int r = 0; r < 16; ++r) {
            const int k2 = 32 * kt + (r & 3) + 8 * (r >> 2) + 4 * h;
            dst[k2 * 64 + k1] = (f32x2){zr[r] * scale + dd, zi[r] * scale};
        }
    }
}
constexpr int HM_W3L = HM_END + 128;
static_assert(HM_W3L + 32 * HM_FRS <= LDS_BARST, "spectra lds");
__device__ __forceinline__ void spectra_phase(const Frame& F, int l) {
    const Params& P = *F.P; unsigned char* ws = P.ws + opaque_zero(); const int tid = F.tid, lane = F.lane, r32 = lane & 31, h = lane >> 5;
    LAS unsigned char* lds = F.lds; LAS float* red = (LAS float*)(lds + HM_END);
    hm_init_tables(lds, tid);
    const bf16_t* H2B = (const bf16_t*)(ws + CTL_H2) + (size_t)l * SEQ * 64;
    const float* w3 = P.in[I_FW3] + (size_t)l * 64 * 2048;
    f32x2* spec = (f32x2*)(ws + WS_S);
    const float min_decay = logf(0.01f) / 1.5f, max_decay = logf(0.01f) / 0.3f;
    for (int it = F.bid; it < 256; it += F.G) {
        const int o = it >> 7, c0 = (it & 127) * 4;
        { const int row = tid >> 6, j = tid & 63;
          *(LAS unsigned short*)(lds + HM_W3L + row * HM_FRS + j * 2) = f2bf(w3[(size_t)j * 2048 + (o * 2 + (row >> 2)) * 512 + c0 + (row & 3)]);
#pragma unroll
          for (int k = 0; k < 3; ++k) { const int e = tid + 512 * k; *(LAS unsigned short*)(lds + HM_W3L + (8 + (e >> 6)) * HM_FRS + (e & 63) * 2) = 0; } }
        __syncthreads();
        bf16x8 wA[4];
#pragma unroll
        for (int ks = 0; ks < 4; ++ks) wA[ks] = hm_ld2(lds + HM_W3L + r32 * HM_FRS + (16 * ks + 8 * h) * 2, 8);
        float dl[4];
#pragma unroll
        for (int cc = 0; cc < 4; ++cc) dl[cc] = fabsf(min_decay + (max_decay - min_decay) * ((float)(c0 + cc) / 511.f));
        float ss[4] = {0.f, 0.f, 0.f, 0.f};
#pragma unroll 2
        for (int tt = F.wave; tt < 64; tt += 8) {
            const int t = 32 * tt + r32;
            const bf16_t* hp = H2B + (size_t)t * 64 + 8 * h;
            f32x16 d;
#pragma unroll
            for (int r = 0; r < 16; ++r) d[r] = 0.f;
            bf16x8 hb[4];
#pragma unroll
            for (int ks = 0; ks < 4; ++ks) hb[ks] = *(const bf16x8*)(hp + 16 * ks);
#pragma unroll
            for (int ks = 0; ks < 4; ++ks) d = HM_MFMA(wA[ks], hb[ks], d);
            const float tn = (float)t / (float)(SEQ - 1);
#pragma unroll
            for (int cc = 0; cc < 4; ++cc) {
                float v = d[cc] * expf(-tn * dl[cc]);
                const float other = __shfl_xor(v, 32);
                LAS unsigned char* PR = lds + HM_STG + cc * (64 * HM_RS);
                int n;
                if (t == 0) { if (h == 0) { v += other; n = 0; } else { v = 0.f; n = 2048; } }
                else n = h ? 4096 - t : t;
                *(LAS unsigned short*)(PR + (n >> 6) * HM_RS + (n & 63) * 2) = f2bf(v);
                ss[cc] += v * v;
            }
        }
#pragma unroll
        for (int cc = 0; cc < 4; ++cc) ss[cc] = wave_sum(ss[cc]);
        if (lane == 0) *(LAS f32x4*)(red + F.wave * 4) = (f32x4){ss[0], ss[1], ss[2], ss[3]};
        __syncthreads();
        {
            const int cc = F.wave & 3, c = c0 + cc;
            float tot = 0.f;
#pragma unroll
            for (int w = 0; w < 8; ++w) tot += red[w * 4 + cc];
            const float scale = rsqrtf(tot + RMS_EPS) * (1.f / 4096.f);
            const float dd = P.in[I_HYD][(l * 2 + o) * 512 + c] * (1.f / 4096.f);
            hm_spec_wave(lds, lane, cc, F.wave >> 2, scale, dd, spec + (size_t)(o * 512 + c) * 4096);
        }
        __syncthreads();
    }
}

__device__ __forceinline__ int hm_addr(int ch, int pl, int t) { return ((ch * 2 + pl) * 32 + (t >> 6)) * HM_RS + (t & 63) * 2; }
template <int MODE> __device__ __forceinline__ void hm_elem_pass(const Frame& F, LAS unsigned char* lds, const bf16_t* HY, int b0, int coff, const float* cw, const float* cb, bf16_t* outp, int c0) {
    const int tid = F.tid, b = tid >> 8, t0 = (tid & 255) * 8;
    const bf16_t* rp = HY + ((size_t)(coff >> 3) * MTOK + (size_t)(b0 + b) * SEQ + t0) * 8;
    u32x4 x[10];
    const u32x4 z4 = {0u, 0u, 0u, 0u};
    x[0] = (t0 > 0) ? *(const u32x4*)(rp - 8) : z4;
#pragma unroll
    for (int i = 0; i < 8; ++i) x[1 + i] = *(const u32x4*)(rp + 8 * i);
    x[9] = (t0 + 8 < SEQ) ? *(const u32x4*)(rp + 64) : z4;
    u32x4 res[8];
#pragma unroll
    for (int kp = 0; kp < 4; ++kp) {
        const float wl0 = cw[coff + 2 * kp], wl1 = cw[1536 + coff + 2 * kp], wl2 = cw[2 * 1536 + coff + 2 * kp], bl = cb[coff + 2 * kp];
        const float wh0 = cw[coff + 2 * kp + 1], wh1 = cw[1536 + coff + 2 * kp + 1], wh2 = cw[2 * 1536 + coff + 2 * kp + 1], bh = cb[coff + 2 * kp + 1];
        float lo[8], hi[8];
#pragma unroll
        for (int i = 0; i < 8; ++i) {
            lo[i] = bflo(x[i][kp]) * wl0 + bflo(x[i + 1][kp]) * wl1 + bflo(x[i + 2][kp]) * wl2 + bl;
            hi[i] = bfhi(x[i][kp]) * wh0 + bfhi(x[i + 1][kp]) * wh1 + bfhi(x[i + 2][kp]) * wh2 + bh;
        }
        if (MODE != 0) {
            const u32x4 pl = *(const LAS u32x4*)(lds + HM_STG + hm_addr(2 * kp, b, t0)), ph = *(const LAS u32x4*)(lds + HM_STG + hm_addr(2 * kp + 1, b, t0));
#pragma unroll
            for (int i = 0; i < 4; ++i) { lo[2 * i] *= bflo(pl[i]); lo[2 * i + 1] *= bfhi(pl[i]); hi[2 * i] *= bflo(ph[i]); hi[2 * i + 1] *= bfhi(ph[i]); }
        }
        res[2 * kp] = (u32x4){pk2(lo[0], lo[1]), pk2(lo[2], lo[3]), pk2(lo[4], lo[5]), pk2(lo[6], lo[7])};
        res[2 * kp + 1] = (u32x4){pk2(hi[0], hi[1]), pk2(hi[2], hi[3]), pk2(hi[4], hi[5]), pk2(hi[6], hi[7])};
    }
    if (MODE == 2) {
#pragma unroll
        for (int i = 0; i < 8; ++i) {
            u32x4 w;
#pragma unroll
            for (int kp = 0; kp < 4; ++kp) {
                const unsigned a = res[2 * kp][i >> 1], c = res[2 * kp + 1][i >> 1];
                w[kp] = (i & 1) ? ((a >> 16) | (c & 0xffff0000u)) : ((a & 0xffffu) | (c << 16));
            }
            *(u32x4*)(outp + ((size_t)(b0 + b) * SEQ + t0 + i) * 512 + c0) = w;
        }
    } else {
#pragma unroll
        for (int k = 0; k < 8; ++k) *(LAS u32x4*)(lds + HM_STG + hm_addr(k, b, t0)) = res[k];
    }
    __syncthreads();
}
__device__ __forceinline__ void gate_rows_i8(const Frame& F, int wv, int nw, size_t rowss_off) {
    const Params& P = *F.P; unsigned char* ws = P.ws + opaque_zero(); const int lane = F.lane;
    const float* rowss = (const float*)(ws + rowss_off); float* fct = (float*)(ws + CTL_FCTA);
    for (int m0 = wv; m0 < MTOK; m0 += 4 * nw) {
        u32x4 v[4][2];
#pragma unroll
        for (int r = 0; r < 4; ++r) { const int m = m0 + r * nw; if (m < MTOK) { const u32x4* xr = (const u32x4*)(ws + WS_XB + (size_t)m * DM * 2) + lane; v[r][0] = xr[0]; v[r][1] = xr[64]; } }
#pragma unroll
        for (int r = 0; r < 4; ++r) { const int m = m0 + r * nw; if (m < MTOK) {
            float f[16];
#pragma unroll
            for (int h = 0; h < 2; ++h) { const u32x4 w = v[r][h]; f[8 * h + 0] = bflo(w.x); f[8 * h + 1] = bfhi(w.x); f[8 * h + 2] = bflo(w.y); f[8 * h + 3] = bfhi(w.y);
                f[8 * h + 4] = bflo(w.z); f[8 * h + 5] = bfhi(w.z); f[8 * h + 6] = bflo(w.w); f[8 * h + 7] = bfhi(w.w); }
            float mx = 0.f;
#pragma unroll
            for (int e = 0; e < 16; ++e) mx = fmaxf(mx, fabsf(f[e]));
#pragma unroll
            for (int o = 32; o > 0; o >>= 1) mx = fmaxf(mx, __shfl_xor(mx, o));
            const float sc = mx > 0.f ? 127.f / mx : 0.f;
            u32x2* o8 = (u32x2*)(ws + WS_XB8 + (size_t)m * DM) + lane;
#pragma unroll
            for (int h = 0; h < 2; ++h)
                o8[64 * h] = (u32x2){pack_b0(q8(f[8 * h] * sc), q8(f[8 * h + 1] * sc), q8(f[8 * h + 2] * sc), q8(f[8 * h + 3] * sc)), pack_b0(q8(f[8 * h + 4] * sc), q8(f[8 * h + 5] * sc), q8(f[8 * h + 6] * sc), q8(f[8 * h + 7] * sc))};
            if (lane == 0) { const f32x4 q = *(const f32x4*)(rowss + (size_t)m * 4);
                *(f32x4*)(fct + (size_t)m * 4) = (f32x4){rsqrtf(((q[0] + q[1]) + (q[2] + q[3])) * (1.f / DM) + RMS_EPS) * mx * (1.f / 127.f), 0.f, 0.f, 0.f}; }
        } }
    }
}
__device__ __forceinline__ void p5_prep(const Frame& F, int l) {
    gate_rows_i8(F, F.bid * 8 + F.wave, F.G * 8, WS_ROWSSB);
}
__device__ __forceinline__ void hyena_phase(const Frame& F, int l) {
    const Params& P = *F.P; unsigned char* ws = P.ws + opaque_zero(); const int tid = F.tid;
    LAS unsigned char* lds = F.lds;
    hm_init_tables(lds, tid);
    const bf16_t* HY = (const bf16_t*)(ws + G_HY); bf16_t* OB = (bf16_t*)(ws + WS_OB);
    const f32x2* spec = (const f32x2*)(ws + WS_S);
    const float* cw = P.in[I_CONVW] + (size_t)l * 3 * 1536; const float* cb = P.in[I_CONVB] + (size_t)l * 1536;
    for (int it = F.bid; it < 256; it += F.G) {
        const int combo = (it & 7) * 4 + (it >> 6), bp = combo >> 3, cg = (combo & 7) * 8 + ((it >> 3) & 7), b0 = 2 * bp, c0 = 8 * cg;
        hm_elem_pass<0>(F, lds, HY, b0, c0, cw, cb, nullptr, c0);
        hm_conv_wave(lds, F.lane, F.wave, spec + (size_t)(c0 + F.wave) * 4096);
        __syncthreads();
        hm_elem_pass<1>(F, lds, HY, b0, 512 + c0, cw, cb, nullptr, c0);
        hm_conv_wave(lds, F.lane, F.wave, spec + (size_t)(512 + c0 + F.wave) * 4096);
        __syncthreads();
        hm_elem_pass<2>(F, lds, HY, b0, 1024 + c0, cw, cb, OB, c0);
    }
}

template <int KW, int DV, bool WINDOW>
__device__ __forceinline__ void attn_core(LAS unsigned char* lds, int tid, const bf16_t* Qg, int ldq, const bf16_t* Kb, int ldk, const bf16_t* Vb, int ldv,
                                          int q0, int t_lo, int t_hi, float m_init, float l_init, int kcol, f32x16 (&o)[DV / 32], float& m_out, float& l_out) {
    constexpr int KSTR = (KW + 8) * 2, VSTR = (DV == 128) ? 320 : 192, KCH = KW / 8, VCH = DV / 8, NK = 64 * KCH / NTHREADS, NV = 64 * VCH / NTHREADS;
    constexpr int KBUF = 64 * KSTR, VBUF = 64 * VSTR, VOFF = 2 * KBUF;
    const int lane = tid & 63, wave = tid >> 6, w4 = wave & 3, r32 = lane & 31, h = lane >> 5;
    const int qrow = q0 + 32 * w4 + r32;
    bf16x8 qf[4];
#pragma unroll
    for (int ds = 0; ds < 4; ++ds) qf[ds] = *(const bf16x8*)(Qg + (size_t)qrow * ldq + 16 * ds + 8 * h);
#pragma unroll
    for (int db = 0; db < DV / 32; ++db)
#pragma unroll
        for (int r = 0; r < 16; ++r) o[db][r] = 0.f;
    float m = m_init, l = l_init;
    u32x4 kreg[NK], vreg[NV];
    auto kload = [&](int t) {
#pragma unroll
        for (int i = 0; i < NK; ++i) { const int c = tid + NTHREADS * i, row = c / KCH, ch = c % KCH; kreg[i] = *(const u32x4*)(Kb + (size_t)(64 * t + row) * ldk + ch * 8); }
    };
    auto vload = [&](int t) {
#pragma unroll
        for (int i = 0; i < NV; ++i) { const int c = tid + NTHREADS * i, row = c / VCH, ch = c % VCH; vreg[i] = *(const u32x4*)(Vb + (size_t)(64 * t + row) * ldv + ch * 8); }
    };
    auto kstore = [&](int buf) {
#pragma unroll
        for (int i = 0; i < NK; ++i) { const int c = tid + NTHREADS * i, row = c / KCH, ch = c % KCH; *(LAS u32x4*)(lds + buf * KBUF + row * KSTR + ch * 16) = kreg[i]; }
    };
    auto vstore = [&](int buf) {
#pragma unroll
        for (int i = 0; i < NV; ++i) { const int c = tid + NTHREADS * i, row = c / VCH, ch = c % VCH; *(LAS u32x4*)(lds + VOFF + buf * VBUF + row * VSTR + ch * 16) = vreg[i]; }
    };
    auto qk = [&](int buf, f32x16& S0, f32x16& S1) {
#pragma unroll
        for (int r = 0; r < 16; ++r) { S0[r] = 0.f; S1[r] = 0.f; }
        const LAS unsigned char* kb = lds + buf * KBUF + r32 * KSTR + (kcol + 8 * h) * 2;
#pragma unroll
        for (int ds = 0; ds < 4; ++ds) {
            const bf16x8 k0 = *(const LAS bf16x8*)(kb + ds * 32);
            const bf16x8 k1 = *(const LAS bf16x8*)(kb + 32 * KSTR + ds * 32);
            S0 = __builtin_amdgcn_mfma_f32_32x32x16_bf16(k0, qf[ds], S0, 0, 0, 0);
            S1 = __builtin_amdgcn_mfma_f32_32x32x16_bf16(k1, qf[ds], S1, 0, 0, 0);
        }
    };
    kload(t_lo); vload(t_lo); kstore(0); vstore(0);
    if (t_lo < t_hi) kload(t_lo + 1);
    __syncthreads();
    f32x16 Sa0, Sa1, Sb0, Sb1;
    qk(0, Sa0, Sa1);
    if (t_lo < t_hi) kstore(1);
    __syncthreads();
    auto step = [&](int t, f32x16& S0, f32x16& S1, f32x16& N0, f32x16& N1) {
        const int i = t - t_lo, vcur = i & 1, knext = (i + 1) & 1;
        if (t + 2 <= t_hi) kload(t + 2);
        if (t + 1 <= t_hi) { vload(t + 1); qk(knext, N0, N1); }
        if (WINDOW) {
            const int kbase = 64 * t + 4 * h - qrow;
#pragma unroll
            for (int r = 0; r < 16; ++r) {
                const int d0 = kbase + (r & 3) + 8 * (r >> 2), d1 = d0 + 32;
                if (d0 > 128 || d0 < -128) S0[r] = -1e30f;
                if (d1 > 128 || d1 < -128) S1[r] = -1e30f;
            }
        }
        float mx0 = fmaxf(fmaxf(S0[0], S0[1]), S0[2]), mx1 = fmaxf(fmaxf(S1[0], S1[1]), S1[2]);
#pragma unroll
        for (int r = 3; r < 15; r += 2) { mx0 = fmaxf(fmaxf(mx0, S0[r]), S0[r + 1]); mx1 = fmaxf(fmaxf(mx1, S1[r]), S1[r + 1]); }
        float mx = fmaxf(fmaxf(mx0, S0[15]), fmaxf(mx1, S1[15]));
        mx = fmaxf(mx, __shfl_xor(mx, 32));
        if (__any(mx > m + 6.0f)) {
            const float mnew = fmaxf(m, mx);
            const float alpha = __builtin_amdgcn_exp2f(m - mnew);
            m = mnew; l *= alpha;
#pragma unroll
            for (int db = 0; db < DV / 32; ++db)
#pragma unroll
                for (int r = 0; r < 16; ++r) o[db][r] *= alpha;
        }
        float ps0 = 0.f, ps1 = 0.f, ps2 = 0.f, ps3 = 0.f;
#pragma unroll
        for (int r = 0; r < 16; r += 2) {
            S0[r] = __builtin_amdgcn_exp2f(S0[r] - m); S0[r + 1] = __builtin_amdgcn_exp2f(S0[r + 1] - m); S1[r] = __builtin_amdgcn_exp2f(S1[r] - m); S1[r + 1] = __builtin_amdgcn_exp2f(S1[r + 1] - m);
            ps0 += S0[r]; ps1 += S0[r + 1]; ps2 += S1[r]; ps3 += S1[r + 1];
        }
        l += (ps0 + ps1) + (ps2 + ps3);
        bf16x8 pf[2][2];
#pragma unroll
        for (int s = 0; s < 2; ++s) {
            u32x4 w0, w1;
            w0.x = pk2(S0[8 * s + 0], S0[8 * s + 1]); w0.y = pk2(S0[8 * s + 2], S0[8 * s + 3]); w0.z = pk2(S0[8 * s + 4], S0[8 * s + 5]); w0.w = pk2(S0[8 * s + 6], S0[8 * s + 7]);
            w1.x = pk2(S1[8 * s + 0], S1[8 * s + 1]); w1.y = pk2(S1[8 * s + 2], S1[8 * s + 3]); w1.z = pk2(S1[8 * s + 4], S1[8 * s + 5]); w1.w = pk2(S1[8 * s + 6], S1[8 * s + 7]);
            pf[0][s] = __builtin_bit_cast(bf16x8, w0); pf[1][s] = __builtin_bit_cast(bf16x8, w1);
        }
        const LAS unsigned char* vb = lds + VOFF + vcur * VBUF + (4 * h + ((lane & 15) >> 2)) * VSTR + (16 * ((lane >> 4) & 1) + 4 * (lane & 3)) * 2;
#pragma unroll
        for (int kh = 0; kh < 2; ++kh)
#pragma unroll
            for (int s = 0; s < 2; ++s)
#pragma unroll
                for (int db = 0; db < DV / 32; ++db) {
                    const LAS unsigned char* p = vb + (32 * kh + 16 * s) * VSTR + db * 64;
                    const s16x4 lo4 = __builtin_amdgcn_ds_read_tr16_b64_v4i16((LAS s16x4*)p);
                    const s16x4 hi4 = __builtin_amdgcn_ds_read_tr16_b64_v4i16((LAS s16x4*)(p + 8 * VSTR));
                    const bf16x8 vf = {lo4[0], lo4[1], lo4[2], lo4[3], hi4[0], hi4[1], hi4[2], hi4[3]};
                    o[db] = __builtin_amdgcn_mfma_f32_32x32x16_bf16(vf, pf[kh][s], o[db], 0, 0, 0);
                }
        if (t + 2 <= t_hi) kstore(i & 1);
        if (t + 1 <= t_hi) vstore((i + 1) & 1);
        __syncthreads();
    };
    int t = t_lo;
    for (; t + 1 <= t_hi; t += 2) { step(t, Sa0, Sa1, Sb0, Sb1); step(t + 1, Sb0, Sb1, Sa0, Sa1); }
    if (t <= t_hi) step(t, Sa0, Sa1, Sb0, Sb1);
    m_out = m; l_out = l;
}

constexpr int ATT_CMB = 75776;
template <int WHICH> __device__ __forceinline__ void attn_phase(const Frame& F, int l) {
    const Params& P = *F.P; unsigned char* ws = P.ws + opaque_zero(); const int tid = F.tid, lane = F.lane, wave = F.wave, g = wave >> 2, w4 = wave & 3, r32 = lane & 31, h = lane >> 5;
    if constexpr (WHICH == 0) {
        const bf16_t* QC = (const bf16_t*)(ws + WS_QC); const bf16_t* KC = (const bf16_t*)(ws + G_KC); const bf16_t* VC = (const bf16_t*)(ws + G_VC); bf16_t* OC = (bf16_t*)(ws + WS_QC);
        const float lam = ((const float*)(ws + CTL_LAM))[l];
        const float lam_init = 0.8f - 0.6f * expf(-0.3f * (float)l);
        const float* subln = P.in[I_SUBLN] + l * 128;
        for (int u = F.bid; u < 512; u += F.G) {
            const int b = u >> 6, head = (u >> 4) & 3, qblk = u & 15, q0 = qblk * 128;
            const size_t rb = (size_t)b * SEQ;
            f32x16 o[4]; float m, lsum;
            attn_core<128, 128, false>(F.lds, tid, QC + rb * 512 + head * 128 + g * 64, 512, KC + rb * 512 + head * 128, 512, VC + rb * 512 + head * 128, 512,
                                       q0, 0, 31, -1e30f, 0.f, g * 64, o, m, lsum);
            lsum += __shfl_xor(lsum, 32);
            const float inv = 1.f / lsum;
            LAS f32x4* cmb = (LAS f32x4*)(F.lds + ATT_CMB);
            if (g == 1) {
#pragma unroll
                for (int db = 0; db < 4; ++db)
#pragma unroll
                    for (int rq = 0; rq < 4; ++rq) cmb[((w4 * 16 + db * 4 + rq) * 64) + lane] = (f32x4){o[db][4 * rq] * inv, o[db][4 * rq + 1] * inv, o[db][4 * rq + 2] * inv, o[db][4 * rq + 3] * inv};
            }
            __syncthreads();
            if (g == 0 && !F.dry) {
                float ss = 0.f;
#pragma unroll
                for (int db = 0; db < 4; ++db)
#pragma unroll
                    for (int rq = 0; rq < 4; ++rq) {
                        const f32x4 o2 = cmb[((w4 * 16 + db * 4 + rq) * 64) + lane];
#pragma unroll
                        for (int i = 0; i < 4; ++i) { const float v = o[db][4 * rq + i] * inv - lam * o2[i]; o[db][4 * rq + i] = v; ss += v * v; }
                    }
                ss += __shfl_xor(ss, 32);
                const float rn = rsqrtf(ss * (1.f / 128.f) + RMS_EPS) * (1.f - lam_init);
                const int qrow = q0 + 32 * w4 + r32;
                bf16_t* op = OC + (rb + qrow) * 512 + head * 128;
#pragma unroll
                for (int db = 0; db < 4; ++db)
#pragma unroll
                    for (int rp = 0; rp < 2; ++rp) {
                        u32x2 w[2];
#pragma unroll
                        for (int k = 0; k < 2; ++k) { const int rq = 2 * rp + k, d = 32 * db + 8 * rq + 4 * h; const f32x4 sg = *(const f32x4*)(subln + d);
                            w[k].x = pk2(o[db][4 * rq] * rn * sg[0], o[db][4 * rq + 1] * rn * sg[1]); w[k].y = pk2(o[db][4 * rq + 2] * rn * sg[2], o[db][4 * rq + 3] * rn * sg[3]); }
                        { auto r = __builtin_amdgcn_permlane32_swap(w[0].x, w[1].x, false, false); w[0].x = r[0]; w[1].x = r[1]; }
                        { auto r = __builtin_amdgcn_permlane32_swap(w[0].y, w[1].y, false, false); w[0].y = r[0]; w[1].y = r[1]; }
                        *(u32x4*)(op + 32 * db + 16 * rp + 8 * h) = (u32x4){w[0].x, w[0].y, w[1].x, w[1].y};
                    }
            }
        }
    }
    if constexpr (WHICH == 1) {
        const bf16_t* QA = (const bf16_t*)(ws + WS_QA); const bf16_t* KA = (const bf16_t*)(ws + G_KA); const bf16_t* VA = (const bf16_t*)(ws + G_VA); bf16_t* OA = (bf16_t*)(ws + WS_QA);
        const float* sink = P.in[I_SINK] + l * 8;
        for (int u = F.bid; u < 512; u += F.G) {
            const int b = u >> 6, kvh = (u >> 5) & 1, qblk = (u >> 1) & 15, hp = u & 1, q0 = qblk * 128;
            const int qh = kvh * 4 + hp * 2 + g;
            const size_t rb = (size_t)b * SEQ;
            int t_lo = (q0 - 128) / 64; if (t_lo < 0) t_lo = 0;
            int t_hi = (q0 + 255) / 64; if (t_hi > 31) t_hi = 31;
            f32x16 o[2]; float m, lsum;
            attn_core<64, 64, true>(F.lds, tid, QA + rb * 512 + qh * 64, 512, KA + rb * 128 + kvh * 64, 128, VA + rb * 128 + kvh * 64, 128,
                                    q0, t_lo, t_hi, sink[qh] * LOG2E, (h == 0) ? 1.f : 0.f, 0, o, m, lsum);
            lsum += __shfl_xor(lsum, 32);
            const float inv = 1.f / lsum;
            const int qrow = q0 + 32 * w4 + r32;
            bf16_t* op = OA + (rb + qrow) * 512 + qh * 64;
            if (!F.dry)
#pragma unroll
            for (int db = 0; db < 2; ++db)
#pragma unroll
                for (int rp = 0; rp < 2; ++rp) {
                    u32x2 w[2];
#pragma unroll
                    for (int k = 0; k < 2; ++k) { const int rq = 2 * rp + k;
                        w[k].x = pk2(o[db][4 * rq] * inv, o[db][4 * rq + 1] * inv); w[k].y = pk2(o[db][4 * rq + 2] * inv, o[db][4 * rq + 3] * inv); }
                    { auto r = __builtin_amdgcn_permlane32_swap(w[0].x, w[1].x, false, false); w[0].x = r[0]; w[1].x = r[1]; }
                    { auto r = __builtin_amdgcn_permlane32_swap(w[0].y, w[1].y, false, false); w[0].y = r[0]; w[1].y = r[1]; }
                    *(u32x4*)(op + 32 * db + 16 * rp + 8 * h) = (u32x4){w[0].x, w[0].y, w[1].x, w[1].y};
                }
        }
    }
}

__device__ __forceinline__ void p1_inproj(const Frame& F, int l) {
    const Params& P = *F.P; unsigned char* ws = P.ws + opaque_zero();
    pg8::Gemm g{(const bf16_t*)(ws + WS_XB), (const bf16_t*)(ws + W_IN), MTOK, NMAIN, DM, 0, 0};
    pg8::StaticOrder S; S.init(MTOK, NMAIN, F.G, F.bid);
    EpiInProj E{nullptr, (const float*)(ws + WS_ROWSSA), (const unsigned*)(ws + CTL_COS), (const unsigned*)(ws + CTL_SIN) + l * 128,
                (bf16_t*)(ws + WS_QA), (bf16_t*)(ws + G_KA), (bf16_t*)(ws + G_VA), (bf16_t*)(ws + WS_QC), (bf16_t*)(ws + G_KC), (bf16_t*)(ws + G_VC), (bf16_t*)(ws + G_HY)};
    pg8::Acc acc;
    {
        const int U = (MTOK / 256) * (NMAIN / 256), R = (U + F.G - 1) / F.G; int ns = R * F.G - U, si = F.bid - (F.G - ns);
        if (ns == 0) { ns = F.G; si = F.bid; }
        if (si >= 0 && !FUSE_XQ(F)) gate_rows_i8(F, si * 8 + F.wave, ns * 8, WS_ROWSSA);
        __syncthreads();
    }
    pg8::gemm_phase<EpiInProj, pg8::StaticOrder, true, true, true>(F.lds, F.tid, g, S, E, acc);
}
__device__ __forceinline__ void p3_merge(const Frame& F, int l) {
    const Params& P = *F.P; unsigned char* ws = P.ws + opaque_zero();
    pg8::ChainOrder3 S; S.S.init(MTOK, DM, F.G, F.bid);
    {
        pg8::Gemm g{(const bf16_t*)(ws + WS_XB8), (const bf16_t*)(ws + W_IN + (size_t)NMAIN * DM * 2), MTOK, DM, DM, 0, (size_t)DM * DM};
        EpiGate E{nullptr, nullptr, F.tid, (const float*)(ws + CTL_FCTA), (const float*)(ws + CS_G), (u32x4*)(ws + WS_G)};
        pg8::Acc acc;
        pg8::gemm_phase<EpiGate, pg8::ChainOrder3, true, true, true, false, true>(F.lds, F.tid, g, S, E, acc);
    }
    {
        pg8::Gemm g{(const bf16_t*)(ws + WS_QA), (const bf16_t*)(ws + W_OA), MTOK, DM, 512, (size_t)16 * MiB, (size_t)DM * 512 * 2};
        EpiMerge E{F.tid, (const u32x4*)(ws + WS_G), (bf16_t*)(ws + WS_S)};
        pg8::Acc acc;
        pg8::gemm_phase<EpiMerge, pg8::ChainOrder3, true, true, true>(F.lds, F.tid, g, S, E, acc);
    }
}
__device__ __forceinline__ void p4_wout(const Frame& F, int l) {
    const Params& P = *F.P; unsigned char* ws = P.ws + opaque_zero();
    pg8::Gemm g{(const bf16_t*)(ws + WS_S), (const bf16_t*)(ws + W_OUT), MTOK, DM, DM, 0, 0};
    pg8::StaticOrder S; S.init(MTOK, DM, F.G, F.bid);
    const bool fuse = FUSE_XQ(F);
    EpiResid<false> E{(bf16_t*)(ws + WS_XB), P.out, (float*)(ws + WS_ROWSSB), F.dry, (LAS float*)(F.lds + pg8::STAGE_BYTES), F.tid,
                      fuse ? ws + WS_XB8 : nullptr, (float*)(ws + CTL_FCTA), (unsigned long long*)(ws + WS_XSLOT), (unsigned*)(ws + CTL_BAR) + CTLW_XQCNT, (unsigned*)(ws + CTL_BAR), 16u * (unsigned)(2 * l + 1)};
    pg8::Acc acc;
    pg8::gemm_phase<EpiResid<false>, pg8::StaticOrder, true, true, true>(F.lds, F.tid, g, S, E, acc);
}
__device__ __forceinline__ void p5_ffn_up(const Frame& F, int l) {
    const Params& P = *F.P; unsigned char* ws = P.ws + opaque_zero();
    pg8::Gemm g{(const bf16_t*)(ws + WS_XB8), (const bf16_t*)(ws + W_13), MTOK, 2 * DFF, DM, 0, 0};
    pg8::TailSplitOrder S; S.init(MTOK, 2 * DFF, F.G, F.bid);
    EpiSwiGLU E{nullptr, nullptr, (const float*)(ws + CTL_FCTA), (const float*)(ws + CS_13), (bf16_t*)(ws + WS_G), F.dry && (P.pad == 12)};
    pg8::Acc acc;
    pg8::gemm_phase<EpiSwiGLU, pg8::TailSplitOrder, true, true, true, true, true>(F.lds, F.tid, g, S, E, acc);
}
template <int L> __device__ __forceinline__ void p6_ffn_down(const Frame& F) {
    const Params& P = *F.P; unsigned char* ws = P.ws + opaque_zero();
    pg8::Gemm g{(const bf16_t*)(ws + WS_G), (const bf16_t*)(ws + W_2), MTOK, DM, DFF, 0, 0};
    pg8::StaticOrder S; S.init(MTOK, DM, F.G, F.bid);
    constexpr bool FINAL = (L + 1 >= DEPTH);
    const bool fuse = FUSE_XQ(F);
    EpiResid<FINAL> E{(bf16_t*)(ws + WS_XB), P.out, (float*)(ws + WS_ROWSSA), F.dry, (LAS float*)(F.lds + pg8::STAGE_BYTES), F.tid,
                      fuse ? ws + WS_XB8 : nullptr, (float*)(ws + CTL_FCTA), (unsigned long long*)(ws + WS_XSLOT), (unsigned*)(ws + CTL_BAR) + CTLW_XQCNT, (unsigned*)(ws + CTL_BAR), 16u * (unsigned)(2 * L + 2)};
    pg8::Acc acc;
    pg8::gemm_phase<EpiResid<FINAL>, pg8::StaticOrder, true, true, true>(F.lds, F.tid, g, S, E, acc);
}

constexpr int PH_PER_LAYER = 8, NPHASE = PH_PER_LAYER * DEPTH;
#define PH_IN(k) (P.lo <= (k) && (k) < P.hi)
#define PH_FRAME() do { int t_ = threadIdx.x; asm volatile("" : "+v"(t_)); F.tid = t_; F.lane = t_ & 63; F.wave = __builtin_amdgcn_readfirstlane(t_ >> 6); \
                        int b_ = blockIdx.x; asm volatile("" : "+s"(b_)); F.bid = b_; } while (0)
#define PH_SEAM(k) do { if (PH_IN(k) && PH_IN((k) + 1)) { if (P.coop) { xcd_barrier(xbar); if (P.pad == 11) xcd_barrier(xbar); } } __syncthreads(); } while (0)
#define PH_RUN(code, call) do { const int nrep_ = (P.pad == (code)) ? 2 : 1; for (int rep_ = 0; rep_ < nrep_; ++rep_) { PH_FRAME(); F.dry = (rep_ + 1 < nrep_); call; __syncthreads(); } } while (0)
template <int L> __device__ __forceinline__ void run_layer(Frame& F, const Params& P, cg::grid_group& grid, const XcdBarrier& xbar) {
    constexpr int B = PH_PER_LAYER * L;
    if (PH_IN(B + 0)) { PH_RUN(1, (p0_weights(F, L), (L == 0 ? p0_misc(F) : (void)0))); }
    PH_SEAM(B + 0);
    if (PH_IN(B + 1)) { PH_RUN(2, spectra_phase(F, L)); PH_RUN(3, p1_inproj(F, L)); }
    PH_SEAM(B + 1);
    if (PH_IN(B + 2)) { PH_RUN(4, hyena_phase(F, L)); PH_RUN(5, attn_phase<0>(F, L)); PH_RUN(6, attn_phase<1>(F, L)); }
    PH_SEAM(B + 2);
    if (PH_IN(B + 3)) { PH_RUN(7, p3_merge(F, L)); }
    PH_SEAM(B + 3);
    if (PH_IN(B + 4)) { PH_RUN(8, p4_wout(F, L)); }
    PH_SEAM(B + 4);
    if (!FUSE_XQ(F)) { if (PH_IN(B + 5)) { PH_RUN(14, p5_prep(F, L)); } PH_SEAM(B + 5); }
    if (PH_IN(B + 6)) { PH_RUN((P.pad == 12 ? 12 : 9), p5_ffn_up(F, L)); }
    PH_SEAM(B + 6);
    if (PH_IN(B + 7)) { PH_RUN(10, p6_ffn_down<L>(F)); }
    PH_SEAM(B + 7);
}
__global__ void __launch_bounds__(NTHREADS, 2) mega_fwd(Params P) {
    extern __shared__ __attribute__((aligned(16))) unsigned char lds_raw[];
    cg::grid_group grid = cg::this_grid();
    Frame F;
    F.lds = (LAS unsigned char*)lds_raw;
    F.G = gridDim.x; F.P = &P;
    volatile LAS unsigned* bst = (volatile LAS unsigned*)(F.lds + LDS_BARST);
    if (threadIdx.x < 4) bst[threadIdx.x] = 0u;
    __syncthreads();
    XcdBarrier xbar; xbar.bar = (unsigned*)(P.ws + CTL_BAR); xbar.x = 0; xbar.st = bst;
    if (P.coop) xbar = xcd_barrier_post((unsigned*)(P.ws + CTL_BAR), bst);
    if (P.coop == 2) grid.sync();
    run_layer<0>(F, P, grid, xbar);
    run_layer<1>(F, P, grid, xbar);
}

#ifndef PROBE_CODE
#define PROBE_CODE 0
#endif
#ifndef N_LAUNCH_MODE
#define N_LAUNCH_MODE 1
#endif
extern "C" void kernel_launch(void* const* d_in, const int* in_sizes, int n_in, void* d_out, int out_size, void* d_ws, size_t ws_size, hipStream_t stream) {
    static int grid = 0;
    if (grid == 0) {
        int dev = 0, cus = 0, per_cu = 0;
        if (hipGetDevice(&dev) != hipSuccess || hipDeviceGetAttribute(&cus, hipDeviceAttributeMultiprocessorCount, dev) != hipSuccess) { fprintf(stderr, "kernel_launch: device query failed\n"); grid = -1; return; }
        if (hipFuncSetAttribute((const void*)mega_fwd, hipFuncAttributeMaxDynamicSharedMemorySize, LDS_BYTES) != hipSuccess) { fprintf(stderr, "kernel_launch: hipFuncSetAttribute failed\n"); grid = -1; return; }
        if (hipOccupancyMaxActiveBlocksPerMultiprocessor(&per_cu, (const void*)mega_fwd, NTHREADS, LDS_BYTES) != hipSuccess || per_cu < 1) { fprintf(stderr, "kernel_launch: occupancy query failed (%d)\n", per_cu); per_cu = 1; }
        (void)hipGetLastError();
        if (per_cu > 1) per_cu = 1;
        grid = cus * per_cu;
        if (n_in != 31 || ws_size < WS_END) fprintf(stderr, "kernel_launch: unexpected n_in %d / ws_size %zu (need %zu)\n", n_in, ws_size, (size_t)WS_END);
    }
    if (grid < 0) return;
    Params p{};
    for (int i = 0; i < 31; ++i) p.in[i] = (const float*)d_in[i];
    p.out = (float*)d_out; p.ws = (unsigned char*)d_ws;
#if N_LAUNCH_MODE == 1
    p.lo = 0; p.hi = NPHASE; p.coop = 1; p.pad = PROBE_CODE;
    if (hipMemsetAsync((char*)d_ws + CTL_BAR, 0, CTL_BAR_BYTES, stream) != hipSuccess) { fprintf(stderr, "kernel_launch: memset of barrier words failed\n"); return; }
    void* args[] = {&p};
    hipError_t e = hipLaunchCooperativeKernel((const void*)mega_fwd, dim3(grid), dim3(NTHREADS), args, LDS_BYTES, stream);
    if (e != hipSuccess) fprintf(stderr, "cooperative launch failed: %s (grid %d)\n", hipGetErrorString(e), grid);
#else
    for (int ph = 0; ph < NPHASE; ++ph) {
        p.lo = ph; p.hi = ph + 1; p.coop = 0;
        hipLaunchKernelGGL(mega_fwd, dim3(grid), dim3(NTHREADS), LDS_BYTES, stream, p);
    }
#endif
}
```

```cpp
#include <hip/hip_runtime.h>
#include <hip/hip_cooperative_groups.h>
#include <cstdint>
#include <cstdio>
namespace cg = cooperative_groups;

#define LAS __attribute__((address_space(3)))
typedef unsigned short bf16_t;
typedef short bf16x8 __attribute__((ext_vector_type(8)));
typedef short s16x4 __attribute__((ext_vector_type(4)));
typedef float f32x2 __attribute__((ext_vector_type(2)));
typedef float f32x4 __attribute__((ext_vector_type(4)));
typedef float f32x16 __attribute__((ext_vector_type(16)));
typedef unsigned u32x2 __attribute__((ext_vector_type(2)));
typedef unsigned u32x4 __attribute__((ext_vector_type(4)));
typedef __bf16 bf16x2_t __attribute__((ext_vector_type(2)));

constexpr int DM = 1024, NBATCH = 8, SEQ = 2048, MTOK = NBATCH * SEQ, DEPTH = 2;
constexpr int INC = 6912, NMAIN = 3840, DFF = 2816;
constexpr float RMS_EPS = 1e-6f;
constexpr float LOG2E = 1.4426950408889634f;
constexpr float QSCALE = 0.125f * LOG2E;
constexpr int NTHREADS = 512;
constexpr int LDS_BYTES = 147456;

constexpr size_t MiB = 1u << 20;
constexpr size_t WS_CTL = 0;
constexpr size_t CTL_ROWSSA = 0;
constexpr size_t CTL_ROWSSB = 128 * 1024;
constexpr size_t CTL_COS = 256 * 1024;
constexpr size_t CTL_SIN = 512 * 1024;
constexpr size_t CTL_LAM = 768 * 1024;
constexpr size_t CTL_TW = 768 * 1024 + 256;
constexpr size_t CTL_H2 = 1 * MiB;
constexpr size_t CTL_BAR = 2 * MiB;
constexpr size_t CTL_BAR_BYTES = 40960;
constexpr int LDS_BARST = LDS_BYTES - 64;
constexpr size_t WS_W = 4 * MiB;
constexpr size_t W_IN = WS_W;
constexpr size_t W_OA = W_IN + (size_t)INC * DM * 2;
constexpr size_t W_OUT = W_OA + 3 * (size_t)DM * 512 * 2;
constexpr size_t W_13 = W_OUT + (size_t)DM * DM * 2;
constexpr size_t W_2 = W_13 + (size_t)2 * DFF * DM * 2;
constexpr size_t WS_XB = 39 * MiB;
constexpr size_t WS_QA = 71 * MiB;
constexpr size_t WS_OB = 87 * MiB;
constexpr size_t WS_QC = 103 * MiB;
constexpr size_t WS_G = 119 * MiB;
constexpr size_t G_KA = WS_G, G_VA = WS_G + 4 * MiB, G_HY = WS_G + 8 * MiB, G_KC = WS_G + 56 * MiB, G_VC = WS_G + 72 * MiB;
constexpr size_t WS_S = 207 * MiB;
constexpr size_t WS_XB8 = 239 * MiB;
constexpr size_t CTL_FCTA = 3 * MiB + 512 * 1024;
constexpr size_t WS_ROWSSA = 2 * MiB + 512 * 1024;
constexpr size_t WS_ROWSSB = 3 * MiB;
constexpr size_t WS_END = 255 * MiB + 512 * 1024;
constexpr size_t CTL_CS = 3 * MiB + 768 * 1024;
constexpr size_t CS_IN = CTL_CS, CS_G = CTL_CS + 16384, CS_13 = CTL_CS + 32768;
constexpr int CTLW_XQCNT = 8192;
constexpr size_t WS_XSLOT = 255 * MiB;
constexpr int CTLW_W13MAX = 4096 + 256;
constexpr int CTLW_GWMAX = 4096;
static_assert(W_2 + (size_t)DM * DFF * 2 <= WS_XB, "weights fit");

struct Params {
    const float* in[31];
    float* out;
    unsigned char* ws;
    int lo, hi, coop, pad;
};
enum { I_X = 0, I_N1G, I_WIN, I_SINK, I_QNA, I_KNA, I_CONVW, I_CONVB, I_FW1, I_FB1, I_FF1, I_FW2, I_FB2, I_FF2, I_FW3, I_HYD, I_QNC, I_KNC, I_LQ1, I_LK1, I_LQ2, I_LK2, I_SUBLN,
       I_WOA, I_WOB, I_WOC, I_WOUT, I_N2G, I_FFW1, I_FFW3, I_FFW2 };

__device__ __forceinline__ unsigned pk2(float lo, float hi) { f32x2 v = {lo, hi}; bf16x2_t b = __builtin_convertvector(v, bf16x2_t); return __builtin_bit_cast(unsigned, b); }
__device__ __forceinline__ float bf2f(unsigned short b) { return __uint_as_float(((unsigned)b) << 16); }
__device__ __forceinline__ float bflo(unsigned w) { return __uint_as_float(w << 16); }
__device__ __forceinline__ float bfhi(unsigned w) { return __uint_as_float(w & 0xffff0000u); }
__device__ __forceinline__ unsigned short f2bf(float f) { return (unsigned short)(pk2(f, 0.f) & 0xffffu); }
__device__ __forceinline__ size_t opaque_zero() { unsigned z = 0; asm volatile("" : "+s"(z)); return (size_t)z; }
__device__ __forceinline__ float wave_sum(float v) {
#pragma unroll
    for (int o = 1; o < 64; o <<= 1) v += __shfl_xor(v, o);
    return v;
}
__device__ __forceinline__ void rows_rstd8(const float* rowss, int row0, float (&rs)[8]) {
    f32x4 q[8];
#pragma unroll
    for (int k = 0; k < 8; ++k) q[k] = *(const f32x4*)(rowss + (size_t)(row0 + (k >> 2) * 128 + (k & 3) * 16) * 4);
#pragma unroll
    for (int k = 0; k < 8; ++k) rs[k] = rsqrtf(((q[k][0] + q[k][1]) + (q[k][2] + q[k][3])) * (1.f / DM) + RMS_EPS);
}
__device__ __forceinline__ void rows_rstd8_lds(LAS const float* p, int fr, float (&rs)[8]) {
    f32x4 q[8];
#pragma unroll
    for (int k = 0; k < 8; ++k) q[k] = *(LAS const f32x4*)(p + (k >> 2) * 256 + ((k & 3) * 16 + fr) * 4);
#pragma unroll
    for (int k = 0; k < 8; ++k) rs[k] = rsqrtf(((q[k][0] + q[k][1]) + (q[k][2] + q[k][3])) * (1.f / DM) + RMS_EPS);
}
__device__ __forceinline__ int crow(int r, int hi) { return (r & 3) + 8 * (r >> 2) + 4 * hi; }

namespace pg8 {
constexpr int BM = 256, BK = 64, HALF = 128, HTB = HALF * BK * 2, STAGE_BYTES = 8 * HTB, NXCD = 8, WGM = 8;
constexpr int CS_OFF = STAGE_BYTES + 4096 + 8192;
constexpr int RS_OFF = STAGE_BYTES + 4096;
__host__ __device__ __forceinline__ int lds_byte(int r, int c) { const int st = (r >> 4) * 2 + (c >> 5), rr = r & 15, cc = c & 31, ob = rr * 64 + cc * 2; return st * 1024 + (ob ^ (((ob >> 9) & 1) << 5)); }
__host__ __device__ __forceinline__ void stage_rc(int b, int& R, int& C) { const int st = b / 1024, sb = b % 1024, swz = sb ^ (((sb >> 9) & 1) << 5); R = (st >> 1) * 16 + swz / 64; C = (st & 1) * 32 + (swz % 64) / 2; }
__host__ __device__ __forceinline__ int perm32(int rho) { const int n = rho >> 4, i = rho & 15; return 8 * (i >> 2) + 4 * n + (i & 3); }

struct Unit { int pm, pn, sub, half; };
struct Gemm { const bf16_t* A; const bf16_t* Bt; int M, N, K; size_t sA, sB; };

struct StaticOrder {
    int nM, nN, nwg, G, c;
    __host__ __device__ void init(int M, int N, int G_, int c_) { nM = M / BM; nN = N / BM; nwg = nM * nN; G = G_; c = c_; }
    __host__ __device__ void map(int L, Unit& u) const {
        int wgid = L; { const int q = nwg / NXCD, r = nwg % NXCD, xcd = wgid % NXCD, off = wgid / NXCD; wgid = (xcd < r ? xcd * (q + 1) : r * (q + 1) + (xcd - r) * q) + off; }
        const int nig = WGM * nN, gid = wgid / nig, fm = gid * WGM, gsz = (nM - fm) < WGM ? (nM - fm) : WGM;
        u.pm = fm + ((wgid % nig) % gsz); u.pn = (wgid % nig) / gsz; u.sub = 0; u.half = 0;
    }
    __host__ __device__ bool next(int i, Unit& u) const {
        const long L = (long)i * G + c; if (L >= nwg) return false;
        map((int)L, u); return true;
    }
};
struct TailSplitOrder {
    StaticOrder S; int full, rem;
    __device__ __forceinline__ void init(int M, int N, int G_, int c_) { S.init(M, N, G_, c_); full = (S.nwg / G_) * G_; rem = S.nwg - full; }
    __device__ __forceinline__ bool next(int i, Unit& u) const {
        const long L = (long)i * S.G + S.c;
        if (2 * rem != S.G || L < full) return S.next(i, u);
        if (i != full / S.G) return false;
        S.map(full + (S.c >> 1), u); u.half = 1 + (S.c & 1); return true;
    }
};
struct ChainOrder3 {
    StaticOrder S;
    __device__ __forceinline__ bool next(int i, Unit& u) const { const int q = i / 3; if (!S.next(q, u)) return false; u.sub = i - 3 * q; return true; }
};

typedef f32x4 Acc[2][2][4][2];
typedef int i32x4v __attribute__((ext_vector_type(4)));

template <class Epi, class Sched, bool ALIGN_EPI, bool SP2, bool ZERO, bool HALF_OK = false, bool I8 = false>
__device__ __forceinline__ void gemm_phase(LAS unsigned char* lds, const int tid, const Gemm g, const Sched& S, Epi& E, Acc& acc) {
    const int wid = __builtin_amdgcn_readfirstlane(tid >> 6), lane = tid & 63, wr = wid >> 2, wc = wid & 3, fr = lane & 15, fq = lane >> 4;
    constexpr int ES = I8 ? 1 : 2;
    const int K = g.K, nt = K * ES / (BK * 2);
    unsigned voffA[2], voffB[2];
#pragma unroll
    for (int i = 0; i < 2; ++i) { int R, C; stage_rc(tid * 16 + i * 8192, R, C); const int Rb = Epi::PERM ? ((R & ~31) + perm32(R & 31)) : R;
        voffA[i] = (unsigned)(R * K * ES + C * 2); voffB[i] = (unsigned)(Rb * K * ES + C * 2); }
    const size_t kstep = (size_t)(BK * 2);
    const size_t hstep = (size_t)HALF * K * ES;
    const size_t tstep = 2 * hstep;
    const unsigned ldsw = (unsigned)wid * 1024u;
    const int aoff = lds_byte(wr * 64 + fr, fq * 8), boff = lds_byte(wc * 32 + fr, fq * 8);
#define PG8_SA(b, h) (((b) * 2 + (h)) * HTB)
#define PG8_SB(b, h) ((4 + (b) * 2 + (h)) * HTB)
#define PG8_STAGE(bufoff, gbase, voff) do { _Pragma("unroll") for (int _i = 0; _i < 2; ++_i) \
        __builtin_amdgcn_global_load_lds((const unsigned*)((const char*)(gbase) + (voff)[_i]), (LAS unsigned*)(lds + (bufoff) + ldsw + _i * 8192), 16, 0, 0); } while (0)
#define PG8_LDA(dst, b, h) do { _Pragma("unroll") for (int m = 0; m < 4; ++m) _Pragma("unroll") for (int k = 0; k < 2; ++k) dst[m][k] = *(const LAS bf16x8*)(lds + PG8_SA(b, h) + aoff + m * 2048 + k * 1024); } while (0)
#define PG8_LDB(dst, b, h) do { _Pragma("unroll") for (int n = 0; n < 2; ++n) _Pragma("unroll") for (int k = 0; k < 2; ++k) dst[n][k] = *(const LAS bf16x8*)(lds + PG8_SB(b, h) + boff + n * 2048 + k * 1024); } while (0)
#define PG8_MMA(ai, bj, At, Bt) do { __builtin_amdgcn_s_setprio(1); _Pragma("unroll") for (int m = 0; m < 4; ++m) _Pragma("unroll") for (int n = 0; n < 2; ++n) { \
        _Pragma("unroll") for (int k = 0; k < 2; ++k) { \
        if constexpr (I8) acc[ai][bj][m][n] = __builtin_bit_cast(f32x4, __builtin_amdgcn_mfma_i32_16x16x64_i8(__builtin_bit_cast(i32x4v, Bt[n][k]), __builtin_bit_cast(i32x4v, At[m][k]), __builtin_bit_cast(i32x4v, acc[ai][bj][m][n]), 0, 0, 0)); \
        else acc[ai][bj][m][n] = __builtin_amdgcn_mfma_f32_16x16x32_bf16(Bt[n][k], At[m][k], acc[ai][bj][m][n], 0, 0, 0); } } \
        __builtin_amdgcn_s_setprio(0); } while (0)
#define PG8_WAIT_V(n) asm volatile("s_waitcnt vmcnt(" #n ")" ::: "memory")
#define PG8_WAIT_L(n) asm volatile("s_waitcnt lgkmcnt(" #n ")" ::: "memory")
#define PG8_BAR __builtin_amdgcn_s_barrier()
#define PG8_SCHED __builtin_amdgcn_sched_barrier(0)
#define PG8_ZERO_ACC() do { _Pragma("unroll") for (int a = 0; a < 2; ++a) _Pragma("unroll") for (int b = 0; b < 2; ++b) _Pragma("unroll") for (int m = 0; m < 4; ++m) _Pragma("unroll") for (int n = 0; n < 2; ++n) acc[a][b][m][n] = (f32x4){0.f, 0.f, 0.f, 0.f}; } while (0)
#define PG8_RS_LOAD(un, par) do { if constexpr (Epi::RS_LDS) { if (wc == 0) { _Pragma("unroll") for (int _a = 0; _a < 2; ++_a) \
        __builtin_amdgcn_global_load_lds((const unsigned*)(E.rowss + (size_t)((un).pm * 256 + _a * 128 + wr * 64 + lane) * 4), (LAS unsigned*)(lds + RS_OFF + (par) * 4096 + wr * 2048 + _a * 1024), 16, 0, 0); } } } while (0)
#define PG8_CS_LOAD(un, par) do { if constexpr (Epi::CS_LDS) { if (wid == 1) \
        __builtin_amdgcn_global_load_lds((const unsigned*)(E.cs_ptr(un) + 4 * lane), (LAS unsigned*)(lds + CS_OFF + (par) * 1024), 16, 0, 0); } } while (0)
    Unit cur, nxt; int ui = 0;
    if (!S.next(0, cur)) return;
    if (ZERO) PG8_ZERO_ACC();
    PG8_RS_LOAD(cur, 0); PG8_CS_LOAD(cur, 0);
    bf16x8 At[4][2], B0[2][2], B1[2][2];
    const char* cA = (const char*)g.A + (size_t)cur.sub * g.sA + (size_t)cur.pm * tstep; const char* cB = (const char*)g.Bt + (size_t)cur.sub * g.sB + (size_t)cur.pn * tstep;
    if constexpr (SP2) {
        PG8_STAGE(PG8_SB(0, 0), cB, voffB); PG8_STAGE(PG8_SB(0, 1), cB + hstep, voffB); PG8_STAGE(PG8_SA(0, 0), cA, voffA); PG8_STAGE(PG8_SA(0, 1), cA + hstep, voffA);
        if (wr == 1) PG8_BAR;
        PG8_WAIT_V(2); PG8_BAR;
        PG8_STAGE(PG8_SB(1, 0), cB + kstep, voffB); PG8_STAGE(PG8_SA(1, 0), cA + kstep, voffA); PG8_STAGE(PG8_SB(1, 1), cB + hstep + kstep, voffB);
        PG8_WAIT_V(6); PG8_BAR;
    } else {
        PG8_STAGE(PG8_SB(0, 0), cB, voffB); PG8_STAGE(PG8_SA(0, 0), cA, voffA); PG8_STAGE(PG8_SB(0, 1), cB + hstep, voffB); PG8_STAGE(PG8_SA(0, 1), cA + hstep, voffA);
        if (wr == 1) PG8_BAR;
        PG8_WAIT_V(4); PG8_BAR;
        PG8_STAGE(PG8_SB(1, 0), cB + kstep, voffB); PG8_STAGE(PG8_SA(1, 0), cA + kstep, voffA); PG8_STAGE(PG8_SB(1, 1), cB + hstep + kstep, voffB);
        PG8_WAIT_V(6); PG8_BAR;
    }
    for (;;) {
        const bool has_next = S.next(ui + 1, nxt);
        const char* nA = has_next ? (const char*)g.A + (size_t)nxt.sub * g.sA + (size_t)nxt.pm * tstep : cA; const char* nB = has_next ? (const char*)g.Bt + (size_t)nxt.sub * g.sB + (size_t)nxt.pn * tstep : cB;
        const bool do0 = !HALF_OK || cur.half != 2, do1 = !HALF_OK || cur.half != 1;
#pragma unroll 1
        for (int t = 0; t < nt; t += 2) {
            const bool last = (t == nt - 2);
            const char* a1 = cA + (size_t)(t + 1) * kstep;
            const char* a2 = last ? nA : cA + (size_t)(t + 2) * kstep; const char* b2 = last ? nB : cB + (size_t)(t + 2) * kstep;
            const char* a3 = a2 + kstep; const char* b3 = b2 + kstep;
            if constexpr (SP2) {
            PG8_LDB(B0, 0, 0); PG8_LDB(B1, 0, 1); PG8_SCHED; if (do0) PG8_LDA(At, 0, 0); PG8_STAGE(PG8_SA(1, 1), a1 + hstep, voffA);
            PG8_WAIT_V(8); PG8_WAIT_L(0); PG8_BAR; if (do0) { PG8_MMA(0, 0, At, B0); PG8_MMA(0, 1, At, B1); } PG8_BAR; PG8_SCHED;
            if (do1) PG8_LDA(At, 0, 1); PG8_STAGE(PG8_SB(0, 0), b2, voffB); PG8_STAGE(PG8_SB(0, 1), b2 + hstep, voffB); PG8_STAGE(PG8_SA(0, 0), a2, voffA);
            PG8_WAIT_V(8); PG8_WAIT_L(0); PG8_BAR; if (do1) { PG8_MMA(1, 0, At, B0); PG8_MMA(1, 1, At, B1); } PG8_BAR; PG8_SCHED;
            PG8_LDB(B0, 1, 0); PG8_LDB(B1, 1, 1); PG8_SCHED; if (do0) PG8_LDA(At, 1, 0); PG8_STAGE(PG8_SA(0, 1), a2 + hstep, voffA);
            PG8_WAIT_V(8); PG8_WAIT_L(0); PG8_BAR; if (do0) { PG8_MMA(0, 0, At, B0); PG8_MMA(0, 1, At, B1); } PG8_BAR; PG8_SCHED;
            if (do1) PG8_LDA(At, 1, 1); PG8_STAGE(PG8_SB(1, 0), b3, voffB); PG8_STAGE(PG8_SB(1, 1), b3 + hstep, voffB); PG8_STAGE(PG8_SA(1, 0), a3, voffA);
            PG8_WAIT_V(8); PG8_WAIT_L(0); PG8_BAR; if (do1) { PG8_MMA(1, 0, At, B0); PG8_MMA(1, 1, At, B1); } PG8_BAR; PG8_SCHED;
            } else {
            PG8_LDB(B0, 0, 0); PG8_SCHED; PG8_LDA(At, 0, 0); PG8_STAGE(PG8_SA(1, 1), a1 + hstep, voffA);
            PG8_WAIT_L(8); PG8_BAR; PG8_WAIT_L(0); PG8_MMA(0, 0, At, B0); PG8_BAR; PG8_SCHED;
            PG8_LDB(B1, 0, 1); PG8_STAGE(PG8_SB(0, 0), b2, voffB);
            PG8_BAR; PG8_WAIT_L(0); PG8_MMA(0, 1, At, B1); PG8_BAR;
            PG8_LDA(At, 0, 1); PG8_STAGE(PG8_SA(0, 0), a2, voffA);
            PG8_BAR; PG8_WAIT_L(0); PG8_MMA(1, 0, At, B0); PG8_BAR; PG8_SCHED;
            PG8_STAGE(PG8_SB(0, 1), b2 + hstep, voffB);
            PG8_WAIT_V(6); PG8_BAR; PG8_MMA(1, 1, At, B1); PG8_BAR;
            PG8_LDB(B0, 1, 0); PG8_SCHED; PG8_LDA(At, 1, 0); PG8_STAGE(PG8_SA(0, 1), a2 + hstep, voffA);
            PG8_WAIT_L(8); PG8_BAR; PG8_WAIT_L(0); PG8_MMA(0, 0, At, B0); PG8_BAR; PG8_SCHED;
            PG8_LDB(B1, 1, 1); PG8_STAGE(PG8_SB(1, 0), b3, voffB);
            PG8_BAR; PG8_WAIT_L(0); PG8_MMA(0, 1, At, B1); PG8_BAR;
            PG8_LDA(At, 1, 1); PG8_STAGE(PG8_SA(1, 0), a3, voffA);
            PG8_BAR; PG8_WAIT_L(0); PG8_MMA(1, 0, At, B0); PG8_BAR; PG8_SCHED;
            PG8_STAGE(PG8_SB(1, 1), b3 + hstep, voffB);
            PG8_WAIT_V(6); PG8_BAR; PG8_MMA(1, 1, At, B1); PG8_BAR;
            }
        }
        if constexpr (ALIGN_EPI) { if (wr == 0) PG8_BAR; }
        if constexpr (Epi::RS_LDS) E.rsl = (LAS const float*)(lds + RS_OFF + (ui & 1) * 4096 + wr * 2048);
        if constexpr (Epi::CS_LDS) E.csl = (LAS const float*)(lds + CS_OFF + (ui & 1) * 1024);
        const bool keep = E(acc, cur, wr, wc, fr, fq);
        if (!has_next) break;
        if (!keep) PG8_ZERO_ACC();
        cur = nxt; cA = nA; cB = nB; ++ui;
        PG8_RS_LOAD(cur, ui & 1); PG8_CS_LOAD(cur, ui & 1);
        if constexpr (ALIGN_EPI) { if (wr == 1) PG8_BAR; }
    }
    PG8_WAIT_V(0);
    if constexpr (!ALIGN_EPI) { if (wr == 0) PG8_BAR; }
    PG8_BAR;
#undef PG8_SA
#undef PG8_SB
#undef PG8_STAGE
#undef PG8_LDA
#undef PG8_LDB
#undef PG8_MMA
#undef PG8_WAIT_V
#undef PG8_WAIT_L
#undef PG8_BAR
#undef PG8_SCHED
#undef PG8_ZERO_ACC
#undef PG8_RS_LOAD
#undef PG8_CS_LOAD
}
}

#define XB_TMO      128
#define XB_XCNT(j)  (256  + 64 * (j))
#define XB_XSUB(j)  (1280 + 64 * (j))
#define XB_XGEN(j)  (2304 + 64 * (j))
#define XB_TOP      3328
#define XB_TOPGEN   3392
#define XCD_BAR_WORDS 3456
#define XB_SPIN_CAP (1u << 18)
__device__ __forceinline__ unsigned xb_ld(unsigned* p)              { return __hip_atomic_load(p, __ATOMIC_RELAXED, __HIP_MEMORY_SCOPE_AGENT); }
__device__ __forceinline__ unsigned xb_add(unsigned* p, unsigned v) { return __hip_atomic_fetch_add(p, v, __ATOMIC_RELAXED, __HIP_MEMORY_SCOPE_AGENT); }
__device__ __forceinline__ unsigned xb_xcc_id() { return (unsigned)__builtin_amdgcn_s_getreg((3 << 11) | 20) & 0xFu; }
#define XB_SPIN(cond, bar) do { unsigned _sp = 0; while (cond) { __builtin_amdgcn_s_sleep(1); \
    if ((++_sp & 255u) == 0u) { if (xb_ld(&(bar)[XB_TMO])) break; if (_sp > XB_SPIN_CAP) { atomicAdd(&(bar)[XB_TMO], 1u); break; } } } } while (0)
__device__ __forceinline__ unsigned q8(float t) { return __builtin_bit_cast(unsigned, __builtin_amdgcn_fmed3f(t, -127.f, 127.f) + 12582912.f); }
struct EpiInProj {
    static constexpr bool PERM = true, RS_LDS = true, CS_LDS = false;
    LAS const float* rsl;
    const float* rowss; const unsigned* csT; const unsigned* gp;
    bf16_t *QA, *KA, *VA, *QC, *KC, *VC, *HY;
    __device__ __forceinline__ bool operator()(pg8::Acc& acc, const pg8::Unit& u, int wr, int wc, int fr, int fq) const {
        const int g = 4 * u.pn + wc;
        int kind, ld, hd, gty = 0; bf16_t* dst;
        if (g < 8)       { kind = 2; dst = QA; ld = 512; hd = g; gty = 0; }
        else if (g < 10) { kind = 1; dst = KA; ld = 128; hd = g - 8; gty = 1; }
        else if (g < 12) { kind = 0; dst = VA; ld = 128; hd = g - 10; }
        else if (g < 20) { kind = 2; dst = QC; ld = 512; hd = g - 12; gty = 2; }
        else if (g < 28) { kind = 1; dst = KC; ld = 512; hd = g - 20; gty = 3; }
        else if (g < 36) { kind = 0; dst = VC; ld = 512; hd = g - 28; }
        else             { kind = 0; dst = HY; ld = 1536; hd = g - 36; }
        const int col0 = 64 * hd + 8 * fq;
        const float qs = (kind == 2) ? QSCALE : 1.f;
        float rs8[8]; rows_rstd8_lds(rsl, fr, rs8);
        const int rowb = u.pm * 256 + wr * 64 + fr;
        if (kind == 0) {
#pragma unroll
            for (int ai = 0; ai < 2; ++ai)
#pragma unroll
                for (int m = 0; m < 4; ++m) {
                    const int row = rowb + ai * 128 + m * 16;
                    const float rstd = rs8[ai * 4 + m];
                    const f32x4 a0 = acc[ai][0][m][0] * rstd, a1 = acc[ai][0][m][1] * rstd, b0 = acc[ai][1][m][0] * rstd, b1 = acc[ai][1][m][1] * rstd;
                    u32x4 wa, wb;
                    wa.x = pk2(a0[0], a0[1]); wa.y = pk2(a0[2], a0[3]); wa.z = pk2(a1[0], a1[1]); wa.w = pk2(a1[2], a1[3]);
                    wb.x = pk2(b0[0], b0[1]); wb.y = pk2(b0[2], b0[3]); wb.z = pk2(b1[0], b1[1]); wb.w = pk2(b1[2], b1[3]);
                    if (g >= 36) {
                        bf16_t* rp = dst + ((size_t)(8 * hd + fq) * MTOK + row) * 8;
                        *(u32x4*)rp = wa; *(u32x4*)(rp + (size_t)4 * MTOK * 8) = wb;
                    } else {
                        bf16_t* rp = dst + (size_t)row * ld + col0;
                        *(u32x4*)rp = wa; *(u32x4*)(rp + 32) = wb;
                    }
                }
        } else {
            const u32x4 gq0 = *(const u32x4*)(gp + gty * 32 + 8 * fq), gq1 = *(const u32x4*)(gp + gty * 32 + 8 * fq + 4);
            u32x4 cs[2][2];
            { const unsigned* cp = csT + (rowb & (SEQ - 1)) * 32 + 8 * fq; cs[0][0] = *(const u32x4*)cp; cs[0][1] = *(const u32x4*)(cp + 4); }
#pragma unroll
            for (int it = 0; it < 8; ++it) {
                const int ai = it >> 2, m = it & 3;
                const int row = rowb + ai * 128 + m * 16;
                if (it + 1 < 8) { const int nrow = rowb + ((it + 1) >> 2) * 128 + ((it + 1) & 3) * 16; const unsigned* cp = csT + (nrow & (SEQ - 1)) * 32 + 8 * fq;
                    cs[(it + 1) & 1][0] = *(const u32x4*)cp; cs[(it + 1) & 1][1] = *(const u32x4*)(cp + 4); }
                const float rstd = rs8[it];
                float ss = 0.f;
#pragma unroll
                for (int n = 0; n < 2; ++n)
#pragma unroll
                    for (int i = 0; i < 4; ++i) { const float x = acc[ai][0][m][n][i], y = acc[ai][1][m][n][i]; ss += x * x + y * y; }
                ss += __shfl_xor(ss, 16); ss += __shfl_xor(ss, 32);
                const float f = rstd * rsqrtf(ss * rstd * rstd * (1.f / 64.f) + RMS_EPS) * qs;
                u32x4 wa, wb;
#pragma unroll
                for (int n = 0; n < 2; ++n) {
                    const u32x4 gq = n ? gq1 : gq0, cq = cs[it & 1][n];
                    float ra[4], rb[4];
#pragma unroll
                    for (int i = 0; i < 4; ++i) {
                        const float ga = (float)__builtin_bit_cast(_Float16, (unsigned short)(gq[i] & 0xffffu)), gb = (float)__builtin_bit_cast(_Float16, (unsigned short)(gq[i] >> 16));
                        const float c = (float)__builtin_bit_cast(_Float16, (unsigned short)(cq[i] & 0xffffu)), sn = (float)__builtin_bit_cast(_Float16, (unsigned short)(cq[i] >> 16));
                        const float x = acc[ai][0][m][n][i] * (f * ga), y = acc[ai][1][m][n][i] * (f * gb);
                        ra[i] = x * c - y * sn; rb[i] = y * c + x * sn;
                    }
                    if (n == 0) { wa.x = pk2(ra[0], ra[1]); wa.y = pk2(ra[2], ra[3]); wb.x = pk2(rb[0], rb[1]); wb.y = pk2(rb[2], rb[3]); }
                    else        { wa.z = pk2(ra[0], ra[1]); wa.w = pk2(ra[2], ra[3]); wb.z = pk2(rb[0], rb[1]); wb.w = pk2(rb[2], rb[3]); }
                }
                bf16_t* rp = dst + (size_t)row * ld + col0;
                *(u32x4*)rp = wa; *(u32x4*)(rp + 32) = wb;
                asm volatile("" ::: "memory");
            }
        }
        return false;
    }
};

#ifndef MERGE_PD
#define MERGE_PD 2
#endif
__device__ __forceinline__ unsigned gate_q(float a) {
    const float t = __builtin_amdgcn_fmed3f(__builtin_fmaf(__builtin_amdgcn_exp2f(a), 1.f / 255.f, 1.f / 255.f), 0.f, 1.f);
    return __builtin_bit_cast(unsigned, __builtin_amdgcn_rcpf(t) + 8388608.f);
}
__device__ __forceinline__ unsigned pack_b0(unsigned u0, unsigned u1, unsigned u2, unsigned u3) {
    return __builtin_amdgcn_perm(__builtin_amdgcn_perm(u3, u2, 0x0c0c0400u), __builtin_amdgcn_perm(u1, u0, 0x0c0c0400u), 0x05040100u);
}
struct EpiGate {
    static constexpr bool PERM = true, RS_LDS = true, CS_LDS = true;
    LAS const float* rsl; LAS const float* csl;
    int tid; const float* rowss; const float* cs; u32x4* scr0;
    __device__ __forceinline__ const float* cs_ptr(const pg8::Unit& u) const { return cs + u.sub * DM + u.pn * 256; }
    __device__ __forceinline__ bool operator()(pg8::Acc& acc, const pg8::Unit& u, int wr, int wc, int fr, int fq) const {
        u32x4* scr = scr0 + ((size_t)(u.pm * 4 + u.pn) * 3 + u.sub) * 8 * 512 + tid;
        float rs8[8];
#pragma unroll
        for (int k = 0; k < 8; ++k) rs8[k] = rsl[(k >> 2) * 256 + ((k & 3) * 16 + fr) * 4];
        f32x4 cq[2][2];
#pragma unroll
        for (int bj = 0; bj < 2; ++bj)
#pragma unroll
            for (int n = 0; n < 2; ++n) cq[bj][n] = *(const LAS f32x4*)(csl + bj * 128 + wc * 32 + 8 * fq + 4 * n) * (-LOG2E);
#pragma unroll
        for (int ai = 0; ai < 2; ++ai)
#pragma unroll
            for (int m = 0; m < 4; ++m) {
                const float rs = rs8[ai * 4 + m];
                unsigned pw[4];
#pragma unroll
                for (int bj = 0; bj < 2; ++bj) {
                    const pg8::i32x4v i0 = __builtin_bit_cast(pg8::i32x4v, acc[ai][bj][m][0]), i1 = __builtin_bit_cast(pg8::i32x4v, acc[ai][bj][m][1]);
                    const f32x4 v0 = (f32x4){(float)i0[0], (float)i0[1], (float)i0[2], (float)i0[3]} * cq[bj][0], v1 = (f32x4){(float)i1[0], (float)i1[1], (float)i1[2], (float)i1[3]} * cq[bj][1];
                    pw[bj * 2] = pack_b0(gate_q(v0[0] * rs), gate_q(v0[1] * rs), gate_q(v0[2] * rs), gate_q(v0[3] * rs));
                    pw[bj * 2 + 1] = pack_b0(gate_q(v1[0] * rs), gate_q(v1[1] * rs), gate_q(v1[2] * rs), gate_q(v1[3] * rs));
                }
                u32x4 w; w.x = pw[0]; w.y = pw[1]; w.z = pw[2]; w.w = pw[3];
                scr[(size_t)(ai * 4 + m) * 512] = w;
            }
        return false;
    }
};
__device__ __forceinline__ float ub(unsigned w, int k) { return (float)((w >> (8 * k)) & 0xffu); }
struct EpiMerge {
    static constexpr bool PERM = true, RS_LDS = false, CS_LDS = false;
    static constexpr int PD = MERGE_PD;
    int tid; const u32x4* scr0; bf16_t* merged;
    __device__ __forceinline__ bool operator()(pg8::Acc& acc, const pg8::Unit& u, int wr, int wc, int fr, int fq) const {
        const int sub = u.sub;
        const u32x4* sa_p = scr0 + ((size_t)(u.pm * 4 + u.pn) * 3 + sub) * 8 * 512 + tid;
        u32x4 wa[8], wb[8];
#pragma unroll
        for (int it = 0; it < PD; ++it) { wa[it] = sa_p[(size_t)it * 512]; if (sub < 2) wb[it] = sa_p[(size_t)(8 + it) * 512]; }
#pragma unroll
        for (int it = 0; it < 8; ++it) {
            const int ai = it >> 2, m = it & 3;
            const int row = u.pm * 256 + ai * 128 + wr * 64 + m * 16 + fr;
            if (it + PD < 8) { wa[it + PD] = sa_p[(size_t)(it + PD) * 512]; if (sub < 2) wb[it + PD] = sa_p[(size_t)(8 + it + PD) * 512]; }
#pragma unroll
            for (int bj = 0; bj < 2; ++bj) {
                f32x4& v0 = acc[ai][bj][m][0]; f32x4& v1 = acc[ai][bj][m][1];
                const unsigned a0 = bj ? wa[it].z : wa[it].x, a1 = bj ? wa[it].w : wa[it].y;
                if (sub < 2) {
                    const unsigned b0 = bj ? wb[it].z : wb[it].x, b1 = bj ? wb[it].w : wb[it].y;
#pragma unroll
                    for (int i = 0; i < 4; ++i) { v0[i] *= ub(a0, i) * __builtin_amdgcn_rcpf(ub(b0, i)); v1[i] *= ub(a1, i) * __builtin_amdgcn_rcpf(ub(b1, i)); }
                } else {
                    constexpr float C = 1.f / 255.f;
                    u32x4 w; w.x = pk2(v0[0] * (ub(a0, 0) * C), v0[1] * (ub(a0, 1) * C)); w.y = pk2(v0[2] * (ub(a0, 2) * C), v0[3] * (ub(a0, 3) * C));
                    w.z = pk2(v1[0] * (ub(a1, 0) * C), v1[1] * (ub(a1, 1) * C)); w.w = pk2(v1[2] * (ub(a1, 2) * C), v1[3] * (ub(a1, 3) * C));
                    *(u32x4*)(merged + (size_t)row * DM + u.pn * 256 + bj * 128 + wc * 32 + 8 * fq) = w;
                }
            }
            asm volatile("" ::: "memory");
        }
        return sub < 2;
    }
};

template <bool FINAL> struct EpiResid {
    static constexpr bool PERM = true, RS_LDS = false, CS_LDS = false;
    bf16_t* xb; float* xout; float* rowss; bool dry; LAS float* red; int tid;
    unsigned char* xq; float* fct; unsigned long long* xslot; unsigned* xcnt; unsigned* bar; unsigned want;
    __device__ __forceinline__ bool operator()(pg8::Acc& acc, const pg8::Unit& u, int wr, int wc, int fr, int fq) const {
        if (dry) return false;
        const bool qz = !FINAL && xq != nullptr;
#pragma unroll
        for (int ai = 0; ai < 2; ++ai)
#pragma unroll
            for (int m = 0; m < 4; ++m) {
                const int row = u.pm * 256 + ai * 128 + wr * 64 + m * 16 + fr;
                float ss = 0.f, am = 0.f;
#pragma unroll
                for (int bj = 0; bj < 2; ++bj) {
                    const size_t off = (size_t)row * DM + u.pn * 256 + bj * 128 + wc * 32 + 8 * fq;
                    const u32x4 xo = *(const u32x4*)(xb + off);
                    const f32x4 a0 = acc[ai][bj][m][0], a1 = acc[ai][bj][m][1];
                    float xn[8] = {bflo(xo.x) + a0[0], bfhi(xo.x) + a0[1], bflo(xo.y) + a0[2], bfhi(xo.y) + a0[3], bflo(xo.z) + a1[0], bfhi(xo.z) + a1[1], bflo(xo.w) + a1[2], bfhi(xo.w) + a1[3]};
                    if (FINAL) {
                        *(f32x4*)(xout + off) = (f32x4){xn[0], xn[1], xn[2], xn[3]}; *(f32x4*)(xout + off + 4) = (f32x4){xn[4], xn[5], xn[6], xn[7]};
                    } else {
                        u32x4 w; w.x = pk2(xn[0], xn[1]); w.y = pk2(xn[2], xn[3]); w.z = pk2(xn[4], xn[5]); w.w = pk2(xn[6], xn[7]);
                        *(u32x4*)(xb + off) = w;
                        const float r[8] = {bflo(w.x), bfhi(w.x), bflo(w.y), bfhi(w.y), bflo(w.z), bfhi(w.z), bflo(w.w), bfhi(w.w)};
#pragma unroll
                        for (int i = 0; i < 8; ++i) { ss += r[i] * r[i]; am = fmaxf(am, fabsf(r[i])); }
                        acc[ai][bj][m][0] = (f32x4){r[0], r[1], r[2], r[3]}; acc[ai][bj][m][1] = (f32x4){r[4], r[5], r[6], r[7]};
                    }
                }
                if (!FINAL) { ss += __shfl_xor(ss, 16); ss += __shfl_xor(ss, 32); am = fmaxf(am, __shfl_xor(am, 16)); am = fmaxf(am, __shfl_xor(am, 32));
                    if (fq == 0) { const int rl = ai * 128 + wr * 64 + m * 16 + fr; red[rl * 4 + wc] = ss; red[1024 + rl * 4 + wc] = am; } }
            }
        if (!FINAL) {
            asm volatile("s_waitcnt lgkmcnt(0)" ::: "memory"); __builtin_amdgcn_s_barrier(); asm volatile("" ::: "memory");
            if (tid < 256) { const f32x4 p = *(const LAS f32x4*)(red + tid * 4); const float st = (p[0] + p[1]) + (p[2] + p[3]);
                rowss[(size_t)(u.pm * 256 + tid) * 4 + u.pn] = st;
                if (qz) { const f32x4 a = *(const LAS f32x4*)(red + 1024 + tid * 4); const float at = fmaxf(fmaxf(a[0], a[1]), fmaxf(a[2], a[3]));
                    __hip_atomic_store(xslot + (size_t)(u.pm * 256 + tid) * 4 + u.pn, ((unsigned long long)__builtin_bit_cast(unsigned, at) << 32) | __builtin_bit_cast(unsigned, st), __ATOMIC_RELAXED, __HIP_MEMORY_SCOPE_AGENT); } }
            if (qz) {
                asm volatile("s_waitcnt vmcnt(0)" ::: "memory");
                if (tid < 256 && (tid & 63) == 0) (void)xb_add(xcnt + 16 * u.pm, 1u);
                if (tid == 0) XB_SPIN(xb_ld(xcnt + 16 * u.pm) < want, bar);
                asm volatile("s_waitcnt vmcnt(0) lgkmcnt(0)" ::: "memory"); __builtin_amdgcn_s_barrier(); asm volatile("" ::: "memory");
                if (tid < 256) {
                    const unsigned long long* sl = xslot + (size_t)(u.pm * 256 + tid) * 4; float st[4], at[4];
#pragma unroll
                    for (int t = 0; t < 4; ++t) { const unsigned long long w = __hip_atomic_load(sl + t, __ATOMIC_RELAXED, __HIP_MEMORY_SCOPE_AGENT); st[t] = __builtin_bit_cast(float, (unsigned)w); at[t] = __builtin_bit_cast(float, (unsigned)(w >> 32)); }
                    const float amax = fmaxf(fmaxf(at[0], at[1]), fmaxf(at[2], at[3]));
                    red[2048 + tid] = amax > 0.f ? 127.f / amax : 0.f;
                    if (u.pn == 0) *(f32x4*)(fct + (size_t)(u.pm * 256 + tid) * 4) = (f32x4){rsqrtf(((st[0] + st[1]) + (st[2] + st[3])) * (1.f / DM) + RMS_EPS) * amax * (1.f / 127.f), 0.f, 0.f, 0.f};
                }
                asm volatile("s_waitcnt lgkmcnt(0)" ::: "memory"); __builtin_amdgcn_s_barrier(); asm volatile("" ::: "memory");
#pragma unroll
                for (int ai = 0; ai < 2; ++ai)
#pragma unroll
                    for (int m = 0; m < 4; ++m) {
                        const int rl = ai * 128 + wr * 64 + m * 16 + fr; const float sc = red[2048 + rl];
#pragma unroll
                        for (int bj = 0; bj < 2; ++bj) {
                            const f32x4 v0 = acc[ai][bj][m][0] * sc, v1 = acc[ai][bj][m][1] * sc;
                            *(u32x2*)(xq + (size_t)(u.pm * 256 + rl) * DM + u.pn * 256 + bj * 128 + wc * 32 + 8 * fq) = (u32x2){pack_b0(q8(v0[0]), q8(v0[1]), q8(v0[2]), q8(v0[3])), pack_b0(q8(v1[0]), q8(v1[1]), q8(v1[2]), q8(v1[3]))};
                        }
                    }
            }
            asm volatile("s_waitcnt lgkmcnt(0)" ::: "memory"); __builtin_amdgcn_s_barrier(); asm volatile("" ::: "memory");
        }
        return false;
    }
};

struct EpiSwiGLU {
    static constexpr bool PERM = true, RS_LDS = true, CS_LDS = true;
    LAS const float* rsl; LAS const float* csl;
    const float* rowss; const float* cs; bf16_t* act; bool dry;
    __device__ __forceinline__ const float* cs_ptr(const pg8::Unit& u) const { return cs + u.pn * 256; }
    __device__ __forceinline__ bool operator()(pg8::Acc& acc, const pg8::Unit& u, int wr, int wc, int fr, int fq) const {
        if (dry) return false;
        float rs8[8];
#pragma unroll
        for (int k = 0; k < 8; ++k) rs8[k] = rsl[(k >> 2) * 256 + ((k & 3) * 16 + fr) * 4];
        f32x4 cq[2][2];
#pragma unroll
        for (int bj = 0; bj < 2; ++bj)
#pragma unroll
            for (int n = 0; n < 2; ++n) cq[bj][n] = *(const LAS f32x4*)(csl + bj * 128 + wc * 32 + 8 * fq + 4 * n);
#pragma unroll
        for (int ai = 0; ai < 2; ++ai) {
            if (u.half == 2 - ai) continue;
#pragma unroll
            for (int m = 0; m < 4; ++m) {
                const int row = u.pm * 256 + ai * 128 + wr * 64 + m * 16 + fr;
                const float rstd = rs8[ai * 4 + m];
                float o[8];
#pragma unroll
                for (int n = 0; n < 2; ++n) {
                    const pg8::i32x4v ia = __builtin_bit_cast(pg8::i32x4v, acc[ai][0][m][n]), ib = __builtin_bit_cast(pg8::i32x4v, acc[ai][1][m][n]);
#pragma unroll
                    for (int i = 0; i < 4; ++i) {
                        const float a = (float)ia[i] * (rstd * cq[0][n][i]), b = (float)ib[i] * (rstd * cq[1][n][i]);
                        o[4 * n + i] = a * __builtin_amdgcn_rcpf(1.f + __builtin_amdgcn_exp2f(-a * LOG2E)) * b;
                    }
                }
                u32x4 w; w.x = pk2(o[0], o[1]); w.y = pk2(o[2], o[3]); w.z = pk2(o[4], o[5]); w.w = pk2(o[6], o[7]);
                *(u32x4*)(act + (size_t)row * DFF + u.pn * 128 + wc * 32 + 8 * fq) = w;
            }
        }
        return false;
    }
};

struct XcdBarrier { unsigned* bar; unsigned x; volatile LAS unsigned* st; };
__device__ __forceinline__ XcdBarrier xcd_barrier_post(unsigned* bar, volatile LAS unsigned* st) {
    XcdBarrier b; b.bar = bar; b.x = xb_xcc_id(); b.st = st;
    if (threadIdx.x == 0) (void)xb_add(&bar[XB_XCNT(b.x)], 1u);
    return b;
}
__device__ __forceinline__ void xcd_barrier_complete(unsigned* bar, unsigned x, unsigned& nloc, unsigned& nx) {
    const unsigned G = gridDim.x * gridDim.y * gridDim.z;
    unsigned sum, cnt, mine, sp = 0u;
    for (;;) {
        sum = 0u; cnt = 0u; mine = 0u;
#pragma unroll
        for (unsigned j = 0; j < 16; ++j) { const unsigned c = xb_ld(&bar[XB_XCNT(j)]); sum += c; cnt += (c > 0u) ? 1u : 0u; mine = (j == x) ? c : mine; }
        if (sum == G) break;
        __builtin_amdgcn_s_sleep(1);
        if ((++sp & 255u) == 0u) { if (xb_ld(&bar[XB_TMO])) break; if (sp > XB_SPIN_CAP) { atomicAdd(&bar[XB_TMO], 1u); break; } }
    }
    nloc = mine > 0u ? mine : 1u; nx = cnt > 0u ? cnt : 1u;
}
__device__ __forceinline__ void xcd_barrier(const XcdBarrier& b) {
    asm volatile("s_waitcnt vmcnt(0)" ::: "memory");
    __syncthreads();
    if (threadIdx.x == 0) {
        unsigned* bar = b.bar;
        __builtin_amdgcn_s_waitcnt(0);
        unsigned nloc = b.st[0], nx = b.st[1];
        if (nloc == 0u) { xcd_barrier_complete(bar, b.x, nloc, nx); b.st[0] = nloc; b.st[1] = nx; }
        const unsigned old = xb_add(&bar[XB_XSUB(b.x)], 1u);
        const unsigned gen = old / nloc;
        if (old + 1u == (gen + 1u) * nloc) {
            __builtin_amdgcn_fence(__ATOMIC_RELEASE, "agent");
            asm volatile("s_waitcnt vmcnt(0)" ::: "memory");
            const unsigned og = xb_add(&bar[XB_TOP], 1u);
            const unsigned tg = og / nx;
            if (og + 1u == (tg + 1u) * nx) xb_add(&bar[XB_TOPGEN], 1u);
            else XB_SPIN(xb_ld(&bar[XB_TOPGEN]) == tg, bar);
            __builtin_amdgcn_fence(__ATOMIC_ACQUIRE, "agent");
            xb_add(&bar[XB_XGEN(b.x)], 1u);
            asm volatile("s_waitcnt vmcnt(0)" ::: "memory");
        } else {
            XB_SPIN(xb_ld(&bar[XB_XGEN(b.x)]) == gen, bar);
            __builtin_amdgcn_fence(__ATOMIC_ACQUIRE, "agent");
            asm volatile("s_waitcnt vmcnt(0)" ::: "memory");
        }
    }
    __syncthreads();
}

#define FUSE_XQ(F) ((F).G == (MTOK / 256) * (DM / 256))
struct Frame {
    LAS unsigned char* lds;
    int tid, lane, wave, G, bid;
    bool dry;
    const Params* P;
};

template <bool WANTMAX = false>
__device__ __forceinline__ float transpose_item(const float* W, int N, int k0, int n0, bf16_t* WT, int K, int drow_lo, int drow_hi, const float* gain, LAS float* scr, int lane) {
    float mx = 0.f;
#pragma unroll
    for (int h = 0; h < 2; ++h) {
        f32x4 v[8];
#pragma unroll
        for (int i = 0; i < 8; ++i) { const int kk = 4 * (8 * h + i) + (lane >> 4); v[i] = __builtin_nontemporal_load((const f32x4*)(W + (size_t)(k0 + kk) * N + n0 + 4 * (lane & 15))); }
#pragma unroll
        for (int i = 0; i < 8; ++i) { const int kk = 4 * (8 * h + i) + (lane >> 4); f32x4 w = v[i]; if (gain) w = w * gain[k0 + kk];
            if (WANTMAX) mx = fmaxf(mx, fmaxf(fmaxf(fabsf(w[0]), fabsf(w[1])), fmaxf(fabsf(w[2]), fabsf(w[3]))));
            LAS float* d = scr + kk * 65 + 4 * (lane & 15); d[0] = w[0]; d[1] = w[1]; d[2] = w[2]; d[3] = w[3]; }
    }
    asm volatile("s_waitcnt lgkmcnt(0)" ::: "memory");
    const int c = lane & 7;
#pragma unroll
    for (int j = 0; j < 8; ++j) { const int n = (lane >> 3) + 8 * j; const LAS float* s = scr + (8 * c) * 65 + n;
        u32x4 o; o.x = pk2(s[0 * 65], s[1 * 65]); o.y = pk2(s[2 * 65], s[3 * 65]); o.z = pk2(s[4 * 65], s[5 * 65]); o.w = pk2(s[6 * 65], s[7 * 65]);
        const int drow = (n < 32) ? drow_lo + n : drow_hi + n - 32;
        *(u32x4*)(WT + (size_t)drow * K + k0 + 8 * c) = o; }
    asm volatile("s_waitcnt lgkmcnt(0)" ::: "memory");
    return mx;
}
__device__ __forceinline__ float absmax_item(const float* W, int N, int k0, int n0, const float* gain, int lane) {
    float mx = 0.f;
#pragma unroll
    for (int h = 0; h < 2; ++h) {
        f32x4 v[8];
#pragma unroll
        for (int i = 0; i < 8; ++i) { const int kk = 4 * (8 * h + i) + (lane >> 4); v[i] = *(const f32x4*)(W + (size_t)(k0 + kk) * N + n0 + 4 * (lane & 15)); }
#pragma unroll
        for (int i = 0; i < 8; ++i) { const int kk = 4 * (8 * h + i) + (lane >> 4); const float g = fabsf(gain[k0 + kk]);
            mx = fmaxf(mx, g * fmaxf(fmaxf(fabsf(v[i][0]), fabsf(v[i][1])), fmaxf(fabsf(v[i][2]), fabsf(v[i][3])))); }
    }
#pragma unroll
    for (int o = 32; o > 0; o >>= 1) mx = fmaxf(mx, __shfl_xor(mx, o));
    return mx;
}
__device__ __forceinline__ void transpose_item_i8(const float* W, int N, int k0, int n0, unsigned char* WT8, int K, int drow0, const float* gain, float scale, LAS float* scr, int lane) {
#pragma unroll
    for (int h = 0; h < 2; ++h) {
        f32x4 v[8];
#pragma unroll
        for (int i = 0; i < 8; ++i) { const int kk = 4 * (8 * h + i) + (lane >> 4); v[i] = __builtin_nontemporal_load((const f32x4*)(W + (size_t)(k0 + kk) * N + n0 + 4 * (lane & 15))); }
#pragma unroll
        for (int i = 0; i < 8; ++i) { const int kk = 4 * (8 * h + i) + (lane >> 4); const f32x4 w = v[i] * (gain[k0 + kk] * scale);
            LAS float* d = scr + kk * 65 + 4 * (lane & 15); d[0] = w[0]; d[1] = w[1]; d[2] = w[2]; d[3] = w[3]; }
    }
    asm volatile("s_waitcnt lgkmcnt(0)" ::: "memory");
    const int c = lane & 7;
#pragma unroll
    for (int j = 0; j < 8; ++j) { const int n = (lane >> 3) + 8 * j; const LAS float* s = scr + (8 * c) * 65 + n;
        const unsigned lo = pack_b0(q8(s[0 * 65]), q8(s[1 * 65]), q8(s[2 * 65]), q8(s[3 * 65])), hi = pack_b0(q8(s[4 * 65]), q8(s[5 * 65]), q8(s[6 * 65]), q8(s[7 * 65]));
        *(u32x2*)(WT8 + (size_t)(drow0 + n) * K + k0 + 8 * c) = (u32x2){lo, hi}; }
    asm volatile("s_waitcnt lgkmcnt(0)" ::: "memory");
}
__device__ __forceinline__ void colgroup_i8(const Frame& F, const float* W, int N, int n0, unsigned char* WT8, int drow_lo, int drow_hi, const float* gain, float* cscale) {
    LAS float* scr = (LAS float*)(F.lds + F.wave * 16640);
    LAS float* cmx = (LAS float*)(F.lds + 8 * 16640);
    const int lane = F.lane, wave = F.wave;
    float cm[4] = {0.f, 0.f, 0.f, 0.f};
#pragma unroll 1
    for (int b = 0; b < 2; ++b) { const int k0 = 64 * (2 * wave + b);
#pragma unroll
        for (int h = 0; h < 2; ++h) {
            f32x4 v[8];
#pragma unroll
            for (int i = 0; i < 8; ++i) { const int kk = 4 * (8 * h + i) + (lane >> 4); v[i] = *(const f32x4*)(W + (size_t)(k0 + kk) * N + n0 + 4 * (lane & 15)); }
#pragma unroll
            for (int i = 0; i < 8; ++i) { const int kk = 4 * (8 * h + i) + (lane >> 4); const float g = fabsf(gain[k0 + kk]);
#pragma unroll
                for (int j = 0; j < 4; ++j) cm[j] = fmaxf(cm[j], g * fabsf(v[i][j])); }
        }
    }
#pragma unroll
    for (int j = 0; j < 4; ++j) { cm[j] = fmaxf(cm[j], __shfl_xor(cm[j], 16)); cm[j] = fmaxf(cm[j], __shfl_xor(cm[j], 32)); }
    if (lane < 16) *(LAS f32x4*)(cmx + wave * 64 + 4 * lane) = (f32x4){cm[0], cm[1], cm[2], cm[3]};
    asm volatile("s_waitcnt lgkmcnt(0)" ::: "memory"); __syncthreads();
    f32x4 mxv = *(const LAS f32x4*)(cmx + 4 * (lane & 15));
#pragma unroll
    for (int w = 1; w < 8; ++w) { const f32x4 t = *(const LAS f32x4*)(cmx + w * 64 + 4 * (lane & 15)); mxv = (f32x4){fmaxf(mxv[0], t[0]), fmaxf(mxv[1], t[1]), fmaxf(mxv[2], t[2]), fmaxf(mxv[3], t[3])}; }
    float sc[4];
#pragma unroll
    for (int j = 0; j < 4; ++j) sc[j] = mxv[j] > 0.f ? 127.f / mxv[j] : 0.f;
    if (wave == 0 && lane < 16) {
#pragma unroll
        for (int j = 0; j < 4; ++j) { const int n = 4 * lane + j; cscale[n < 32 ? drow_lo + n : drow_hi + n - 32] = mxv[j] * (1.f / 127.f); } }
#pragma unroll 1
    for (int b = 0; b < 2; ++b) { const int k0 = 64 * (2 * wave + b);
#pragma unroll
        for (int h = 0; h < 2; ++h) {
            f32x4 v[8];
#pragma unroll
            for (int i = 0; i < 8; ++i) { const int kk = 4 * (8 * h + i) + (lane >> 4); v[i] = __builtin_nontemporal_load((const f32x4*)(W + (size_t)(k0 + kk) * N + n0 + 4 * (lane & 15))); }
#pragma unroll
            for (int i = 0; i < 8; ++i) { const int kk = 4 * (8 * h + i) + (lane >> 4); const float g = gain[k0 + kk];
                LAS float* d = scr + kk * 65 + 4 * (lane & 15); d[0] = v[i][0] * (g * sc[0]); d[1] = v[i][1] * (g * sc[1]); d[2] = v[i][2] * (g * sc[2]); d[3] = v[i][3] * (g * sc[3]); }
        }
        asm volatile("s_waitcnt lgkmcnt(0)" ::: "memory");
        const int c = lane & 7;
#pragma unroll
        for (int j = 0; j < 8; ++j) { const int n = (lane >> 3) + 8 * j; const LAS float* s = scr + (8 * c) * 65 + n;
            const unsigned lo = pack_b0(q8(s[0 * 65]), q8(s[1 * 65]), q8(s[2 * 65]), q8(s[3 * 65])), hi = pack_b0(q8(s[4 * 65]), q8(s[5 * 65]), q8(s[6 * 65]), q8(s[7 * 65]));
            *(u32x2*)(WT8 + (size_t)(n < 32 ? drow_lo + n : drow_hi + n - 32) * DM + k0 + 8 * c) = (u32x2){lo, hi}; }
        asm volatile("s_waitcnt lgkmcnt(0)" ::: "memory");
    }
    __syncthreads();
}
__device__ __forceinline__ int inproj_base(int g) {
    if (g < 8) return 64 * g;
    if (g < 10) return 512 + 64 * (g - 8);
    if (g < 12) return 640 + 64 * (g - 10);
    if (g < 20) return 2304 + 64 * (g - 12);
    if (g < 28) return 2816 + 64 * (g - 20);
    if (g < 36) return 3328 + 64 * (g - 28);
    return 768 + 64 * (g - 36);
}
__device__ __forceinline__ void p0_weights(const Frame& F, int l) {
    const Params& P = *F.P;
    LAS float* scr = (LAS float*)(F.lds + F.wave * 16640);
    const int gw = F.bid * 8 + F.wave, NGW = F.G * 8;
    unsigned char* ws = P.ws + opaque_zero();
    const float* w_in = P.in[I_WIN] + (size_t)l * DM * INC;
    const float* n1g = P.in[I_N1G] + l * DM; const float* n2g = P.in[I_N2G] + l * DM;
    constexpr int NCG = 48 + 88;
    for (int it = F.G - 1 - F.bid; it < NCG; it += F.G) {
        if (it < 48) colgroup_i8(F, w_in, INC, NMAIN + 64 * it, ws + W_IN + (size_t)NMAIN * DM * 2, 64 * it, 64 * it + 32, n1g, (float*)(ws + CS_G));
        else { const int r = it - 48, which = r / 44, c = 64 * (r % 44), d0 = 256 * (c >> 7) + 128 * which + (c & 127);
            colgroup_i8(F, P.in[which ? I_FFW3 : I_FFW1] + (size_t)l * DM * DFF, DFF, c, ws + W_13, d0, d0 + 32, n2g, (float*)(ws + CS_13)); }
    }
    constexpr int N1 = 60 * 16, N2 = 0, N3 = 3 * 128, N4 = 256, N5 = 0, N6 = 44 * 16;
    constexpr int NIT = N1 + N2 + N3 + N4 + N5 + N6;
    const int nfree = F.G - NCG, pw0 = nfree > 0 ? gw : gw, pstride = nfree > 0 ? nfree * 8 : NGW;
    if (nfree > 0 && F.bid >= nfree) return;
    for (int it = pw0; it < NIT; it += pstride) {
        int r = it;
        if (r < N1) { const int g = r / 16, kb = r % 16; const int d0 = 256 * (g >> 2) + 32 * (g & 3);
            transpose_item(w_in, INC, 64 * kb, inproj_base(g), (bf16_t*)(ws + W_IN), DM, d0, d0 + 128, n1g, scr, F.lane); continue; }
        r -= N1;
        r -= N2;
        if (r < N3) { const int w = r / 128, q = r % 128, cb = q / 8, kb = q % 8;
            const float* src = P.in[I_WOA + w] + (size_t)l * 512 * DM;
            transpose_item(src, DM, 64 * kb, 64 * cb, (bf16_t*)(ws + W_OA) + (size_t)w * DM * 512, 512, 64 * cb, 64 * cb + 32, nullptr, scr, F.lane); continue; }
        r -= N3;
        if (r < N4) { const int cb = r / 16, kb = r % 16;
            transpose_item(P.in[I_WOUT] + (size_t)l * DM * DM, DM, 64 * kb, 64 * cb, (bf16_t*)(ws + W_OUT), DM, 64 * cb, 64 * cb + 32, nullptr, scr, F.lane); continue; }
        r -= N4;
        r -= N5;
        { const int cb = r / 44, kb = r % 44;
            transpose_item(P.in[I_FFW2] + (size_t)l * DFF * DM, DM, 64 * kb, 64 * cb, (bf16_t*)(ws + W_2), DFF, 64 * cb, 64 * cb + 32, nullptr, scr, F.lane); }
    }
}
__device__ __forceinline__ void p0_misc(const Frame& F) {
    const Params& P = *F.P;
    unsigned char* ws = P.ws + opaque_zero();
    const int gw = F.bid * 8 + F.wave, NGW = F.G * 8, lane = F.lane;
    const int gt = F.bid * NTHREADS + F.tid, NGT = F.G * NTHREADS;
    float* rowssA = (float*)(ws + WS_ROWSSA);
    const float* x = P.in[I_X]; bf16_t* xb = (bf16_t*)(ws + WS_XB);
    for (int m = gw; m < MTOK; m += NGW) {
        const f32x4* xr = (const f32x4*)(x + (size_t)m * DM) + lane;
        float s = 0.f; f32x4 v[4];
#pragma unroll
        for (int j = 0; j < 4; ++j) { v[j] = __builtin_nontemporal_load(xr + 64 * j); s += v[j][0] * v[j][0] + v[j][1] * v[j][1] + v[j][2] * v[j][2] + v[j][3] * v[j][3]; }
        s = wave_sum(s);
        u32x2* o = (u32x2*)(xb + (size_t)m * DM) + lane;
        float mx = 0.f; u32x2 wv[4];
#pragma unroll
        for (int j = 0; j < 4; ++j) { u32x2 w; w.x = pk2(v[j][0], v[j][1]); w.y = pk2(v[j][2], v[j][3]); o[64 * j] = w; wv[j] = w;
            mx = fmaxf(mx, fmaxf(fmaxf(fabsf(bflo(w.x)), fabsf(bfhi(w.x))), fmaxf(fabsf(bflo(w.y)), fabsf(bfhi(w.y))))); }
        if (lane < 4) rowssA[(size_t)m * 4 + lane] = (lane == 0) ? s : 0.f;
#pragma unroll
        for (int o2 = 32; o2 > 0; o2 >>= 1) mx = fmaxf(mx, __shfl_xor(mx, o2));
        { const float sc = mx > 0.f ? 127.f / mx : 0.f; unsigned* q = (unsigned*)(ws + WS_XB8 + (size_t)m * DM) + lane;
#pragma unroll
          for (int j = 0; j < 4; ++j) q[64 * j] = pack_b0(q8(bflo(wv[j].x) * sc), q8(bfhi(wv[j].x) * sc), q8(bflo(wv[j].y) * sc), q8(bfhi(wv[j].y) * sc));
          if (lane == 0) *(f32x4*)((float*)(ws + CTL_FCTA) + (size_t)m * 4) = (f32x4){rsqrtf(s * (1.f / DM) + RMS_EPS) * mx * (1.f / 127.f), 0.f, 0.f, 0.f}; }
    }
    unsigned* csT = (unsigned*)(ws + CTL_COS);
    for (int i = gt; i < SEQ * 32; i += NGT) { const int pos = i >> 5, k = i & 31;
        const double inv = exp(-(double)k / 32.0 * log(10000.0)); const double ang = (double)pos * inv;
        const _Float16 ch = (_Float16)(float)cos(ang), sh = (_Float16)(float)sin(ang);
        csT[i] = (unsigned)__builtin_bit_cast(unsigned short, ch) | ((unsigned)__builtin_bit_cast(unsigned short, sh) << 16); }
    f32x2* tw = (f32x2*)(ws + CTL_TW);
    for (int i = gt; i < 2048; i += NGT) { float s, c; sincospif(-(float)i * (1.f / 2048.f), &s, &c); tw[i] = (f32x2){c, s}; }
    { unsigned* gp = (unsigned*)(ws + CTL_SIN);
      for (int i = gt; i < DEPTH * 4 * 32; i += NGT) { const int l = i >> 7, ty = (i >> 5) & 3, d = i & 31;
          const float* gsrc = P.in[ty == 0 ? I_QNA : (ty == 1 ? I_KNA : (ty == 2 ? I_QNC : I_KNC))] + l * 64;
          const _Float16 lo = (_Float16)gsrc[d], hi = (_Float16)gsrc[d + 32];
          gp[i] = (unsigned)__builtin_bit_cast(unsigned short, lo) | ((unsigned)__builtin_bit_cast(unsigned short, hi) << 16); } }
    if (gt < DEPTH) { const int l = gt; float a = 0.f, b = 0.f;
        for (int i = 0; i < 64; ++i) { a += P.in[I_LQ1][l * 64 + i] * P.in[I_LK1][l * 64 + i]; b += P.in[I_LQ2][l * 64 + i] * P.in[I_LK2][l * 64 + i]; }
        const float li = 0.8f - 0.6f * expf(-0.3f * (float)l);
        ((float*)(ws + CTL_LAM))[l] = expf(a) - expf(b) + li; }
    float* H2 = (float*)(ws + CTL_H2);
    for (int it = gw; it < DEPTH * SEQ; it += NGW) {
        const int l = it / SEQ, t = it % SEQ;
        const float* w1 = P.in[I_FW1] + l * 33 * 64; const float* w2 = P.in[I_FW2] + l * 64 * 64;
        const int band = (lane & 15) + 1; const int ph = (t * band) & 2047;
        float sv, cv; sincospif((float)ph * (1.f / 1024.f), &sv, &cv);
        float pre = P.in[I_FB1][l * 64 + lane] + ((float)t / (float)(SEQ - 1)) * w1[lane];
#pragma unroll
        for (int k = 0; k < 16; ++k) { pre += __shfl(cv, k) * w1[(1 + k) * 64 + lane]; pre += __shfl(sv, k) * w1[(17 + k) * 64 + lane]; }
        const float h1 = sinf(P.in[I_FF1][l * 64 + lane] * pre);
        float pre2 = P.in[I_FB2][l * 64 + lane];
        for (int j = 0; j < 64; ++j) pre2 += __shfl(h1, j) * w2[j * 64 + lane];
        ((bf16_t*)H2)[(size_t)it * 64 + lane] = f2bf(sinf(P.in[I_FF2][l * 64 + lane] * pre2));
    }
}

__device__ __forceinline__ f32x2 cmul(f32x2 a, f32x2 b) { return (f32x2){a.x * b.x - a.y * b.y, a.x * b.y + a.y * b.x}; }
__device__ __forceinline__ f32x2 cmulc(f32x2 a, f32x2 b) { return (f32x2){a.x * b.x + a.y * b.y, a.y * b.x - a.x * b.y}; }
__device__ __forceinline__ f32x2 mul_mi(f32x2 a) { return (f32x2){a.y, -a.x}; }
__device__ __forceinline__ f32x2 mul_pi(f32x2 a) { return (f32x2){-a.y, a.x}; }
constexpr float RS2 = 0.70710678118654752f;
__device__ __forceinline__ int pidx(int i) { return i + (i >> 3); }
struct Tw3 { f32x2 w1, w2, w3; };
struct TwF { f32x2 w1, s1, w2, s2, w3, s3; };
struct TwI { f32x2 c1, t1, c2, t2, c3, t3; };
__device__ __forceinline__ f32x2 cm2(f32x2 a, f32x2 w, f32x2 s) { const f32x2 t = (f32x2){a.x, a.x} * w; return __builtin_elementwise_fma((f32x2){a.y, a.y}, s, t); }
__device__ __forceinline__ TwF tw_fwd(const Tw3& t) { return TwF{t.w1, (f32x2){-t.w1.y, t.w1.x}, t.w2, (f32x2){-t.w2.y, t.w2.x}, t.w3, (f32x2){-t.w3.y, t.w3.x}}; }
__device__ __forceinline__ TwI tw_inv(const Tw3& t) { return TwI{(f32x2){t.w1.x, -t.w1.y}, (f32x2){t.w1.y, t.w1.x}, (f32x2){t.w2.x, -t.w2.y}, (f32x2){t.w2.y, t.w2.x}, (f32x2){t.w3.x, -t.w3.y}, (f32x2){t.w3.y, t.w3.x}}; }
template <bool UNIT> __device__ __forceinline__ void r8_fwd(f32x2 (&v)[8], const TwF& T) {
    {
        f32x2 d0 = v[0] - v[4], d1 = v[1] - v[5], d2 = v[2] - v[6], d3 = v[3] - v[7];
        v[0] = v[0] + v[4]; v[1] = v[1] + v[5]; v[2] = v[2] + v[6]; v[3] = v[3] + v[7];
        d1 = (f32x2){(d1.x + d1.y) * RS2, (d1.y - d1.x) * RS2};
        d2 = mul_mi(d2);
        d3 = (f32x2){(d3.y - d3.x) * RS2, -(d3.x + d3.y) * RS2};
        if (UNIT) { v[4] = d0; v[5] = d1; v[6] = d2; v[7] = d3; }
        else { v[4] = cm2(d0, T.w1, T.s1); v[5] = cm2(d1, T.w1, T.s1); v[6] = cm2(d2, T.w1, T.s1); v[7] = cm2(d3, T.w1, T.s1); }
    }
#pragma unroll
    for (int q = 0; q < 8; q += 4) {
        const f32x2 d0 = v[q] - v[q + 2], d1 = mul_mi(v[q + 1] - v[q + 3]);
        v[q] = v[q] + v[q + 2]; v[q + 1] = v[q + 1] + v[q + 3];
        if (UNIT) { v[q + 2] = d0; v[q + 3] = d1; } else { v[q + 2] = cm2(d0, T.w2, T.s2); v[q + 3] = cm2(d1, T.w2, T.s2); }
    }
#pragma unroll
    for (int q = 0; q < 8; q += 2) { const f32x2 d = v[q] - v[q + 1]; v[q] = v[q] + v[q + 1]; v[q + 1] = UNIT ? d : cm2(d, T.w3, T.s3); }
}
template <bool UNIT> __device__ __forceinline__ void r8_inv(f32x2 (&v)[8], const TwI& T) {
#pragma unroll
    for (int q = 0; q < 8; q += 2) { const f32x2 b = UNIT ? v[q + 1] : cm2(v[q + 1], T.c3, T.t3), a = v[q]; v[q] = a + b; v[q + 1] = a - b; }
#pragma unroll
    for (int q = 0; q < 8; q += 4) {
        const f32x2 b0 = UNIT ? v[q + 2] : cm2(v[q + 2], T.c2, T.t2), b1 = mul_pi(UNIT ? v[q + 3] : cm2(v[q + 3], T.c2, T.t2)), a0 = v[q], a1 = v[q + 1];
        v[q] = a0 + b0; v[q + 2] = a0 - b0; v[q + 1] = a1 + b1; v[q + 3] = a1 - b1;
    }
    {
        const f32x2 b0 = UNIT ? v[4] : cm2(v[4], T.c1, T.t1); f32x2 b1 = UNIT ? v[5] : cm2(v[5], T.c1, T.t1); const f32x2 b2 = mul_pi(UNIT ? v[6] : cm2(v[6], T.c1, T.t1)); f32x2 b3 = UNIT ? v[7] : cm2(v[7], T.c1, T.t1);
        b1 = (f32x2){(b1.x - b1.y) * RS2, (b1.x + b1.y) * RS2};
        b3 = (f32x2){-(b3.x + b3.y) * RS2, (b3.x - b3.y) * RS2};
        const f32x2 a0 = v[0], a1 = v[1], a2 = v[2], a3 = v[3];
        v[0] = a0 + b0; v[4] = a0 - b0; v[1] = a1 + b1; v[5] = a1 - b1; v[2] = a2 + b2; v[6] = a2 - b2; v[3] = a3 + b3; v[7] = a3 - b3;
    }
}
__device__ __forceinline__ void wave_lds_sync() { asm volatile("s_waitcnt lgkmcnt(0)" ::: "memory"); }
struct FftTw { Tw3 w512, w64, w8; };
__device__ __forceinline__ Tw3 tw3_make(int e) {
    Tw3 t; float s, c;
    sincospif(-(float)e * (1.f / 2048.f), &s, &c); t.w1 = (f32x2){c, s};
    sincospif(-(float)(2 * e) * (1.f / 2048.f), &s, &c); t.w2 = (f32x2){c, s};
    sincospif(-(float)(4 * e) * (1.f / 2048.f), &s, &c); t.w3 = (f32x2){c, s};
    return t;
}
__device__ __forceinline__ FftTw fft_twiddles(int tid) { FftTw t; t.w512 = tw3_make(tid); t.w64 = tw3_make(8 * (tid & 63)); t.w8 = tw3_make(64 * (tid & 7)); return t; }
template <int SP> __device__ __forceinline__ int fft_base(int tid) { return (tid / SP) * 8 * SP + (tid & (SP - 1)); }
template <int SP> __device__ __forceinline__ void fft_ld(const LAS f32x2* X, int tid, f32x2 (&v)[8]) {
    const int base = fft_base<SP>(tid);
#pragma unroll
    for (int j = 0; j < 8; ++j) v[j] = X[pidx(base + j * SP)];
}
template <int SP> __device__ __forceinline__ void fft_st(LAS f32x2* X, int tid, const f32x2 (&v)[8]) {
    const int base = fft_base<SP>(tid);
#pragma unroll
    for (int j = 0; j < 8; ++j) X[pidx(base + j * SP)] = v[j];
}
template <int SP> __device__ __forceinline__ void fft_pass_fwd(LAS f32x2* X, int tid, const Tw3& w) { const TwF T = tw_fwd(w); f32x2 v[8]; fft_ld<SP>(X, tid, v); r8_fwd<false>(v, T); fft_st<SP>(X, tid, v); }
template <int SP> __device__ __forceinline__ void fft_pass_inv(LAS f32x2* X, int tid, const Tw3& w) { const TwI T = tw_inv(w); f32x2 v[8]; fft_ld<SP>(X, tid, v); r8_inv<false>(v, T); fft_st<SP>(X, tid, v); }

constexpr int HY_STG = 0, HY_STG_BYTES = 2 * 2050 * 16, HY_X = 65664, HY_X_BYTES = 4608 * 8, HY_RED = HY_X + HY_X_BYTES;
static_assert(HY_STG_BYTES <= HY_X && HY_X + 2 * HY_X_BYTES <= LDS_BARST, "hyena lds");

constexpr int HM_RS = 192, HM_PLANE = 32 * HM_RS, HM_STG = 0, HM_STG_BYTES = 16 * HM_PLANE;
constexpr int HM_FT = HM_STG_BYTES, HM_FRS = 136, HM_FTBL = 64 * HM_FRS;
constexpr int HM_WT = HM_FT + 3 * HM_FTBL, HM_END = HM_WT + 4096 * 4;
static_assert(HM_END + 128 <= LDS_BARST, "hyena mfma lds");
__device__ __forceinline__ bf16x8 hm_ld_tr(const LAS unsigned char* p) {
    const s16x4 lo4 = __builtin_amdgcn_ds_read_tr16_b64_v4i16((LAS s16x4*)p);
    const s16x4 hi4 = __builtin_amdgcn_ds_read_tr16_b64_v4i16((LAS s16x4*)(p + 4 * HM_RS));
    return (bf16x8){lo4[0], lo4[1], lo4[2], lo4[3], hi4[0], hi4[1], hi4[2], hi4[3]};
}
__device__ __forceinline__ bf16x8 hm_ld2(const LAS unsigned char* p, int off2) {
    const u32x2 a = *(const LAS u32x2*)p, b = *(const LAS u32x2*)(p + off2);
    return __builtin_bit_cast(bf16x8, (u32x4){a.x, a.y, b.x, b.y});
}
__device__ __forceinline__ bf16x8 hm_pack(const f32x16& t, int s) {
    u32x4 w; w.x = pk2(t[8 * s + 0], t[8 * s + 1]); w.y = pk2(t[8 * s + 2], t[8 * s + 3]); w.z = pk2(t[8 * s + 4], t[8 * s + 5]); w.w = pk2(t[8 * s + 6], t[8 * s + 7]);
    return __builtin_bit_cast(bf16x8, w);
}
#define HM_MFMA(a, b, c) __builtin_amdgcn_mfma_f32_32x32x16_bf16(a, b, c, 0, 0, 0)
struct HmF3 { bf16x8 r, i, n; };
__device__ __forceinline__ HmF3 hm_ldf(const LAS unsigned char* fp, int off2) { HmF3 f; f.r = hm_ld2(fp, off2); f.i = hm_ld2(fp + HM_FTBL, off2); f.n = hm_ld2(fp + 2 * HM_FTBL, off2); return f; }
__device__ __forceinline__ void hm_conv_wave(LAS unsigned char* lds, int lane, int ch, const f32x2* H) {
    const int r32 = lane & 31, h = lane >> 5;
    LAS unsigned char* PR = lds + HM_STG + (ch * 2) * HM_PLANE; LAS unsigned char* PI = PR + HM_PLANE;
    const LAS unsigned char* FT = lds + HM_FT; const LAS unsigned* WT = (const LAS unsigned*)(lds + HM_WT);
    f32x16 xr[2], xi[2];
#pragma unroll
    for (int nt = 0; nt < 2; ++nt)
#pragma unroll
        for (int r = 0; r < 16; ++r) { xr[nt][r] = 0.f; xi[nt][r] = 0.f; }
    const int trow0 = 8 * h + ((lane & 15) >> 2), tcol0 = 16 * ((lane >> 4) & 1) + 4 * (lane & 3);
#pragma unroll 1
    for (int c1 = 0; c1 < 2; ++c1) {
        const int k1 = 32 * c1 + r32;
        bf16x8 yrB[4], yiB[4];
        {
            const LAS unsigned char* fb = FT + k1 * HM_FRS + 8 * h * 2;
            bf16x8 aR = hm_ld_tr(PR + trow0 * HM_RS + tcol0 * 2), aI = hm_ld_tr(PI + trow0 * HM_RS + tcol0 * 2);
            HmF3 f = hm_ldf(fb, 8);
#pragma unroll
            for (int rt = 0; rt < 2; ++rt) {
                f32x16 yr, yi;
#pragma unroll
                for (int r = 0; r < 16; ++r) { yr[r] = 0.f; yi[r] = 0.f; }
#pragma unroll
                for (int ks = 0; ks < 2; ++ks) {
                    const int g = 2 * rt + ks;
                    bf16x8 aRn = aR, aIn = aI; HmF3 fn = f;
                    if (g + 1 < 4) { const int rt2 = (g + 1) >> 1, ks2 = (g + 1) & 1;
                        aRn = hm_ld_tr(PR + (16 * ks2 + trow0) * HM_RS + (32 * rt2 + tcol0) * 2); aIn = hm_ld_tr(PI + (16 * ks2 + trow0) * HM_RS + (32 * rt2 + tcol0) * 2);
                        fn = hm_ldf(fb + 16 * ks2 * 2, 8); }
                    yr = HM_MFMA(aR, f.r, yr); yr = HM_MFMA(aI, f.n, yr);
                    yi = HM_MFMA(aR, f.i, yi); yi = HM_MFMA(aI, f.r, yi);
                    asm volatile("" ::: "memory");
                    aR = aRn; aI = aIn; f = fn;
                }
#pragma unroll
                for (int r = 0; r < 16; ++r) {
                    const int n2 = 32 * rt + (r & 3) + 8 * (r >> 2) + 4 * h;
                    const unsigned w = WT[k1 * n2];
                    const float wr = (float)__builtin_bit_cast(_Float16, (unsigned short)(w & 0xffffu)), wi = (float)__builtin_bit_cast(_Float16, (unsigned short)(w >> 16));
                    const float a = yr[r], b = yi[r];
                    yr[r] = a * wr - b * wi; yi[r] = a * wi + b * wr;
                }
#pragma unroll
                for (int s = 0; s < 2; ++s) { yrB[2 * rt + s] = hm_pack(yr, s); yiB[2 * rt + s] = hm_pack(yi, s); }
            }
        }
        bf16x8 zrA[4], ziA[4];
#pragma unroll
        for (int kt = 0; kt < 2; ++kt) {
            f32x16 zr, zi;
#pragma unroll
            for (int r = 0; r < 16; ++r) { zr[r] = 0.f; zi[r] = 0.f; }
            f32x2 hv[16];
#pragma unroll
            for (int r = 0; r < 16; ++r) hv[r] = H[(32 * kt + (r & 3) + 8 * (r >> 2) + 4 * h) * 64 + k1];
            const LAS unsigned char* fb = FT + (32 * kt + r32) * HM_FRS + 4 * h * 2;
            HmF3 f = hm_ldf(fb, 16);
#pragma unroll
            for (int q = 0; q < 4; ++q) {
                HmF3 fn = f; if (q + 1 < 4) fn = hm_ldf(fb + 16 * (q + 1) * 2, 16);
                zr = HM_MFMA(f.r, yrB[q], zr); zr = HM_MFMA(f.n, yiB[q], zr);
                zi = HM_MFMA(f.i, yrB[q], zi); zi = HM_MFMA(f.r, yiB[q], zi);
                asm volatile("" ::: "memory");
                f = fn;
            }
#pragma unroll
            for (int r = 0; r < 16; ++r) {
                const float a = zr[r], b = zi[r];
                zr[r] = a * hv[r].x - b * hv[r].y; zi[r] = a * hv[r].y + b * hv[r].x;
            }
#pragma unroll
            for (int s = 0; s < 2; ++s) { zrA[2 * kt + s] = hm_pack(zr, s); ziA[2 * kt + s] = hm_pack(zi, s); }
        }
#pragma unroll
        for (int nt = 0; nt < 2; ++nt) {
            const int n2 = 32 * nt + r32;
            f32x16 vr, vi;
#pragma unroll
            for (int r = 0; r < 16; ++r) { vr[r] = 0.f; vi[r] = 0.f; }
            const LAS unsigned char* fb = FT + n2 * HM_FRS + 4 * h * 2;
            HmF3 f = hm_ldf(fb, 16);
#pragma unroll
            for (int q = 0; q < 4; ++q) {
                HmF3 fn = f; if (q + 1 < 4) fn = hm_ldf(fb + 16 * (q + 1) * 2, 16);
                vr = HM_MFMA(zrA[q], f.r, vr); vr = HM_MFMA(ziA[q], f.i, vr);
                vi = HM_MFMA(ziA[q], f.r, vi); vi = HM_MFMA(zrA[q], f.n, vi);
                asm volatile("" ::: "memory");
                f = fn;
            }
            const LAS unsigned char* f4 = FT + r32 * HM_FRS + (32 * c1 + 4 * h) * 2;
            HmF3 g0 = hm_ldf(f4, 16), g1 = hm_ldf(f4 + 16 * 2, 16);
#pragma unroll
            for (int r = 0; r < 16; ++r) {
                const int kk = 32 * c1 + (r & 3) + 8 * (r >> 2) + 4 * h;
                const unsigned w = WT[kk * n2];
                const float wr = (float)__builtin_bit_cast(_Float16, (unsigned short)(w & 0xffffu)), wi = (float)__builtin_bit_cast(_Float16, (unsigned short)(w >> 16));
                const float a = vr[r], b = vi[r];
                vr[r] = a * wr + b * wi; vi[r] = b * wr - a * wi;
            }
            {
                const bf16x8 vrB = hm_pack(vr, 0), viB = hm_pack(vi, 0);
                xr[nt] = HM_MFMA(g0.r, vrB, xr[nt]); xr[nt] = HM_MFMA(g0.i, viB, xr[nt]);
                xi[nt] = HM_MFMA(g0.r, viB, xi[nt]); xi[nt] = HM_MFMA(g0.n, vrB, xi[nt]);
            }
            {
                const bf16x8 vrB = hm_pack(vr, 1), viB = hm_pack(vi, 1);
                xr[nt] = HM_MFMA(g1.r, vrB, xr[nt]); xr[nt] = HM_MFMA(g1.i, viB, xr[nt]);
                xi[nt] = HM_MFMA(g1.r, viB, xi[nt]); xi[nt] = HM_MFMA(g1.n, vrB, xi[nt]);
            }
            asm volatile("" ::: "memory");
        }
    }
    asm volatile("s_waitcnt lgkmcnt(0)" ::: "memory");
#pragma unroll
    for (int nt = 0; nt < 2; ++nt)
#pragma unroll
        for (int r = 0; r < 16; ++r) {
            const int n1 = (r & 3) + 8 * (r >> 2) + 4 * h, off = n1 * HM_RS + (32 * nt + r32) * 2;
            *(LAS unsigned short*)(PR + off) = f2bf(xr[nt][r]); *(LAS unsigned short*)(PI + off) = f2bf(xi[nt][r]);
        }
}
__device__ __forceinline__ void hm_init_tables(LAS unsigned char* lds, int tid) {
    for (int i = tid; i < 4096; i += NTHREADS) {
        const int a = i >> 6, b = i & 63; float s, c; sincospif(-(float)((a * b) & 63) * (1.f / 32.f), &s, &c);
        LAS unsigned short* fp = (LAS unsigned short*)(lds + HM_FT + a * HM_FRS + b * 2);
        fp[0] = f2bf(c); fp[HM_FTBL / 2] = f2bf(s); fp[HM_FTBL] = f2bf(-s);
        float s2, c2; sincospif(-(float)i * (1.f / 2048.f), &s2, &c2);
        const _Float16 ch_ = (_Float16)c2, sh_ = (_Float16)s2;
        ((LAS unsigned*)(lds + HM_WT))[i] = (unsigned)__builtin_bit_cast(unsigned short, ch_) | ((unsigned)__builtin_bit_cast(unsigned short, sh_) << 16);
    }
}
__device__ __forceinline__ void hm_spec_wave(const LAS unsigned char* lds, int lane, int cc, int c1, float scale, float dd, f32x2* dst) {
    const int r32 = lane & 31, h = lane >> 5, k1 = 32 * c1 + r32;
    const LAS unsigned char* PR = lds + HM_STG + cc * (64 * HM_RS);
    const LAS unsigned char* FT = lds + HM_FT; const LAS unsigned* WT = (const LAS unsigned*)(lds + HM_WT);
    const int trow0 = 8 * h + ((lane & 15) >> 2), tcol0 = 16 * ((lane >> 4) & 1) + 4 * (lane & 3);
    bf16x8 yrB[4], yiB[4];
#pragma unroll
    for (int rt = 0; rt < 2; ++rt) {
        f32x16 yr, yi;
#pragma unroll
        for (int r = 0; r < 16; ++r) { yr[r] = 0.f; yi[r] = 0.f; }
#pragma unroll
        for (int ks = 0; ks < 4; ++ks) {
            const bf16x8 aR = hm_ld_tr(PR + (16 * ks + trow0) * HM_RS + (32 * rt + tcol0) * 2);
            const LAS unsigned char* fp = FT + k1 * HM_FRS + (16 * ks + 8 * h) * 2;
            const bf16x8 bFr = hm_ld2(fp, 8), bFi = hm_ld2(fp + HM_FTBL, 8);
            yr = HM_MFMA(aR, bFr, yr); yi = HM_MFMA(aR, bFi, yi);
            asm volatile("" ::: "memory");
        }
#pragma unroll
        for (int r = 0; r < 16; ++r) {
            const int n2 = 32 * rt + (r & 3) + 8 * (r >> 2) + 4 * h;
            const unsigned w = WT[k1 * n2];
            const float wr = (float)__builtin_bit_cast(_Float16, (unsigned short)(w & 0xffffu)), wi = (float)__builtin_bit_cast(_Float16, (unsigned short)(w >> 16));
            const float a = yr[r], b = yi[r];
            yr[r] = a * wr - b * wi; yi[r] = a * wi + b * wr;
        }
#pragma unroll
        for (int s = 0; s < 2; ++s) { yrB[2 * rt + s] = hm_pack(yr, s); yiB[2 * rt + s] = hm_pack(yi, s); }
    }
#pragma unroll
    for (int kt = 0; kt < 2; ++kt) {
        f32x16 zr, zi;
#pragma unroll
        for (int r = 0; r < 16; ++r) { zr[r] = 0.f; zi[r] = 0.f; }
#pragma unroll
        for (int q = 0; q < 4; ++q) {
            const HmF3 f = hm_ldf(FT + (32 * kt + r32) * HM_FRS + (16 * q + 4 * h) * 2, 16);
            zr = HM_MFMA(f.r, yrB[q], zr); zr = HM_MFMA(f.n, yiB[q], zr);
            zi = HM_MFMA(f.i, yrB[q], zi); zi = HM_MFMA(f.r, yiB[q], zi);
            asm volatile("" ::: "memory");
        }
#pragma unroll
        for (int r = 0; r < 16; ++r) {
            const int k2 = 32 * kt + (r & 3) + 8 * (r >> 2) + 4 * h;
            dst[k2 * 64 + k1] = (f32x2){zr[r] * scale + dd, zi[r] * scale};
        }
    }
}
constexpr int HM_W3L = HM_END + 128;
static_assert(HM_W3L + 32 * HM_FRS <= LDS_BARST, "spectra lds");
__device__ __forceinline__ void spectra_phase(const Frame& F, int l) {
    const Params& P = *F.P; unsigned char* ws = P.ws + opaque_zero(); const int tid = F.tid, lane = F.lane, r32 = lane & 31, h = lane >> 5;
    LAS unsigned char* lds = F.lds; LAS float* red = (LAS float*)(lds + HM_END);
    hm_init_tables(lds, tid);
    const bf16_t* H2B = (const bf16_t*)(ws + CTL_H2) + (size_t)l * SEQ * 64;
    const float* w3 = P.in[I_FW3] + (size_t)l * 64 * 2048;
    f32x2* spec = (f32x2*)(ws + WS_S);
    const float min_decay = logf(0.01f) / 1.5f, max_decay = logf(0.01f) / 0.3f;
    for (int it = F.bid; it < 256; it += F.G) {
        const int o = it >> 7, c0 = (it & 127) * 4;
        { const int row = tid >> 6, j = tid & 63;
          *(LAS unsigned short*)(lds + HM_W3L + row * HM_FRS + j * 2) = f2bf(w3[(size_t)j * 2048 + (o * 2 + (row >> 2)) * 512 + c0 + (row & 3)]);
#pragma unroll
          for (int k = 0; k < 3; ++k) { const int e = tid + 512 * k; *(LAS unsigned short*)(lds + HM_W3L + (8 + (e >> 6)) * HM_FRS + (e & 63) * 2) = 0; } }
        __syncthreads();
        bf16x8 wA[4];
#pragma unroll
        for (int ks = 0; ks < 4; ++ks) wA[ks] = hm_ld2(lds + HM_W3L + r32 * HM_FRS + (16 * ks + 8 * h) * 2, 8);
        float dl[4];
#pragma unroll
        for (int cc = 0; cc < 4; ++cc) dl[cc] = fabsf(min_decay + (max_decay - min_decay) * ((float)(c0 + cc) / 511.f));
        float ss[4] = {0.f, 0.f, 0.f, 0.f};
#pragma unroll 2
        for (int tt = F.wave; tt < 64; tt += 8) {
            const int t = 32 * tt + r32;
            const bf16_t* hp = H2B + (size_t)t * 64 + 8 * h;
            f32x16 d;
#pragma unroll
            for (int r = 0; r < 16; ++r) d[r] = 0.f;
            bf16x8 hb[4];
#pragma unroll
            for (int ks = 0; ks < 4; ++ks) hb[ks] = *(const bf16x8*)(hp + 16 * ks);
#pragma unroll
            for (int ks = 0; ks < 4; ++ks) d = HM_MFMA(wA[ks], hb[ks], d);
            const float tn = (float)t / (float)(SEQ - 1);
#pragma unroll
            for (int cc = 0; cc < 4; ++cc) {
                float v = d[cc] * expf(-tn * dl[cc]);
                const float other = __shfl_xor(v, 32);
                LAS unsigned char* PR = lds + HM_STG + cc * (64 * HM_RS);
                int n;
                if (t == 0) { if (h == 0) { v += other; n = 0; } else { v = 0.f; n = 2048; } }
                else n = h ? 4096 - t : t;
                *(LAS unsigned short*)(PR + (n >> 6) * HM_RS + (n & 63) * 2) = f2bf(v);
                ss[cc] += v * v;
            }
        }
#pragma unroll
        for (int cc = 0; cc < 4; ++cc) ss[cc] = wave_sum(ss[cc]);
        if (lane == 0) *(LAS f32x4*)(red + F.wave * 4) = (f32x4){ss[0], ss[1], ss[2], ss[3]};
        __syncthreads();
        {
            const int cc = F.wave & 3, c = c0 + cc;
            float tot = 0.f;
#pragma unroll
            for (int w = 0; w < 8; ++w) tot += red[w * 4 + cc];
            const float scale = rsqrtf(tot + RMS_EPS) * (1.f / 4096.f);
            const float dd = P.in[I_HYD][(l * 2 + o) * 512 + c] * (1.f / 4096.f);
            hm_spec_wave(lds, lane, cc, F.wave >> 2, scale, dd, spec + (size_t)(o * 512 + c) * 4096);
        }
        __syncthreads();
    }
}

__device__ __forceinline__ int hm_addr(int ch, int pl, int t) { return ((ch * 2 + pl) * 32 + (t >> 6)) * HM_RS + (t & 63) * 2; }
template <int MODE> __device__ __forceinline__ void hm_elem_pass(const Frame& F, LAS unsigned char* lds, const bf16_t* HY, int b0, int coff, const float* cw, const float* cb, bf16_t* outp, int c0) {
    const int tid = F.tid, b = tid >> 8, t0 = (tid & 255) * 8;
    const bf16_t* rp = HY + ((size_t)(coff >> 3) * MTOK + (size_t)(b0 + b) * SEQ + t0) * 8;
    u32x4 x[10];
    const u32x4 z4 = {0u, 0u, 0u, 0u};
    x[0] = (t0 > 0) ? *(const u32x4*)(rp - 8) : z4;
#pragma unroll
    for (int i = 0; i < 8; ++i) x[1 + i] = *(const u32x4*)(rp + 8 * i);
    x[9] = (t0 + 8 < SEQ) ? *(const u32x4*)(rp + 64) : z4;
    u32x4 res[8];
#pragma unroll
    for (int kp = 0; kp < 4; ++kp) {
        const float wl0 = cw[coff + 2 * kp], wl1 = cw[1536 + coff + 2 * kp], wl2 = cw[2 * 1536 + coff + 2 * kp], bl = cb[coff + 2 * kp];
        const float wh0 = cw[coff + 2 * kp + 1], wh1 = cw[1536 + coff + 2 * kp + 1], wh2 = cw[2 * 1536 + coff + 2 * kp + 1], bh = cb[coff + 2 * kp + 1];
        float lo[8], hi[8];
#pragma unroll
        for (int i = 0; i < 8; ++i) {
            lo[i] = bflo(x[i][kp]) * wl0 + bflo(x[i + 1][kp]) * wl1 + bflo(x[i + 2][kp]) * wl2 + bl;
            hi[i] = bfhi(x[i][kp]) * wh0 + bfhi(x[i + 1][kp]) * wh1 + bfhi(x[i + 2][kp]) * wh2 + bh;
        }
        if (MODE != 0) {
            const u32x4 pl = *(const LAS u32x4*)(lds + HM_STG + hm_addr(2 * kp, b, t0)), ph = *(const LAS u32x4*)(lds + HM_STG + hm_addr(2 * kp + 1, b, t0));
#pragma unroll
            for (int i = 0; i < 4; ++i) { lo[2 * i] *= bflo(pl[i]); lo[2 * i + 1] *= bfhi(pl[i]); hi[2 * i] *= bflo(ph[i]); hi[2 * i + 1] *= bfhi(ph[i]); }
        }
        res[2 * kp] = (u32x4){pk2(lo[0], lo[1]), pk2(lo[2], lo[3]), pk2(lo[4], lo[5]), pk2(lo[6], lo[7])};
        res[2 * kp + 1] = (u32x4){pk2(hi[0], hi[1]), pk2(hi[2], hi[3]), pk2(hi[4], hi[5]), pk2(hi[6], hi[7])};
    }
    if (MODE == 2) {
#pragma unroll
        for (int i = 0; i < 8; ++i) {
            u32x4 w;
#pragma unroll
            for (int kp = 0; kp < 4; ++kp) {
                const unsigned a = res[2 * kp][i >> 1], c = res[2 * kp + 1][i >> 1];
                w[kp] = (i & 1) ? ((a >> 16) | (c & 0xffff0000u)) : ((a & 0xffffu) | (c << 16));
            }
            *(u32x4*)(outp + ((size_t)(b0 + b) * SEQ + t0 + i) * 512 + c0) = w;
        }
    } else {
#pragma unroll
        for (int k = 0; k < 8; ++k) *(LAS u32x4*)(lds + HM_STG + hm_addr(k, b, t0)) = res[k];
    }
    __syncthreads();
}
__device__ __forceinline__ void gate_rows_i8(const Frame& F, int wv, int nw, size_t rowss_off) {
    const Params& P = *F.P; unsigned char* ws = P.ws + opaque_zero(); const int lane = F.lane;
    const float* rowss = (const float*)(ws + rowss_off); float* fct = (float*)(ws + CTL_FCTA);
    for (int m0 = wv; m0 < MTOK; m0 += 4 * nw) {
        u32x4 v[4][2];
#pragma unroll
        for (int r = 0; r < 4; ++r) { const int m = m0 + r * nw; if (m < MTOK) { const u32x4* xr = (const u32x4*)(ws + WS_XB + (size_t)m * DM * 2) + lane; v[r][0] = xr[0]; v[r][1] = xr[64]; } }
#pragma unroll
        for (int r = 0; r < 4; ++r) { const int m = m0 + r * nw; if (m < MTOK) {
            float f[16];
#pragma unroll
            for (int h = 0; h < 2; ++h) { const u32x4 w = v[r][h]; f[8 * h + 0] = bflo(w.x); f[8 * h + 1] = bfhi(w.x); f[8 * h + 2] = bflo(w.y); f[8 * h + 3] = bfhi(w.y);
                f[8 * h + 4] = bflo(w.z); f[8 * h + 5] = bfhi(w.z); f[8 * h + 6] = bflo(w.w); f[8 * h + 7] = bfhi(w.w); }
            float mx = 0.f;
#pragma unroll
            for (int e = 0; e < 16; ++e) mx = fmaxf(mx, fabsf(f[e]));
#pragma unroll
            for (int o = 32; o > 0; o >>= 1) mx = fmaxf(mx, __shfl_xor(mx, o));
            const float sc = mx > 0.f ? 127.f / mx : 0.f;
            u32x2* o8 = (u32x2*)(ws + WS_XB8 + (size_t)m * DM) + lane;
#pragma unroll
            for (int h = 0; h < 2; ++h)
                o8[64 * h] = (u32x2){pack_b0(q8(f[8 * h] * sc), q8(f[8 * h + 1] * sc), q8(f[8 * h + 2] * sc), q8(f[8 * h + 3] * sc)), pack_b0(q8(f[8 * h + 4] * sc), q8(f[8 * h + 5] * sc), q8(f[8 * h + 6] * sc), q8(f[8 * h + 7] * sc))};
            if (lane == 0) { const f32x4 q = *(const f32x4*)(rowss + (size_t)m * 4);
                *(f32x4*)(fct + (size_t)m * 4) = (f32x4){rsqrtf(((q[0] + q[1]) + (q[2] + q[3])) * (1.f / DM) + RMS_EPS) * mx * (1.f / 127.f), 0.f, 0.f, 0.f}; }
        } }
    }
}
__device__ __forceinline__ void p5_prep(const Frame& F, int l) {
    gate_rows_i8(F, F.bid * 8 + F.wave, F.G * 8, WS_ROWSSB);
}
__device__ __forceinline__ void hyena_phase(const Frame& F, int l) {
    const Params& P = *F.P; unsigned char* ws = P.ws + opaque_zero(); const int tid = F.tid;
    LAS unsigned char* lds = F.lds;
    hm_init_tables(lds, tid);
    const bf16_t* HY = (const bf16_t*)(ws + G_HY); bf16_t* OB = (bf16_t*)(ws + WS_OB);
    const f32x2* spec = (const f32x2*)(ws + WS_S);
    const float* cw = P.in[I_CONVW] + (size_t)l * 3 * 1536; const float* cb = P.in[I_CONVB] + (size_t)l * 1536;
    for (int it = F.bid; it < 256; it += F.G) {
        const int combo = (it & 7) * 4 + (it >> 6), bp = combo >> 3, cg = (combo & 7) * 8 + ((it >> 3) & 7), b0 = 2 * bp, c0 = 8 * cg;
        hm_elem_pass<0>(F, lds, HY, b0, c0, cw, cb, nullptr, c0);
        hm_conv_wave(lds, F.lane, F.wave, spec + (size_t)(c0 + F.wave) * 4096);
        __syncthreads();
        hm_elem_pass<1>(F, lds, HY, b0, 512 + c0, cw, cb, nullptr, c0);
        hm_conv_wave(lds, F.lane, F.wave, spec + (size_t)(512 + c0 + F.wave) * 4096);
        __syncthreads();
        hm_elem_pass<2>(F, lds, HY, b0, 1024 + c0, cw, cb, OB, c0);
    }
}

template <int KW, int DV, bool WINDOW>
__device__ __forceinline__ void attn_core(LAS unsigned char* lds, int tid, const bf16_t* Qg, int ldq, const bf16_t* Kb, int ldk, const bf16_t* Vb, int ldv,
                                          int q0, int t_lo, int t_hi, float m_init, float l_init, int kcol, f32x16 (&o)[DV / 32], float& m_out, float& l_out) {
    constexpr int KSTR = (KW + 8) * 2, VSTR = (DV == 128) ? 320 : 192, KCH = KW / 8, VCH = DV / 8, NK = 64 * KCH / NTHREADS, NV = 64 * VCH / NTHREADS;
    constexpr int KBUF = 64 * KSTR, VBUF = 64 * VSTR, VOFF = 2 * KBUF;
    const int lane = tid & 63, wave = tid >> 6, w4 = wave & 3, r32 = lane & 31, h = lane >> 5;
    const int qrow = q0 + 32 * w4 + r32;
    bf16x8 qf[4];
#pragma unroll
    for (int ds = 0; ds < 4; ++ds) qf[ds] = *(const bf16x8*)(Qg + (size_t)qrow * ldq + 16 * ds + 8 * h);
#pragma unroll
    for (int db = 0; db < DV / 32; ++db)
#pragma unroll
        for (int r = 0; r < 16; ++r) o[db][r] = 0.f;
    float m = m_init, l = l_init;
    u32x4 kreg[NK], vreg[NV];
    auto kload = [&](int t) {
#pragma unroll
        for (int i = 0; i < NK; ++i) { const int c = tid + NTHREADS * i, row = c / KCH, ch = c % KCH; kreg[i] = *(const u32x4*)(Kb + (size_t)(64 * t + row) * ldk + ch * 8); }
    };
    auto vload = [&](int t) {
#pragma unroll
        for (int i = 0; i < NV; ++i) { const int c = tid + NTHREADS * i, row = c / VCH, ch = c % VCH; vreg[i] = *(const u32x4*)(Vb + (size_t)(64 * t + row) * ldv + ch * 8); }
    };
    auto kstore = [&](int buf) {
#pragma unroll
        for (int i = 0; i < NK; ++i) { const int c = tid + NTHREADS * i, row = c / KCH, ch = c % KCH; *(LAS u32x4*)(lds + buf * KBUF + row * KSTR + ch * 16) = kreg[i]; }
    };
    auto vstore = [&](int buf) {
#pragma unroll
        for (int i = 0; i < NV; ++i) { const int c = tid + NTHREADS * i, row = c / VCH, ch = c % VCH; *(LAS u32x4*)(lds + VOFF + buf * VBUF + row * VSTR + ch * 16) = vreg[i]; }
    };
    auto qk = [&](int buf, f32x16& S0, f32x16& S1) {
#pragma unroll
        for (int r = 0; r < 16; ++r) { S0[r] = 0.f; S1[r] = 0.f; }
        const LAS unsigned char* kb = lds + buf * KBUF + r32 * KSTR + (kcol + 8 * h) * 2;
#pragma unroll
        for (int ds = 0; ds < 4; ++ds) {
            const bf16x8 k0 = *(const LAS bf16x8*)(kb + ds * 32);
            const bf16x8 k1 = *(const LAS bf16x8*)(kb + 32 * KSTR + ds * 32);
            S0 = __builtin_amdgcn_mfma_f32_32x32x16_bf16(k0, qf[ds], S0, 0, 0, 0);
            S1 = __builtin_amdgcn_mfma_f32_32x32x16_bf16(k1, qf[ds], S1, 0, 0, 0);
        }
    };
    kload(t_lo); vload(t_lo); kstore(0); vstore(0);
    if (t_lo < t_hi) kload(t_lo + 1);
    __syncthreads();
    f32x16 Sa0, Sa1, Sb0, Sb1;
    qk(0, Sa0, Sa1);
    if (t_lo < t_hi) kstore(1);
    __syncthreads();
    auto step = [&](int t, f32x16& S0, f32x16& S1, f32x16& N0, f32x16& N1) {
        const int i = t - t_lo, vcur = i & 1, knext = (i + 1) & 1;
        if (t + 2 <= t_hi) kload(t + 2);
        if (t + 1 <= t_hi) { vload(t + 1); qk(knext, N0, N1); }
        if (WINDOW) {
            const int kbase = 64 * t + 4 * h - qrow;
#pragma unroll
            for (int r = 0; r < 16; ++r) {
                const int d0 = kbase + (r & 3) + 8 * (r >> 2), d1 = d0 + 32;
                if (d0 > 128 || d0 < -128) S0[r] = -1e30f;
                if (d1 > 128 || d1 < -128) S1[r] = -1e30f;
            }
        }
        float mx0 = fmaxf(fmaxf(S0[0], S0[1]), S0[2]), mx1 = fmaxf(fmaxf(S1[0], S1[1]), S1[2]);
#pragma unroll
        for (int r = 3; r < 15; r += 2) { mx0 = fmaxf(fmaxf(mx0, S0[r]), S0[r + 1]); mx1 = fmaxf(fmaxf(mx1, S1[r]), S1[r + 1]); }
        float mx = fmaxf(fmaxf(mx0, S0[15]), fmaxf(mx1, S1[15]));
        mx = fmaxf(mx, __shfl_xor(mx, 32));
        if (__any(mx > m + 6.0f)) {
            const float mnew = fmaxf(m, mx);
            const float alpha = __builtin_amdgcn_exp2f(m - mnew);
            m = mnew; l *= alpha;
#pragma unroll
            for (int db = 0; db < DV / 32; ++db)
#pragma unroll
                for (int r = 0; r < 16; ++r) o[db][r] *= alpha;
        }
        float ps0 = 0.f, ps1 = 0.f, ps2 = 0.f, ps3 = 0.f;
#pragma unroll
        for (int r = 0; r < 16; r += 2) {
            S0[r] = __builtin_amdgcn_exp2f(S0[r] - m); S0[r + 1] = __builtin_amdgcn_exp2f(S0[r + 1] - m); S1[r] = __builtin_amdgcn_exp2f(S1[r] - m); S1[r + 1] = __builtin_amdgcn_exp2f(S1[r + 1] - m);
            ps0 += S0[r]; ps1 += S0[r + 1]; ps2 += S1[r]; ps3 += S1[r + 1];
        }
        l += (ps0 + ps1) + (ps2 + ps3);
        bf16x8 pf[2][2];
#pragma unroll
        for (int s = 0; s < 2; ++s) {
            u32x4 w0, w1;
            w0.x = pk2(S0[8 * s + 0], S0[8 * s + 1]); w0.y = pk2(S0[8 * s + 2], S0[8 * s + 3]); w0.z = pk2(S0[8 * s + 4], S0[8 * s + 5]); w0.w = pk2(S0[8 * s + 6], S0[8 * s + 7]);
            w1.x = pk2(S1[8 * s + 0], S1[8 * s + 1]); w1.y = pk2(S1[8 * s + 2], S1[8 * s + 3]); w1.z = pk2(S1[8 * s + 4], S1[8 * s + 5]); w1.w = pk2(S1[8 * s + 6], S1[8 * s + 7]);
            pf[0][s] = __builtin_bit_cast(bf16x8, w0); pf[1][s] = __builtin_bit_cast(bf16x8, w1);
        }
        const LAS unsigned char* vb = lds + VOFF + vcur * VBUF + (4 * h + ((lane & 15) >> 2)) * VSTR + (16 * ((lane >> 4) & 1) + 4 * (lane & 3)) * 2;
#pragma unroll
        for (int kh = 0; kh < 2; ++kh)
#pragma unroll
            for (int s = 0; s < 2; ++s)
#pragma unroll
                for (int db = 0; db < DV / 32; ++db) {
                    const LAS unsigned char* p = vb + (32 * kh + 16 * s) * VSTR + db * 64;
                    const s16x4 lo4 = __builtin_amdgcn_ds_read_tr16_b64_v4i16((LAS s16x4*)p);
                    const s16x4 hi4 = __builtin_amdgcn_ds_read_tr16_b64_v4i16((LAS s16x4*)(p + 8 * VSTR));
                    const bf16x8 vf = {lo4[0], lo4[1], lo4[2], lo4[3], hi4[0], hi4[1], hi4[2], hi4[3]};
                    o[db] = __builtin_amdgcn_mfma_f32_32x32x16_bf16(vf, pf[kh][s], o[db], 0, 0, 0);
                }
        if (t + 2 <= t_hi) kstore(i & 1);
        if (t + 1 <= t_hi) vstore((i + 1) & 1);
        __syncthreads();
    };
    int t = t_lo;
    for (; t + 1 <= t_hi; t += 2) { step(t, Sa0, Sa1, Sb0, Sb1); step(t + 1, Sb0, Sb1, Sa0, Sa1); }
    if (t <= t_hi) step(t, Sa0, Sa1, Sb0, Sb1);
    m_out = m; l_out = l;
}

constexpr int ATT_CMB = 75776;
template <int WHICH> __device__ __forceinline__ void attn_phase(const Frame& F, int l) {
    const Params& P = *F.P; unsigned char* ws = P.ws + opaque_zero(); const int tid = F.tid, lane = F.lane, wave = F.wave, g = wave >> 2, w4 = wave & 3, r32 = lane & 31, h = lane >> 5;
    if constexpr (WHICH == 0) {
        const bf16_t* QC = (const bf16_t*)(ws + WS_QC); const bf16_t* KC = (const bf16_t*)(ws + G_KC); const bf16_t* VC = (const bf16_t*)(ws + G_VC); bf16_t* OC = (bf16_t*)(ws + WS_QC);
        const float lam = ((const float*)(ws + CTL_LAM))[l];
        const float lam_init = 0.8f - 0.6f * expf(-0.3f * (float)l);
        const float* subln = P.in[I_SUBLN] + l * 128;
        for (int u = F.bid; u < 512; u += F.G) {
            const int b = u >> 6, head = (u >> 4) & 3, qblk = u & 15, q0 = qblk * 128;
            const size_t rb = (size_t)b * SEQ;
            f32x16 o[4]; float m, lsum;
            attn_core<128, 128, false>(F.lds, tid, QC + rb * 512 + head * 128 + g * 64, 512, KC + rb * 512 + head * 128, 512, VC + rb * 512 + head * 128, 512,
                                       q0, 0, 31, -1e30f, 0.f, g * 64, o, m, lsum);
            lsum += __shfl_xor(lsum, 32);
            const float inv = 1.f / lsum;
            LAS f32x4* cmb = (LAS f32x4*)(F.lds + ATT_CMB);
            if (g == 1) {
#pragma unroll
                for (int db = 0; db < 4; ++db)
#pragma unroll
                    for (int rq = 0; rq < 4; ++rq) cmb[((w4 * 16 + db * 4 + rq) * 64) + lane] = (f32x4){o[db][4 * rq] * inv, o[db][4 * rq + 1] * inv, o[db][4 * rq + 2] * inv, o[db][4 * rq + 3] * inv};
            }
            __syncthreads();
            if (g == 0 && !F.dry) {
                float ss = 0.f;
#pragma unroll
                for (int db = 0; db < 4; ++db)
#pragma unroll
                    for (int rq = 0; rq < 4; ++rq) {
                        const f32x4 o2 = cmb[((w4 * 16 + db * 4 + rq) * 64) + lane];
#pragma unroll
                        for (int i = 0; i < 4; ++i) { const float v = o[db][4 * rq + i] * inv - lam * o2[i]; o[db][4 * rq + i] = v; ss += v * v; }
                    }
                ss += __shfl_xor(ss, 32);
                const float rn = rsqrtf(ss * (1.f / 128.f) + RMS_EPS) * (1.f - lam_init);
                const int qrow = q0 + 32 * w4 + r32;
                bf16_t* op = OC + (rb + qrow) * 512 + head * 128;
#pragma unroll
                for (int db = 0; db < 4; ++db)
#pragma unroll
                    for (int rp = 0; rp < 2; ++rp) {
                        u32x2 w[2];
#pragma unroll
                        for (int k = 0; k < 2; ++k) { const int rq = 2 * rp + k, d = 32 * db + 8 * rq + 4 * h; const f32x4 sg = *(const f32x4*)(subln + d);
                            w[k].x = pk2(o[db][4 * rq] * rn * sg[0], o[db][4 * rq + 1] * rn * sg[1]); w[k].y = pk2(o[db][4 * rq + 2] * rn * sg[2], o[db][4 * rq + 3] * rn * sg[3]); }
                        { auto r = __builtin_amdgcn_permlane32_swap(w[0].x, w[1].x, false, false); w[0].x = r[0]; w[1].x = r[1]; }
                        { auto r = __builtin_amdgcn_permlane32_swap(w[0].y, w[1].y, false, false); w[0].y = r[0]; w[1].y = r[1]; }
                        *(u32x4*)(op + 32 * db + 16 * rp + 8 * h) = (u32x4){w[0].x, w[0].y, w[1].x, w[1].y};
                    }
            }
        }
    }
    if constexpr (WHICH == 1) {
        const bf16_t* QA = (const bf16_t*)(ws + WS_QA); const bf16_t* KA = (const bf16_t*)(ws + G_KA); const bf16_t* VA = (const bf16_t*)(ws + G_VA); bf16_t* OA = (bf16_t*)(ws + WS_QA);
        const float* sink = P.in[I_SINK] + l * 8;
        for (int u = F.bid; u < 512; u += F.G) {
            const int b = u >> 6, kvh = (u >> 5) & 1, qblk = (u >> 1) & 15, hp = u & 1, q0 = qblk * 128;
            const int qh = kvh * 4 + hp * 2 + g;
            const size_t rb = (size_t)b * SEQ;
            int t_lo = (q0 - 128) / 64; if (t_lo < 0) t_lo = 0;
            int t_hi = (q0 + 255) / 64; if (t_hi > 31) t_hi = 31;
            f32x16 o[2]; float m, lsum;
            attn_core<64, 64, true>(F.lds, tid, QA + rb * 512 + qh * 64, 512, KA + rb * 128 + kvh * 64, 128, VA + rb * 128 + kvh * 64, 128,
                                    q0, t_lo, t_hi, sink[qh] * LOG2E, (h == 0) ? 1.f : 0.f, 0, o, m, lsum);
            lsum += __shfl_xor(lsum, 32);
            const float inv = 1.f / lsum;
            const int qrow = q0 + 32 * w4 + r32;
            bf16_t* op = OA + (rb + qrow) * 512 + qh * 64;
            if (!F.dry)
#pragma unroll
            for (int db = 0; db < 2; ++db)
#pragma unroll
                for (int rp = 0; rp < 2; ++rp) {
                    u32x2 w[2];
#pragma unroll
                    for (int k = 0; k < 2; ++k) { const int rq = 2 * rp + k;
                        w[k].x = pk2(o[db][4 * rq] * inv, o[db][4 * rq + 1] * inv); w[k].y = pk2(o[db][4 * rq + 2] * inv, o[db][4 * rq + 3] * inv); }
                    { auto r = __builtin_amdgcn_permlane32_swap(w[0].x, w[1].x, false, false); w[0].x = r[0]; w[1].x = r[1]; }
                    { auto r = __builtin_amdgcn_permlane32_swap(w[0].y, w[1].y, false, false); w[0].y = r[0]; w[1].y = r[1]; }
                    *(u32x4*)(op + 32 * db + 16 * rp + 8 * h) = (u32x4){w[0].x, w[0].y, w[1].x, w[1].y};
                }
        }
    }
}

__device__ __forceinline__ void p1_inproj(const Frame& F, int l) {
    const Params& P = *F.P; unsigned char* ws = P.ws + opaque_zero();
    pg8::Gemm g{(const bf16_t*)(ws + WS_XB), (const bf16_t*)(ws + W_IN), MTOK, NMAIN, DM, 0, 0};
    pg8::StaticOrder S; S.init(MTOK, NMAIN, F.G, F.bid);
    EpiInProj E{nullptr, (const float*)(ws + WS_ROWSSA), (const unsigned*)(ws + CTL_COS), (const unsigned*)(ws + CTL_SIN) + l * 128,
                (bf16_t*)(ws + WS_QA), (bf16_t*)(ws + G_KA), (bf16_t*)(ws + G_VA), (bf16_t*)(ws + WS_QC), (bf16_t*)(ws + G_KC), (bf16_t*)(ws + G_VC), (bf16_t*)(ws + G_HY)};
    pg8::Acc acc;
    {
        const int U = (MTOK / 256) * (NMAIN / 256), R = (U + F.G - 1) / F.G; int ns = R * F.G - U, si = F.bid - (F.G - ns);
        if (ns == 0) { ns = F.G; si = F.bid; }
        if (si >= 0 && !FUSE_XQ(F)) gate_rows_i8(F, si * 8 + F.wave, ns * 8, WS_ROWSSA);
        __syncthreads();
    }
    pg8::gemm_phase<EpiInProj, pg8::StaticOrder, true, true, true>(F.lds, F.tid, g, S, E, acc);
}
__device__ __forceinline__ void p3_merge(const Frame& F, int l) {
    const Params& P = *F.P; unsigned char* ws = P.ws + opaque_zero();
    pg8::ChainOrder3 S; S.S.init(MTOK, DM, F.G, F.bid);
    {
        pg8::Gemm g{(const bf16_t*)(ws + WS_XB8), (const bf16_t*)(ws + W_IN + (size_t)NMAIN * DM * 2), MTOK, DM, DM, 0, (size_t)DM * DM};
        EpiGate E{nullptr, nullptr, F.tid, (const float*)(ws + CTL_FCTA), (const float*)(ws + CS_G), (u32x4*)(ws + WS_G)};
        pg8::Acc acc;
        pg8::gemm_phase<EpiGate, pg8::ChainOrder3, true, true, true, false, true>(F.lds, F.tid, g, S, E, acc);
    }
    {
        pg8::Gemm g{(const bf16_t*)(ws + WS_QA), (const bf16_t*)(ws + W_OA), MTOK, DM, 512, (size_t)16 * MiB, (size_t)DM * 512 * 2};
        EpiMerge E{F.tid, (const u32x4*)(ws + WS_G), (bf16_t*)(ws + WS_S)};
        pg8::Acc acc;
        pg8::gemm_phase<EpiMerge, pg8::ChainOrder3, true, true, true>(F.lds, F.tid, g, S, E, acc);
    }
}
__device__ __forceinline__ void p4_wout(const Frame& F, int l) {
    const Params& P = *F.P; unsigned char* ws = P.ws + opaque_zero();
    pg8::Gemm g{(const bf16_t*)(ws + WS_S), (const bf16_t*)(ws + W_OUT), MTOK, DM, DM, 0, 0};
    pg8::StaticOrder S; S.init(MTOK, DM, F.G, F.bid);
    const bool fuse = FUSE_XQ(F);
    EpiResid<false> E{(bf16_t*)(ws + WS_XB), P.out, (float*)(ws + WS_ROWSSB), F.dry, (LAS float*)(F.lds + pg8::STAGE_BYTES), F.tid,
                      fuse ? ws + WS_XB8 : nullptr, (float*)(ws + CTL_FCTA), (unsigned long long*)(ws + WS_XSLOT), (unsigned*)(ws + CTL_BAR) + CTLW_XQCNT, (unsigned*)(ws + CTL_BAR), 16u * (unsigned)(2 * l + 1)};
    pg8::Acc acc;
    pg8::gemm_phase<EpiResid<false>, pg8::StaticOrder, true, true, true>(F.lds, F.tid, g, S, E, acc);
}
__device__ __forceinline__ void p5_ffn_up(const Frame& F, int l) {
    const Params& P = *F.P; unsigned char* ws = P.ws + opaque_zero();
    pg8::Gemm g{(const bf16_t*)(ws + WS_XB8), (const bf16_t*)(ws + W_13), MTOK, 2 * DFF, DM, 0, 0};
    pg8::TailSplitOrder S; S.init(MTOK, 2 * DFF, F.G, F.bid);
    EpiSwiGLU E{nullptr, nullptr, (const float*)(ws + CTL_FCTA), (const float*)(ws + CS_13), (bf16_t*)(ws + WS_G), F.dry && (P.pad == 12)};
    pg8::Acc acc;
    pg8::gemm_phase<EpiSwiGLU, pg8::TailSplitOrder, true, true, true, true, true>(F.lds, F.tid, g, S, E, acc);
}
template <int L> __device__ __forceinline__ void p6_ffn_down(const Frame& F) {
    const Params& P = *F.P; unsigned char* ws = P.ws + opaque_zero();
    pg8::Gemm g{(const bf16_t*)(ws + WS_G), (const bf16_t*)(ws + W_2), MTOK, DM, DFF, 0, 0};
    pg8::StaticOrder S; S.init(MTOK, DM, F.G, F.bid);
    constexpr bool FINAL = (L + 1 >= DEPTH);
    const bool fuse = FUSE_XQ(F);
    EpiResid<FINAL> E{(bf16_t*)(ws + WS_XB), P.out, (float*)(ws + WS_ROWSSA), F.dry, (LAS float*)(F.lds + pg8::STAGE_BYTES), F.tid,
                      fuse ? ws + WS_XB8 : nullptr, (float*)(ws + CTL_FCTA), (unsigned long long*)(ws + WS_XSLOT), (unsigned*)(ws + CTL_BAR) + CTLW_XQCNT, (unsigned*)(ws + CTL_BAR), 16u * (unsigned)(2 * L + 2)};
    pg8::Acc acc;
    pg8::gemm_phase<EpiResid<FINAL>, pg8::StaticOrder, true, true, true>(F.lds, F.tid, g, S, E, acc);
}

constexpr int PH_PER_LAYER = 8, NPHASE = PH_PER_LAYER * DEPTH;
#define PH_IN(k) (P.lo <= (k) && (k) < P.hi)
#define PH_FRAME() do { int t_ = threadIdx.x; asm volatile("" : "+v"(t_)); F.tid = t_; F.lane = t_ & 63; F.wave = __builtin_amdgcn_readfirstlane(t_ >> 6); \
                        int b_ = blockIdx.x; asm volatile("" : "+s"(b_)); F.bid = b_; } while (0)
#define PH_SEAM(k) do { if (PH_IN(k) && PH_IN((k) + 1)) { if (P.coop) { xcd_barrier(xbar); if (P.pad == 11) xcd_barrier(xbar); } } __syncthreads(); } while (0)
#define PH_RUN(code, call) do { const int nrep_ = (P.pad == (code)) ? 2 : 1; for (int rep_ = 0; rep_ < nrep_; ++rep_) { PH_FRAME(); F.dry = (rep_ + 1 < nrep_); call; __syncthreads(); } } while (0)
template <int L> __device__ __forceinline__ void run_layer(Frame& F, const Params& P, cg::grid_group& grid, const XcdBarrier& xbar) {
    constexpr int B = PH_PER_LAYER * L;
    if (PH_IN(B + 0)) { PH_RUN(1, (p0_weights(F, L), (L == 0 ? p0_misc(F) : (void)0))); }
    PH_SEAM(B + 0);
    if (PH_IN(B + 1)) { PH_RUN(2, spectra_phase(F, L)); PH_RUN(3, p1_inproj(F, L)); }
    PH_SEAM(B + 1);
    if (PH_IN(B + 2)) { PH_RUN(4, hyena_phase(F, L)); PH_RUN(5, attn_phase<0>(F, L)); PH_RUN(6, attn_phase<1>(F, L)); }
    PH_SEAM(B + 2);
    if (PH_IN(B + 3)) { PH_RUN(7, p3_merge(F, L)); }
    PH_SEAM(B + 3);
    if (PH_IN(B + 4)) { PH_RUN(8, p4_wout(F, L)); }
    PH_SEAM(B + 4);
    if (!FUSE_XQ(F)) { if (PH_IN(B + 5)) { PH_RUN(14, p5_prep(F, L)); } PH_SEAM(B + 5); }
    if (PH_IN(B + 6)) { PH_RUN((P.pad == 12 ? 12 : 9), p5_ffn_up(F, L)); }
    PH_SEAM(B + 6);
    if (PH_IN(B + 7)) { PH_RUN(10, p6_ffn_down<L>(F)); }
    PH_SEAM(B + 7);
}
__global__ void __launch_bounds__(NTHREADS, 2) mega_fwd(Params P) {
    extern __shared__ __attribute__((aligned(16))) unsigned char lds_raw[];
    cg::grid_group grid = cg::this_grid();
    Frame F;
    F.lds = (LAS unsigned char*)lds_raw;
    F.G = gridDim.x; F.P = &P;
    volatile LAS unsigned* bst = (volatile LAS unsigned*)(F.lds + LDS_BARST);
    if (threadIdx.x < 4) bst[threadIdx.x] = 0u;
    __syncthreads();
    XcdBarrier xbar; xbar.bar = (unsigned*)(P.ws + CTL_BAR); xbar.x = 0; xbar.st = bst;
    if (P.coop) xbar = xcd_barrier_post((unsigned*)(P.ws + CTL_BAR), bst);
    if (P.coop == 2) grid.sync();
    run_layer<0>(F, P, grid, xbar);
    run_layer<1>(F, P, grid, xbar);
}

#ifndef PROBE_CODE
#define PROBE_CODE 0
#endif
#ifndef N_LAUNCH_MODE
#define N_LAUNCH_MODE 1
#endif
extern "C" void kernel_launch(void* const* d_in, const int* in_sizes, int n_in, void* d_out, int out_size, void* d_ws, size_t ws_size, hipStream_t stream) {
    static int grid = 0;
    if (grid == 0) {
        int dev = 0, cus = 0, per_cu = 0;
        if (hipGetDevice(&dev) != hipSuccess || hipDeviceGetAttribute(&cus, hipDeviceAttributeMultiprocessorCount, dev) != hipSuccess) { fprintf(stderr, "kernel_launch: device query failed\n"); grid = -1; return; }
        if (hipFuncSetAttribute((const void*)mega_fwd, hipFuncAttributeMaxDynamicSharedMemorySize, LDS_BYTES) != hipSuccess) { fprintf(stderr, "kernel_launch: hipFuncSetAttribute failed\n"); grid = -1; return; }
        if (hipOccupancyMaxActiveBlocksPerMultiprocessor(&per_cu, (const void*)mega_fwd, NTHREADS, LDS_BYTES) != hipSuccess || per_cu < 1) { fprintf(stderr, "kernel_launch: occupancy query failed (%d)\n", per_cu); per_cu = 1; }
        (void)hipGetLastError();
        if (per_cu > 1) per_cu = 1;
        grid = cus * per_cu;
        if (n_in != 31 || ws_size < WS_END) fprintf(stderr, "kernel_launch: unexpected n_in %d / ws_size %zu (need %zu)\n", n_in, ws_size, (size_t)WS_END);
    }
    if (grid < 0) return;
    Params p{};
    for (int i = 0; i < 31; ++i) p.in[i] = (const float*)d_in[i];
    p.out = (float*)d_out; p.ws = (unsigned char*)d_ws;
#if N_LAUNCH_MODE == 1
    p.lo = 0; p.hi = NPHASE; p.coop = 1; p.pad = PROBE_CODE;
    if (hipMemsetAsync((char*)d_ws + CTL_BAR, 0, CTL_BAR_BYTES, stream) != hipSuccess) { fprintf(stderr, "kernel_launch: memset of barrier words failed\n"); return; }
    void* args[] = {&p};
    hipError_t e = hipLaunchCooperativeKernel((const void*)mega_fwd, dim3(grid), dim3(NTHREADS), args, LDS_BYTES, stream);
    if (e != hipSuccess) fprintf(stderr, "cooperative launch failed: %s (grid %d)\n", hipGetErrorString(e), grid);
#else
    for (int ph = 0; ph < NPHASE; ++ph) {
        p.lo = ph; p.hi = ph + 1; p.coop = 0;
        hipLaunchKernelGGL(mega_fwd, dim3(grid), dim3(NTHREADS), LDS_BYTES, stream, p);
    }
#endif
}
```

```cpp
#include <hip/hip_runtime.h>
#include <hip/hip_cooperative_groups.h>
#include <cstdint>
#include <cstdio>
namespace cg = cooperative_groups;

#define LAS __attribute__((address_space(3)))
typedef unsigned short bf16_t;
typedef short bf16x8 __attribute__((ext_vector_type(8)));
typedef short s16x4 __attribute__((ext_vector_type(4)));
typedef float f32x2 __attribute__((ext_vector_type(2)));
typedef float f32x4 __attribute__((ext_vector_type(4)));
typedef float f32x16 __attribute__((ext_vector_type(16)));
typedef unsigned u32x2 __attribute__((ext_vector_type(2)));
typedef unsigned u32x4 __attribute__((ext_vector_type(4)));
typedef __bf16 bf16x2_t __attribute__((ext_vector_type(2)));

constexpr int DM = 1024, NBATCH = 8, SEQ = 2048, MTOK = NBATCH * SEQ, DEPTH = 2;
constexpr int INC = 6912, NMAIN = 3840, DFF = 2816;
constexpr float RMS_EPS = 1e-6f;
constexpr float LOG2E = 1.4426950408889634f;
constexpr float QSCALE = 0.125f * LOG2E;
constexpr int NTHREADS = 512;
constexpr int LDS_BYTES = 147456;

constexpr size_t MiB = 1u << 20;
constexpr size_t WS_CTL = 0;
constexpr size_t CTL_ROWSSA = 0;
constexpr size_t CTL_ROWSSB = 128 * 1024;
constexpr size_t CTL_COS = 256 * 1024;
constexpr size_t CTL_SIN = 512 * 1024;
constexpr size_t CTL_LAM = 768 * 1024;
constexpr size_t CTL_TW = 768 * 1024 + 256;
constexpr size_t CTL_H2 = 1 * MiB;
constexpr size_t CTL_BAR = 2 * MiB;
constexpr size_t CTL_BAR_BYTES = 40960;
constexpr int LDS_BARST = LDS_BYTES - 64;
constexpr size_t WS_W = 4 * MiB;
constexpr size_t W_IN = WS_W;
constexpr size_t W_OA = W_IN + (size_t)INC * DM * 2;
constexpr size_t W_OUT = W_OA + 3 * (size_t)DM * 512 * 2;
constexpr size_t W_13 = W_OUT + (size_t)DM * DM * 2;
constexpr size_t W_2 = W_13 + (size_t)2 * DFF * DM * 2;
constexpr size_t WS_XB = 39 * MiB;
constexpr size_t WS_QA = 71 * MiB;
constexpr size_t WS_OB = 87 * MiB;
constexpr size_t WS_QC = 103 * MiB;
constexpr size_t WS_G = 119 * MiB;
constexpr size_t G_KA = WS_G, G_VA = WS_G + 4 * MiB, G_HY = WS_G + 8 * MiB, G_KC = WS_G + 56 * MiB, G_VC = WS_G + 72 * MiB;
constexpr size_t WS_S = 207 * MiB;
constexpr size_t WS_XB8 = 239 * MiB;
constexpr size_t CTL_FCTA = 3 * MiB + 512 * 1024;
constexpr size_t WS_ROWSSA = 2 * MiB + 512 * 1024;
constexpr size_t WS_ROWSSB = 3 * MiB;
constexpr size_t WS_END = 255 * MiB + 512 * 1024;
constexpr size_t CTL_CS = 3 * MiB + 768 * 1024;
constexpr size_t CS_IN = CTL_CS, CS_G = CTL_CS + 16384, CS_13 = CTL_CS + 32768;
constexpr int CTLW_XQCNT = 8192;
constexpr size_t WS_XSLOT = 255 * MiB;
constexpr int CTLW_W13MAX = 4096 + 256;
constexpr int CTLW_GWMAX = 4096;
static_assert(W_2 + (size_t)DM * DFF * 2 <= WS_XB, "weights fit");

struct Params {
    const float* in[31];
    float* out;
    unsigned char* ws;
    int lo, hi, coop, pad;
};
enum { I_X = 0, I_N1G, I_WIN, I_SINK, I_QNA, I_KNA, I_CONVW, I_CONVB, I_FW1, I_FB1, I_FF1, I_FW2, I_FB2, I_FF2, I_FW3, I_HYD, I_QNC, I_KNC, I_LQ1, I_LK1, I_LQ2, I_LK2, I_SUBLN,
       I_WOA, I_WOB, I_WOC, I_WOUT, I_N2G, I_FFW1, I_FFW3, I_FFW2 };

__device__ __forceinline__ unsigned pk2(float lo, float hi) { f32x2 v = {lo, hi}; bf16x2_t b = __builtin_convertvector(v, bf16x2_t); return __builtin_bit_cast(unsigned, b); }
__device__ __forceinline__ float bf2f(unsigned short b) { return __uint_as_float(((unsigned)b) << 16); }
__device__ __forceinline__ float bflo(unsigned w) { return __uint_as_float(w << 16); }
__device__ __forceinline__ float bfhi(unsigned w) { return __uint_as_float(w & 0xffff0000u); }
__device__ __forceinline__ unsigned short f2bf(float f) { return (unsigned short)(pk2(f, 0.f) & 0xffffu); }
__device__ __forceinline__ size_t opaque_zero() { unsigned z = 0; asm volatile("" : "+s"(z)); return (size_t)z; }
__device__ __forceinline__ float wave_sum(float v) {
#pragma unroll
    for (int o = 1; o < 64; o <<= 1) v += __shfl_xor(v, o);
    return v;
}
__device__ __forceinline__ void rows_rstd8(const float* rowss, int row0, float (&rs)[8]) {
    f32x4 q[8];
#pragma unroll
    for (int k = 0; k < 8; ++k) q[k] = *(const f32x4*)(rowss + (size_t)(row0 + (k >> 2) * 128 + (k & 3) * 16) * 4);
#pragma unroll
    for (int k = 0; k < 8; ++k) rs[k] = rsqrtf(((q[k][0] + q[k][1]) + (q[k][2] + q[k][3])) * (1.f / DM) + RMS_EPS);
}
__device__ __forceinline__ void rows_rstd8_lds(LAS const float* p, int fr, float (&rs)[8]) {
    f32x4 q[8];
#pragma unroll
    for (int k = 0; k < 8; ++k) q[k] = *(LAS const f32x4*)(p + (k >> 2) * 256 + ((k & 3) * 16 + fr) * 4);
#pragma unroll
    for (int k = 0; k < 8; ++k) rs[k] = rsqrtf(((q[k][0] + q[k][1]) + (q[k][2] + q[k][3])) * (1.f / DM) + RMS_EPS);
}
__device__ __forceinline__ void st16_wt(void* p, u32x4 v) { asm volatile("global_store_dwordx4 %0, %1, off sc1" :: "v"(p), "v"(v) : "memory"); }
__device__ __forceinline__ int crow(int r, int hi) { return (r & 3) + 8 * (r >> 2) + 4 * hi; }

namespace pg8 {
constexpr int BM = 256, BK = 64, HALF = 128, HTB = HALF * BK * 2, STAGE_BYTES = 8 * HTB, NXCD = 8, WGM = 8;
constexpr int CS_OFF = STAGE_BYTES + 4096 + 8192;
constexpr int RS_OFF = STAGE_BYTES + 4096;
__host__ __device__ __forceinline__ int lds_byte(int r, int c) { const int st = (r >> 4) * 2 + (c >> 5), rr = r & 15, cc = c & 31, ob = rr * 64 + cc * 2; return st * 1024 + (ob ^ (((ob >> 9) & 1) << 5)); }
__host__ __device__ __forceinline__ void stage_rc(int b, int& R, int& C) { const int st = b / 1024, sb = b % 1024, swz = sb ^ (((sb >> 9) & 1) << 5); R = (st >> 1) * 16 + swz / 64; C = (st & 1) * 32 + (swz % 64) / 2; }
__host__ __device__ __forceinline__ int perm32(int rho) { const int n = rho >> 4, i = rho & 15; return 8 * (i >> 2) + 4 * n + (i & 3); }

struct Unit { int pm, pn, sub, half; };
struct Gemm { const bf16_t* A; const bf16_t* Bt; int M, N, K; size_t sA, sB; };

struct StaticOrder {
    int nM, nN, nwg, G, c;
    __host__ __device__ void init(int M, int N, int G_, int c_) { nM = M / BM; nN = N / BM; nwg = nM * nN; G = G_; c = c_; }
    __host__ __device__ void map(int L, Unit& u) const {
        int wgid = L; { const int q = nwg / NXCD, r = nwg % NXCD, xcd = wgid % NXCD, off = wgid / NXCD; wgid = (xcd < r ? xcd * (q + 1) : r * (q + 1) + (xcd - r) * q) + off; }
        const int nig = WGM * nN, gid = wgid / nig, fm = gid * WGM, gsz = (nM - fm) < WGM ? (nM - fm) : WGM;
        u.pm = fm + ((wgid % nig) % gsz); u.pn = (wgid % nig) / gsz; u.sub = 0; u.half = 0;
    }
    __host__ __device__ bool next(int i, Unit& u) const {
        const long L = (long)i * G + c; if (L >= nwg) return false;
        map((int)L, u); return true;
    }
};
struct TailSplitOrder {
    StaticOrder S; int full, rem;
    __device__ __forceinline__ void init(int M, int N, int G_, int c_) { S.init(M, N, G_, c_); full = (S.nwg / G_) * G_; rem = S.nwg - full; }
    __device__ __forceinline__ bool next(int i, Unit& u) const {
        const long L = (long)i * S.G + S.c;
        if (2 * rem != S.G || L < full) return S.next(i, u);
        if (i != full / S.G) return false;
        S.map(full + (S.c >> 1), u); u.half = 1 + (S.c & 1); return true;
    }
};
struct ChainOrder3 {
    StaticOrder S;
    __device__ __forceinline__ bool next(int i, Unit& u) const { const int q = i / 3; if (!S.next(q, u)) return false; u.sub = i - 3 * q; return true; }
};

typedef f32x4 Acc[2][2][4][2];
typedef int i32x4v __attribute__((ext_vector_type(4)));

template <class Epi, class Sched, bool ALIGN_EPI, bool SP2, bool ZERO, bool HALF_OK = false, bool I8 = false>
__device__ __forceinline__ void gemm_phase(LAS unsigned char* lds, const int tid, const Gemm g, const Sched& S, Epi& E, Acc& acc) {
    const int wid = __builtin_amdgcn_readfirstlane(tid >> 6), lane = tid & 63, wr = wid >> 2, wc = wid & 3, fr = lane & 15, fq = lane >> 4;
    constexpr int ES = I8 ? 1 : 2;
    const int K = g.K, nt = K * ES / (BK * 2);
    unsigned voffA[2], voffB[2];
#pragma unroll
    for (int i = 0; i < 2; ++i) { int R, C; stage_rc(tid * 16 + i * 8192, R, C); const int Rb = Epi::PERM ? ((R & ~31) + perm32(R & 31)) : R;
        voffA[i] = (unsigned)(R * K * ES + C * 2); voffB[i] = (unsigned)(Rb * K * ES + C * 2); }
    const size_t kstep = (size_t)(BK * 2);
    const size_t hstep = (size_t)HALF * K * ES;
    const size_t tstep = 2 * hstep;
    const unsigned ldsw = (unsigned)wid * 1024u;
    const int aoff = lds_byte(wr * 64 + fr, fq * 8), boff = lds_byte(wc * 32 + fr, fq * 8);
#define PG8_SA(b, h) (((b) * 2 + (h)) * HTB)
#define PG8_SB(b, h) ((4 + (b) * 2 + (h)) * HTB)
#define PG8_STAGE(bufoff, gbase, voff) do { _Pragma("unroll") for (int _i = 0; _i < 2; ++_i) \
        __builtin_amdgcn_global_load_lds((const unsigned*)((const char*)(gbase) + (voff)[_i]), (LAS unsigned*)(lds + (bufoff) + ldsw + _i * 8192), 16, 0, 0); } while (0)
#define PG8_LDA(dst, b, h) do { _Pragma("unroll") for (int m = 0; m < 4; ++m) _Pragma("unroll") for (int k = 0; k < 2; ++k) dst[m][k] = *(const LAS bf16x8*)(lds + PG8_SA(b, h) + aoff + m * 2048 + k * 1024); } while (0)
#define PG8_LDB(dst, b, h) do { _Pragma("unroll") for (int n = 0; n < 2; ++n) _Pragma("unroll") for (int k = 0; k < 2; ++k) dst[n][k] = *(const LAS bf16x8*)(lds + PG8_SB(b, h) + boff + n * 2048 + k * 1024); } while (0)
#define PG8_MMA(ai, bj, At, Bt) do { __builtin_amdgcn_s_setprio(1); _Pragma("unroll") for (int m = 0; m < 4; ++m) _Pragma("unroll") for (int n = 0; n < 2; ++n) { \
        _Pragma("unroll") for (int k = 0; k < 2; ++k) { \
        if constexpr (I8) acc[ai][bj][m][n] = __builtin_bit_cast(f32x4, __builtin_amdgcn_mfma_i32_16x16x64_i8(__builtin_bit_cast(i32x4v, Bt[n][k]), __builtin_bit_cast(i32x4v, At[m][k]), __builtin_bit_cast(i32x4v, acc[ai][bj][m][n]), 0, 0, 0)); \
        else acc[ai][bj][m][n] = __builtin_amdgcn_mfma_f32_16x16x32_bf16(Bt[n][k], At[m][k], acc[ai][bj][m][n], 0, 0, 0); } } \
        __builtin_amdgcn_s_setprio(0); } while (0)
#define PG8_WAIT_V(n) asm volatile("s_waitcnt vmcnt(" #n ")" ::: "memory")
#define PG8_WAIT_L(n) asm volatile("s_waitcnt lgkmcnt(" #n ")" ::: "memory")
#define PG8_BAR __builtin_amdgcn_s_barrier()
#define PG8_SCHED __builtin_amdgcn_sched_barrier(0)
#define PG8_ZERO_ACC() do { _Pragma("unroll") for (int a = 0; a < 2; ++a) _Pragma("unroll") for (int b = 0; b < 2; ++b) _Pragma("unroll") for (int m = 0; m < 4; ++m) _Pragma("unroll") for (int n = 0; n < 2; ++n) acc[a][b][m][n] = (f32x4){0.f, 0.f, 0.f, 0.f}; } while (0)
#define PG8_RS_LOAD(un, par) do { if constexpr (Epi::RS_LDS) { if (wc == 0) { _Pragma("unroll") for (int _a = 0; _a < 2; ++_a) \
        __builtin_amdgcn_global_load_lds((const unsigned*)(E.rowss + (size_t)((un).pm * 256 + _a * 128 + wr * 64 + lane) * 4), (LAS unsigned*)(lds + RS_OFF + (par) * 4096 + wr * 2048 + _a * 1024), 16, 0, 0); } } } while (0)
#define PG8_CS_LOAD(un, par) do { if constexpr (Epi::CS_LDS) { if (wid == 1) \
        __builtin_amdgcn_global_load_lds((const unsigned*)(E.cs_ptr(un) + 4 * lane), (LAS unsigned*)(lds + CS_OFF + (par) * 1024), 16, 0, 0); } } while (0)
    Unit cur, nxt; int ui = 0;
    if (!S.next(0, cur)) return;
    if (ZERO) PG8_ZERO_ACC();
    PG8_RS_LOAD(cur, 0); PG8_CS_LOAD(cur, 0);
    bf16x8 At[4][2], B0[2][2], B1[2][2];
    const char* cA = (const char*)g.A + (size_t)cur.sub * g.sA + (size_t)cur.pm * tstep; const char* cB = (const char*)g.Bt + (size_t)cur.sub * g.sB + (size_t)cur.pn * tstep;
    if constexpr (SP2) {
        PG8_STAGE(PG8_SB(0, 0), cB, voffB); PG8_STAGE(PG8_SB(0, 1), cB + hstep, voffB); PG8_STAGE(PG8_SA(0, 0), cA, voffA); PG8_STAGE(PG8_SA(0, 1), cA + hstep, voffA);
        if (wr == 1) PG8_BAR;
        PG8_WAIT_V(2); PG8_BAR;
        PG8_STAGE(PG8_SB(1, 0), cB + kstep, voffB); PG8_STAGE(PG8_SA(1, 0), cA + kstep, voffA); PG8_STAGE(PG8_SB(1, 1), cB + hstep + kstep, voffB);
        PG8_WAIT_V(6); PG8_BAR;
    } else {
        PG8_STAGE(PG8_SB(0, 0), cB, voffB); PG8_STAGE(PG8_SA(0, 0), cA, voffA); PG8_STAGE(PG8_SB(0, 1), cB + hstep, voffB); PG8_STAGE(PG8_SA(0, 1), cA + hstep, voffA);
        if (wr == 1) PG8_BAR;
        PG8_WAIT_V(4); PG8_BAR;
        PG8_STAGE(PG8_SB(1, 0), cB + kstep, voffB); PG8_STAGE(PG8_SA(1, 0), cA + kstep, voffA); PG8_STAGE(PG8_SB(1, 1), cB + hstep + kstep, voffB);
        PG8_WAIT_V(6); PG8_BAR;
    }
    for (;;) {
        const bool has_next = S.next(ui + 1, nxt);
        const char* nA = has_next ? (const char*)g.A + (size_t)nxt.sub * g.sA + (size_t)nxt.pm * tstep : cA; const char* nB = has_next ? (const char*)g.Bt + (size_t)nxt.sub * g.sB + (size_t)nxt.pn * tstep : cB;
        const bool do0 = !HALF_OK || cur.half != 2, do1 = !HALF_OK || cur.half != 1;
#pragma unroll 1
        for (int t = 0; t < nt; t += 2) {
            const bool last = (t == nt - 2);
            const char* a1 = cA + (size_t)(t + 1) * kstep;
            const char* a2 = last ? nA : cA + (size_t)(t + 2) * kstep; const char* b2 = last ? nB : cB + (size_t)(t + 2) * kstep;
            const char* a3 = a2 + kstep; const char* b3 = b2 + kstep;
            if constexpr (SP2) {
            PG8_LDB(B0, 0, 0); PG8_LDB(B1, 0, 1); PG8_SCHED; if (do0) PG8_LDA(At, 0, 0); PG8_STAGE(PG8_SA(1, 1), a1 + hstep, voffA);
            PG8_WAIT_V(8); PG8_WAIT_L(0); PG8_BAR; if (do0) { PG8_MMA(0, 0, At, B0); PG8_MMA(0, 1, At, B1); } PG8_BAR; PG8_SCHED;
            if (do1) PG8_LDA(At, 0, 1); PG8_STAGE(PG8_SB(0, 0), b2, voffB); PG8_STAGE(PG8_SB(0, 1), b2 + hstep, voffB); PG8_STAGE(PG8_SA(0, 0), a2, voffA);
            PG8_WAIT_V(8); PG8_WAIT_L(0); PG8_BAR; if (do1) { PG8_MMA(1, 0, At, B0); PG8_MMA(1, 1, At, B1); } PG8_BAR; PG8_SCHED;
            PG8_LDB(B0, 1, 0); PG8_LDB(B1, 1, 1); PG8_SCHED; if (do0) PG8_LDA(At, 1, 0); PG8_STAGE(PG8_SA(0, 1), a2 + hstep, voffA);
            PG8_WAIT_V(8); PG8_WAIT_L(0); PG8_BAR; if (do0) { PG8_MMA(0, 0, At, B0); PG8_MMA(0, 1, At, B1); } PG8_BAR; PG8_SCHED;
            if (do1) PG8_LDA(At, 1, 1); PG8_STAGE(PG8_SB(1, 0), b3, voffB); PG8_STAGE(PG8_SB(1, 1), b3 + hstep, voffB); PG8_STAGE(PG8_SA(1, 0), a3, voffA);
            PG8_WAIT_V(8); PG8_WAIT_L(0); PG8_BAR; if (do1) { PG8_MMA(1, 0, At, B0); PG8_MMA(1, 1, At, B1); } PG8_BAR; PG8_SCHED;
            } else {
            PG8_LDB(B0, 0, 0); PG8_SCHED; PG8_LDA(At, 0, 0); PG8_STAGE(PG8_SA(1, 1), a1 + hstep, voffA);
            PG8_WAIT_L(8); PG8_BAR; PG8_WAIT_L(0); PG8_MMA(0, 0, At, B0); PG8_BAR; PG8_SCHED;
            PG8_LDB(B1, 0, 1); PG8_STAGE(PG8_SB(0, 0), b2, voffB);
            PG8_BAR; PG8_WAIT_L(0); PG8_MMA(0, 1, At, B1); PG8_BAR;
            PG8_LDA(At, 0, 1); PG8_STAGE(PG8_SA(0, 0), a2, voffA);
            PG8_BAR; PG8_WAIT_L(0); PG8_MMA(1, 0, At, B0); PG8_BAR; PG8_SCHED;
            PG8_STAGE(PG8_SB(0, 1), b2 + hstep, voffB);
            PG8_WAIT_V(6); PG8_BAR; PG8_MMA(1, 1, At, B1); PG8_BAR;
            PG8_LDB(B0, 1, 0); PG8_SCHED; PG8_LDA(At, 1, 0); PG8_STAGE(PG8_SA(0, 1), a2 + hstep, voffA);
            PG8_WAIT_L(8); PG8_BAR; PG8_WAIT_L(0); PG8_MMA(0, 0, At, B0); PG8_BAR; PG8_SCHED;
            PG8_LDB(B1, 1, 1); PG8_STAGE(PG8_SB(1, 0), b3, voffB);
            PG8_BAR; PG8_WAIT_L(0); PG8_MMA(0, 1, At, B1); PG8_BAR;
            PG8_LDA(At, 1, 1); PG8_STAGE(PG8_SA(1, 0), a3, voffA);
            PG8_BAR; PG8_WAIT_L(0); PG8_MMA(1, 0, At, B0); PG8_BAR; PG8_SCHED;
            PG8_STAGE(PG8_SB(1, 1), b3 + hstep, voffB);
            PG8_WAIT_V(6); PG8_BAR; PG8_MMA(1, 1, At, B1); PG8_BAR;
            }
        }
        if constexpr (ALIGN_EPI) { if (wr == 0) PG8_BAR; }
        if constexpr (Epi::RS_LDS) E.rsl = (LAS const float*)(lds + RS_OFF + (ui & 1) * 4096 + wr * 2048);
        if constexpr (Epi::CS_LDS) E.csl = (LAS const float*)(lds + CS_OFF + (ui & 1) * 1024);
        const bool keep = E(acc, cur, wr, wc, fr, fq);
        if (!has_next) break;
        if (!keep) PG8_ZERO_ACC();
        cur = nxt; cA = nA; cB = nB; ++ui;
        PG8_RS_LOAD(cur, ui & 1); PG8_CS_LOAD(cur, ui & 1);
        if constexpr (ALIGN_EPI) { if (wr == 1) PG8_BAR; }
    }
    PG8_WAIT_V(0);
    if constexpr (!ALIGN_EPI) { if (wr == 0) PG8_BAR; }
    PG8_BAR;
#undef PG8_SA
#undef PG8_SB
#undef PG8_STAGE
#undef PG8_LDA
#undef PG8_LDB
#undef PG8_MMA
#undef PG8_WAIT_V
#undef PG8_WAIT_L
#undef PG8_BAR
#undef PG8_SCHED
#undef PG8_ZERO_ACC
#undef PG8_RS_LOAD
#undef PG8_CS_LOAD
}
}

#define XB_TMO      128
#define XB_XCNT(j)  (256  + 64 * (j))
#define XB_XSUB(j)  (1280 + 64 * (j))
#define XB_XGEN(j)  (2304 + 64 * (j))
#define XB_TOP      3328
#define XB_TOPGEN   3392
#define XCD_BAR_WORDS 3456
#define XB_SPIN_CAP (1u << 18)
__device__ __forceinline__ unsigned xb_ld(unsigned* p)              { return __hip_atomic_load(p, __ATOMIC_RELAXED, __HIP_MEMORY_SCOPE_AGENT); }
__device__ __forceinline__ unsigned xb_add(unsigned* p, unsigned v) { return __hip_atomic_fetch_add(p, v, __ATOMIC_RELAXED, __HIP_MEMORY_SCOPE_AGENT); }
__device__ __forceinline__ unsigned xb_xcc_id() { return (unsigned)__builtin_amdgcn_s_getreg((3 << 11) | 20) & 0xFu; }
#define XB_SPIN(cond, bar) do { unsigned _sp = 0; while (cond) { __builtin_amdgcn_s_sleep(1); \
    if ((++_sp & 255u) == 0u) { if (xb_ld(&(bar)[XB_TMO])) break; if (_sp > XB_SPIN_CAP) { atomicAdd(&(bar)[XB_TMO], 1u); break; } } } } while (0)
__device__ __forceinline__ unsigned q8(float t) { return __builtin_bit_cast(unsigned, __builtin_amdgcn_fmed3f(t, -127.f, 127.f) + 12582912.f); }
template <bool I8> struct EpiInProj {
    static constexpr bool PERM = true, RS_LDS = true, CS_LDS = I8;
    LAS const float* rsl; LAS const float* csl;
    const float* rowss; const float* cs; int pn0; const unsigned* csT; const unsigned* gp;
    bf16_t *QA, *KA, *VA, *QC, *KC, *VC, *HY;
    __device__ __forceinline__ const float* cs_ptr(const pg8::Unit& u) const { return cs + u.pn * 256; }
    __device__ __forceinline__ bool operator()(pg8::Acc& acc, const pg8::Unit& u, int wr, int wc, int fr, int fq) const {
        const int g = 4 * (u.pn + pn0) + wc;
        int kind, ld, hd, gty = 0; bf16_t* dst;
        if (g < 8)       { kind = 2; dst = QA; ld = 512; hd = g; gty = 0; }
        else if (g < 10) { kind = 1; dst = KA; ld = 128; hd = g - 8; gty = 1; }
        else if (g < 12) { kind = 0; dst = VA; ld = 128; hd = g - 10; }
        else if (g < 20) { kind = 2; dst = QC; ld = 512; hd = g - 12; gty = 2; }
        else if (g < 28) { kind = 1; dst = KC; ld = 512; hd = g - 20; gty = 3; }
        else if (g < 36) { kind = 0; dst = VC; ld = 512; hd = g - 28; }
        else             { kind = 0; dst = HY; ld = 1536; hd = g - 36; }
        const int col0 = 64 * hd + 8 * fq;
        const float qs = (kind == 2) ? QSCALE : 1.f;
        float rs8[8];
        if constexpr (I8) {
#pragma unroll
            for (int k = 0; k < 8; ++k) rs8[k] = rsl[(k >> 2) * 256 + ((k & 3) * 16 + fr) * 4];
            f32x4 cq[2][2];
#pragma unroll
            for (int bj = 0; bj < 2; ++bj)
#pragma unroll
                for (int n = 0; n < 2; ++n) cq[bj][n] = *(const LAS f32x4*)(csl + bj * 128 + wc * 32 + 8 * fq + 4 * n);
#pragma unroll
            for (int ai = 0; ai < 2; ++ai)
#pragma unroll
                for (int bj = 0; bj < 2; ++bj)
#pragma unroll
                    for (int m = 0; m < 4; ++m)
#pragma unroll
                        for (int n = 0; n < 2; ++n) { const pg8::i32x4v t = __builtin_bit_cast(pg8::i32x4v, acc[ai][bj][m][n]);
                            acc[ai][bj][m][n] = (f32x4){(float)t[0], (float)t[1], (float)t[2], (float)t[3]} * cq[bj][n]; }
        } else rows_rstd8_lds(rsl, fr, rs8);
        const int rowb = u.pm * 256 + wr * 64 + fr;
        if (kind == 0) {
#pragma unroll
            for (int ai = 0; ai < 2; ++ai)
#pragma unroll
                for (int m = 0; m < 4; ++m) {
                    const int row = rowb + ai * 128 + m * 16;
                    const float rstd = rs8[ai * 4 + m];
                    const f32x4 a0 = acc[ai][0][m][0] * rstd, a1 = acc[ai][0][m][1] * rstd, b0 = acc[ai][1][m][0] * rstd, b1 = acc[ai][1][m][1] * rstd;
                    u32x4 wa, wb;
                    wa.x = pk2(a0[0], a0[1]); wa.y = pk2(a0[2], a0[3]); wa.z = pk2(a1[0], a1[1]); wa.w = pk2(a1[2], a1[3]);
                    wb.x = pk2(b0[0], b0[1]); wb.y = pk2(b0[2], b0[3]); wb.z = pk2(b1[0], b1[1]); wb.w = pk2(b1[2], b1[3]);
                    if (g >= 36) {
                        bf16_t* rp = dst + ((size_t)(8 * hd + fq) * MTOK + row) * 8;
                        *(u32x4*)rp = wa; *(u32x4*)(rp + (size_t)4 * MTOK * 8) = wb;
                    } else {
                        bf16_t* rp = dst + (size_t)row * ld + col0;
                        *(u32x4*)rp = wa; *(u32x4*)(rp + 32) = wb;
                    }
                }
        } else {
            const u32x4 gq0 = *(const u32x4*)(gp + gty * 32 + 8 * fq), gq1 = *(const u32x4*)(gp + gty * 32 + 8 * fq + 4);
            u32x4 cs[2][2];
            { const unsigned* cp = csT + (rowb & (SEQ - 1)) * 32 + 8 * fq; cs[0][0] = *(const u32x4*)cp; cs[0][1] = *(const u32x4*)(cp + 4); }
#pragma unroll
            for (int it = 0; it < 8; ++it) {
                const int ai = it >> 2, m = it & 3;
                const int row = rowb + ai * 128 + m * 16;
                if (it + 1 < 8) { const int nrow = rowb + ((it + 1) >> 2) * 128 + ((it + 1) & 3) * 16; const unsigned* cp = csT + (nrow & (SEQ - 1)) * 32 + 8 * fq;
                    cs[(it + 1) & 1][0] = *(const u32x4*)cp; cs[(it + 1) & 1][1] = *(const u32x4*)(cp + 4); }
                const float rstd = rs8[it];
                float ss = 0.f;
#pragma unroll
                for (int n = 0; n < 2; ++n)
#pragma unroll
                    for (int i = 0; i < 4; ++i) { const float x = acc[ai][0][m][n][i], y = acc[ai][1][m][n][i]; ss += x * x + y * y; }
                ss += __shfl_xor(ss, 16); ss += __shfl_xor(ss, 32);
                const float f = rstd * rsqrtf(ss * rstd * rstd * (1.f / 64.f) + RMS_EPS) * qs;
                u32x4 wa, wb;
#pragma unroll
                for (int n = 0; n < 2; ++n) {
                    const u32x4 gq = n ? gq1 : gq0, cq = cs[it & 1][n];
                    float ra[4], rb[4];
#pragma unroll
                    for (int i = 0; i < 4; ++i) {
                        const float ga = (float)__builtin_bit_cast(_Float16, (unsigned short)(gq[i] & 0xffffu)), gb = (float)__builtin_bit_cast(_Float16, (unsigned short)(gq[i] >> 16));
                        const float c = (float)__builtin_bit_cast(_Float16, (unsigned short)(cq[i] & 0xffffu)), sn = (float)__builtin_bit_cast(_Float16, (unsigned short)(cq[i] >> 16));
                        const float x = acc[ai][0][m][n][i] * (f * ga), y = acc[ai][1][m][n][i] * (f * gb);
                        ra[i] = x * c - y * sn; rb[i] = y * c + x * sn;
                    }
                    if (n == 0) { wa.x = pk2(ra[0], ra[1]); wa.y = pk2(ra[2], ra[3]); wb.x = pk2(rb[0], rb[1]); wb.y = pk2(rb[2], rb[3]); }
                    else        { wa.z = pk2(ra[0], ra[1]); wa.w = pk2(ra[2], ra[3]); wb.z = pk2(rb[0], rb[1]); wb.w = pk2(rb[2], rb[3]); }
                }
                bf16_t* rp = dst + (size_t)row * ld + col0;
                *(u32x4*)rp = wa; *(u32x4*)(rp + 32) = wb;
                asm volatile("" ::: "memory");
            }
        }
        return false;
    }
};

#ifndef MERGE_PD
#define MERGE_PD 2
#endif
__device__ __forceinline__ unsigned gate_q(float a) {
    const float t = __builtin_amdgcn_fmed3f(__builtin_fmaf(__builtin_amdgcn_exp2f(a), 1.f / 255.f, 1.f / 255.f), 0.f, 1.f);
    return __builtin_bit_cast(unsigned, __builtin_amdgcn_rcpf(t) + 8388608.f);
}
__device__ __forceinline__ unsigned pack_b0(unsigned u0, unsigned u1, unsigned u2, unsigned u3) {
    return __builtin_amdgcn_perm(__builtin_amdgcn_perm(u3, u2, 0x0c0c0400u), __builtin_amdgcn_perm(u1, u0, 0x0c0c0400u), 0x05040100u);
}
struct EpiGate {
    static constexpr bool PERM = true, RS_LDS = true, CS_LDS = true;
    LAS const float* rsl; LAS const float* csl;
    int tid; const float* rowss; const float* cs; u32x4* scr0;
    __device__ __forceinline__ const float* cs_ptr(const pg8::Unit& u) const { return cs + u.sub * DM + u.pn * 256; }
    __device__ __forceinline__ bool operator()(pg8::Acc& acc, const pg8::Unit& u, int wr, int wc, int fr, int fq) const {
        u32x4* scr = scr0 + ((size_t)(u.pm * 4 + u.pn) * 3 + u.sub) * 8 * 512 + tid;
        float rs8[8];
#pragma unroll
        for (int k = 0; k < 8; ++k) rs8[k] = rsl[(k >> 2) * 256 + ((k & 3) * 16 + fr) * 4];
        f32x4 cq[2][2];
#pragma unroll
        for (int bj = 0; bj < 2; ++bj)
#pragma unroll
            for (int n = 0; n < 2; ++n) cq[bj][n] = *(const LAS f32x4*)(csl + bj * 128 + wc * 32 + 8 * fq + 4 * n) * (-LOG2E);
#pragma unroll
        for (int ai = 0; ai < 2; ++ai)
#pragma unroll
            for (int m = 0; m < 4; ++m) {
                const float rs = rs8[ai * 4 + m];
                unsigned pw[4];
#pragma unroll
                for (int bj = 0; bj < 2; ++bj) {
                    const pg8::i32x4v i0 = __builtin_bit_cast(pg8::i32x4v, acc[ai][bj][m][0]), i1 = __builtin_bit_cast(pg8::i32x4v, acc[ai][bj][m][1]);
                    const f32x4 v0 = (f32x4){(float)i0[0], (float)i0[1], (float)i0[2], (float)i0[3]} * cq[bj][0], v1 = (f32x4){(float)i1[0], (float)i1[1], (float)i1[2], (float)i1[3]} * cq[bj][1];
                    pw[bj * 2] = pack_b0(gate_q(v0[0] * rs), gate_q(v0[1] * rs), gate_q(v0[2] * rs), gate_q(v0[3] * rs));
                    pw[bj * 2 + 1] = pack_b0(gate_q(v1[0] * rs), gate_q(v1[1] * rs), gate_q(v1[2] * rs), gate_q(v1[3] * rs));
                }
                u32x4 w; w.x = pw[0]; w.y = pw[1]; w.z = pw[2]; w.w = pw[3];
                st16_wt(scr + (size_t)(ai * 4 + m) * 512, w);
            }
        return false;
    }
};
__device__ __forceinline__ float ub(unsigned w, int k) { return (float)((w >> (8 * k)) & 0xffu); }
struct EpiMerge {
    static constexpr bool PERM = true, RS_LDS = false, CS_LDS = false;
    static constexpr int PD = MERGE_PD;
    int tid; const u32x4* scr0; bf16_t* merged;
    __device__ __forceinline__ bool operator()(pg8::Acc& acc, const pg8::Unit& u, int wr, int wc, int fr, int fq) const {
        const int sub = u.sub;
        const u32x4* sa_p = scr0 + ((size_t)(u.pm * 4 + u.pn) * 3 + sub) * 8 * 512 + tid;
        u32x4 wa[8], wb[8];
#pragma unroll
        for (int it = 0; it < PD; ++it) { wa[it] = sa_p[(size_t)it * 512]; if (sub < 2) wb[it] = sa_p[(size_t)(8 + it) * 512]; }
#pragma unroll
        for (int it = 0; it < 8; ++it) {
            const int ai = it >> 2, m = it & 3;
            const int row = u.pm * 256 + ai * 128 + wr * 64 + m * 16 + fr;
            if (it + PD < 8) { wa[it + PD] = sa_p[(size_t)(it + PD) * 512]; if (sub < 2) wb[it + PD] = sa_p[(size_t)(8 + it + PD) * 512]; }
#pragma unroll
            for (int bj = 0; bj < 2; ++bj) {
                f32x4& v0 = acc[ai][bj][m][0]; f32x4& v1 = acc[ai][bj][m][1];
                const unsigned a0 = bj ? wa[it].z : wa[it].x, a1 = bj ? wa[it].w : wa[it].y;
                if (sub < 2) {
                    const unsigned b0 = bj ? wb[it].z : wb[it].x, b1 = bj ? wb[it].w : wb[it].y;
#pragma unroll
                    for (int i = 0; i < 4; ++i) { v0[i] *= ub(a0, i) * __builtin_amdgcn_rcpf(ub(b0, i)); v1[i] *= ub(a1, i) * __builtin_amdgcn_rcpf(ub(b1, i)); }
                } else {
                    constexpr float C = 1.f / 255.f;
                    u32x4 w; w.x = pk2(v0[0] * (ub(a0, 0) * C), v0[1] * (ub(a0, 1) * C)); w.y = pk2(v0[2] * (ub(a0, 2) * C), v0[3] * (ub(a0, 3) * C));
                    w.z = pk2(v1[0] * (ub(a1, 0) * C), v1[1] * (ub(a1, 1) * C)); w.w = pk2(v1[2] * (ub(a1, 2) * C), v1[3] * (ub(a1, 3) * C));
                    *(u32x4*)(merged + (size_t)row * DM + u.pn * 256 + bj * 128 + wc * 32 + 8 * fq) = w;
                }
            }
            asm volatile("" ::: "memory");
        }
        return sub < 2;
    }
};

template <bool FINAL> struct EpiResid {
    static constexpr bool PERM = true, RS_LDS = false, CS_LDS = false;
    bf16_t* xb; float* xout; float* rowss; bool dry; LAS float* red; int tid;
    unsigned char* xq; float* fct; unsigned long long* xslot; unsigned* xcnt; unsigned* bar; unsigned want;
    __device__ __forceinline__ bool operator()(pg8::Acc& acc, const pg8::Unit& u, int wr, int wc, int fr, int fq) const {
        if (dry) return false;
        const bool qz = !FINAL && xq != nullptr;
#pragma unroll
        for (int ai = 0; ai < 2; ++ai)
#pragma unroll
            for (int m = 0; m < 4; ++m) {
                const int row = u.pm * 256 + ai * 128 + wr * 64 + m * 16 + fr;
                float ss = 0.f, am = 0.f;
#pragma unroll
                for (int bj = 0; bj < 2; ++bj) {
                    const size_t off = (size_t)row * DM + u.pn * 256 + bj * 128 + wc * 32 + 8 * fq;
                    const u32x4 xo = *(const u32x4*)(xb + off);
                    const f32x4 a0 = acc[ai][bj][m][0], a1 = acc[ai][bj][m][1];
                    float xn[8] = {bflo(xo.x) + a0[0], bfhi(xo.x) + a0[1], bflo(xo.y) + a0[2], bfhi(xo.y) + a0[3], bflo(xo.z) + a1[0], bfhi(xo.z) + a1[1], bflo(xo.w) + a1[2], bfhi(xo.w) + a1[3]};
                    if (FINAL) {
                        *(f32x4*)(xout + off) = (f32x4){xn[0], xn[1], xn[2], xn[3]}; *(f32x4*)(xout + off + 4) = (f32x4){xn[4], xn[5], xn[6], xn[7]};
                    } else {
                        u32x4 w; w.x = pk2(xn[0], xn[1]); w.y = pk2(xn[2], xn[3]); w.z = pk2(xn[4], xn[5]); w.w = pk2(xn[6], xn[7]);
                        *(u32x4*)(xb + off) = w;
                        const float r[8] = {bflo(w.x), bfhi(w.x), bflo(w.y), bfhi(w.y), bflo(w.z), bfhi(w.z), bflo(w.w), bfhi(w.w)};
#pragma unroll
                        for (int i = 0; i < 8; ++i) { ss += r[i] * r[i]; am = fmaxf(am, fabsf(r[i])); }
                        acc[ai][bj][m][0] = (f32x4){r[0], r[1], r[2], r[3]}; acc[ai][bj][m][1] = (f32x4){r[4], r[5], r[6], r[7]};
                    }
                }
                if (!FINAL) { ss += __shfl_xor(ss, 16); ss += __shfl_xor(ss, 32); am = fmaxf(am, __shfl_xor(am, 16)); am = fmaxf(am, __shfl_xor(am, 32));
                    if (fq == 0) { const int rl = ai * 128 + wr * 64 + m * 16 + fr; red[rl * 4 + wc] = ss; red[1024 + rl * 4 + wc] = am; } }
            }
        if (!FINAL) {
            asm volatile("s_waitcnt lgkmcnt(0)" ::: "memory"); __builtin_amdgcn_s_barrier(); asm volatile("" ::: "memory");
            if (tid < 256) { const f32x4 p = *(const LAS f32x4*)(red + tid * 4); const float st = (p[0] + p[1]) + (p[2] + p[3]);
                rowss[(size_t)(u.pm * 256 + tid) * 4 + u.pn] = st;
                if (qz) { const f32x4 a = *(const LAS f32x4*)(red + 1024 + tid * 4); const float at = fmaxf(fmaxf(a[0], a[1]), fmaxf(a[2], a[3]));
                    __hip_atomic_store(xslot + (size_t)(u.pm * 256 + tid) * 4 + u.pn, ((unsigned long long)__builtin_bit_cast(unsigned, at) << 32) | __builtin_bit_cast(unsigned, st), __ATOMIC_RELAXED, __HIP_MEMORY_SCOPE_AGENT); } }
            if (qz) {
                asm volatile("s_waitcnt vmcnt(0)" ::: "memory");
                if (tid < 256 && (tid & 63) == 0) (void)xb_add(xcnt + 16 * u.pm, 1u);
                if (tid == 0) XB_SPIN(xb_ld(xcnt + 16 * u.pm) < want, bar);
                asm volatile("s_waitcnt vmcnt(0) lgkmcnt(0)" ::: "memory"); __builtin_amdgcn_s_barrier(); asm volatile("" ::: "memory");
                if (tid < 256) {
                    const unsigned long long* sl = xslot + (size_t)(u.pm * 256 + tid) * 4; float st[4], at[4];
#pragma unroll
                    for (int t = 0; t < 4; ++t) { const unsigned long long w = __hip_atomic_load(sl + t, __ATOMIC_RELAXED, __HIP_MEMORY_SCOPE_AGENT); st[t] = __builtin_bit_cast(float, (unsigned)w); at[t] = __builtin_bit_cast(float, (unsigned)(w >> 32)); }
                    const float amax = fmaxf(fmaxf(at[0], at[1]), fmaxf(at[2], at[3]));
                    red[2048 + tid] = amax > 0.f ? 127.f / amax : 0.f;
                    if (u.pn == 0) *(f32x4*)(fct + (size_t)(u.pm * 256 + tid) * 4) = (f32x4){rsqrtf(((st[0] + st[1]) + (st[2] + st[3])) * (1.f / DM) + RMS_EPS) * amax * (1.f / 127.f), 0.f, 0.f, 0.f};
                }
                asm volatile("s_waitcnt lgkmcnt(0)" ::: "memory"); __builtin_amdgcn_s_barrier(); asm volatile("" ::: "memory");
#pragma unroll
                for (int ai = 0; ai < 2; ++ai)
#pragma unroll
                    for (int m = 0; m < 4; ++m) {
                        const int rl = ai * 128 + wr * 64 + m * 16 + fr; const float sc = red[2048 + rl];
#pragma unroll
                        for (int bj = 0; bj < 2; ++bj) {
                            const f32x4 v0 = acc[ai][bj][m][0] * sc, v1 = acc[ai][bj][m][1] * sc;
                            *(u32x2*)(xq + (size_t)(u.pm * 256 + rl) * DM + u.pn * 256 + bj * 128 + wc * 32 + 8 * fq) = (u32x2){pack_b0(q8(v0[0]), q8(v0[1]), q8(v0[2]), q8(v0[3])), pack_b0(q8(v1[0]), q8(v1[1]), q8(v1[2]), q8(v1[3]))};
                        }
                    }
            }
            asm volatile("s_waitcnt lgkmcnt(0)" ::: "memory"); __builtin_amdgcn_s_barrier(); asm volatile("" ::: "memory");
        }
        return false;
    }
};

struct EpiSwiGLU {
    static constexpr bool PERM = true, RS_LDS = true, CS_LDS = true;
    LAS const float* rsl; LAS const float* csl;
    const float* rowss; const float* cs; bf16_t* act; bool dry;
    __device__ __forceinline__ const float* cs_ptr(const pg8::Unit& u) const { return cs + u.pn * 256; }
    __device__ __forceinline__ bool operator()(pg8::Acc& acc, const pg8::Unit& u, int wr, int wc, int fr, int fq) const {
        if (dry) return false;
        float rs8[8];
#pragma unroll
        for (int k = 0; k < 8; ++k) rs8[k] = rsl[(k >> 2) * 256 + ((k & 3) * 16 + fr) * 4];
        f32x4 cq[2][2];
#pragma unroll
        for (int bj = 0; bj < 2; ++bj)
#pragma unroll
            for (int n = 0; n < 2; ++n) cq[bj][n] = *(const LAS f32x4*)(csl + bj * 128 + wc * 32 + 8 * fq + 4 * n);
#pragma unroll
        for (int ai = 0; ai < 2; ++ai) {
            if (u.half == 2 - ai) continue;
#pragma unroll
            for (int m = 0; m < 4; ++m) {
                const int row = u.pm * 256 + ai * 128 + wr * 64 + m * 16 + fr;
                const float rstd = rs8[ai * 4 + m];
                float o[8];
#pragma unroll
                for (int n = 0; n < 2; ++n) {
                    const pg8::i32x4v ia = __builtin_bit_cast(pg8::i32x4v, acc[ai][0][m][n]), ib = __builtin_bit_cast(pg8::i32x4v, acc[ai][1][m][n]);
#pragma unroll
                    for (int i = 0; i < 4; ++i) {
                        const float a = (float)ia[i] * (rstd * cq[0][n][i]), b = (float)ib[i] * (rstd * cq[1][n][i]);
                        o[4 * n + i] = a * __builtin_amdgcn_rcpf(1.f + __builtin_amdgcn_exp2f(-a * LOG2E)) * b;
                    }
                }
                u32x4 w; w.x = pk2(o[0], o[1]); w.y = pk2(o[2], o[3]); w.z = pk2(o[4], o[5]); w.w = pk2(o[6], o[7]);
                *(u32x4*)(act + (size_t)row * DFF + u.pn * 128 + wc * 32 + 8 * fq) = w;
            }
        }
        return false;
    }
};

struct XcdBarrier { unsigned* bar; unsigned x; volatile LAS unsigned* st; };
__device__ __forceinline__ XcdBarrier xcd_barrier_post(unsigned* bar, volatile LAS unsigned* st) {
    XcdBarrier b; b.bar = bar; b.x = xb_xcc_id(); b.st = st;
    if (threadIdx.x == 0) (void)xb_add(&bar[XB_XCNT(b.x)], 1u);
    return b;
}
__device__ __forceinline__ void xcd_barrier_complete(unsigned* bar, unsigned x, unsigned& nloc, unsigned& nx) {
    const unsigned G = gridDim.x * gridDim.y * gridDim.z;
    unsigned sum, cnt, mine, sp = 0u;
    for (;;) {
        sum = 0u; cnt = 0u; mine = 0u;
#pragma unroll
        for (unsigned j = 0; j < 16; ++j) { const unsigned c = xb_ld(&bar[XB_XCNT(j)]); sum += c; cnt += (c > 0u) ? 1u : 0u; mine = (j == x) ? c : mine; }
        if (sum == G) break;
        __builtin_amdgcn_s_sleep(1);
        if ((++sp & 255u) == 0u) { if (xb_ld(&bar[XB_TMO])) break; if (sp > XB_SPIN_CAP) { atomicAdd(&bar[XB_TMO], 1u); break; } }
    }
    nloc = mine > 0u ? mine : 1u; nx = cnt > 0u ? cnt : 1u;
}
__device__ __forceinline__ void xcd_barrier(const XcdBarrier& b) {
    asm volatile("s_waitcnt vmcnt(0)" ::: "memory");
    __syncthreads();
    if (threadIdx.x == 0) {
        unsigned* bar = b.bar;
        __builtin_amdgcn_s_waitcnt(0);
        __builtin_amdgcn_fence(__ATOMIC_ACQUIRE, "agent");
        unsigned nloc = b.st[0], nx = b.st[1];
        if (nloc == 0u) { xcd_barrier_complete(bar, b.x, nloc, nx); b.st[0] = nloc; b.st[1] = nx; }
        const unsigned old = xb_add(&bar[XB_XSUB(b.x)], 1u);
        const unsigned gen = old / nloc;
        if (old + 1u == (gen + 1u) * nloc) {
            __builtin_amdgcn_fence(__ATOMIC_RELEASE, "agent");
            asm volatile("s_waitcnt vmcnt(0)" ::: "memory");
            const unsigned og = xb_add(&bar[XB_TOP], 1u);
            const unsigned tg = og / nx;
            if (og + 1u == (tg + 1u) * nx) xb_add(&bar[XB_TOPGEN], 1u);
            else XB_SPIN(xb_ld(&bar[XB_TOPGEN]) == tg, bar);
            xb_add(&bar[XB_XGEN(b.x)], 1u);
            asm volatile("s_waitcnt vmcnt(0)" ::: "memory");
        } else {
            XB_SPIN(xb_ld(&bar[XB_XGEN(b.x)]) == gen, bar);
            asm volatile("s_waitcnt vmcnt(0)" ::: "memory");
        }
    }
    __syncthreads();
}

#define FUSE_XQ(F) ((F).G == (MTOK / 256) * (DM / 256))
struct Frame {
    LAS unsigned char* lds;
    int tid, lane, wave, G, bid;
    bool dry;
    const Params* P;
};

template <bool WANTMAX = false>
__device__ __forceinline__ float transpose_item(const float* W, int N, int k0, int n0, bf16_t* WT, int K, int drow_lo, int drow_hi, const float* gain, LAS float* scr, int lane) {
    float mx = 0.f;
#pragma unroll
    for (int h = 0; h < 2; ++h) {
        f32x4 v[8];
#pragma unroll
        for (int i = 0; i < 8; ++i) { const int kk = 4 * (8 * h + i) + (lane >> 4); v[i] = __builtin_nontemporal_load((const f32x4*)(W + (size_t)(k0 + kk) * N + n0 + 4 * (lane & 15))); }
#pragma unroll
        for (int i = 0; i < 8; ++i) { const int kk = 4 * (8 * h + i) + (lane >> 4); f32x4 w = v[i]; if (gain) w = w * gain[k0 + kk];
            if (WANTMAX) mx = fmaxf(mx, fmaxf(fmaxf(fabsf(w[0]), fabsf(w[1])), fmaxf(fabsf(w[2]), fabsf(w[3]))));
            LAS float* d = scr + kk * 65 + 4 * (lane & 15); d[0] = w[0]; d[1] = w[1]; d[2] = w[2]; d[3] = w[3]; }
    }
    asm volatile("s_waitcnt lgkmcnt(0)" ::: "memory");
    const int c = lane & 7;
#pragma unroll
    for (int j = 0; j < 8; ++j) { const int n = (lane >> 3) + 8 * j; const LAS float* s = scr + (8 * c) * 65 + n;
        u32x4 o; o.x = pk2(s[0 * 65], s[1 * 65]); o.y = pk2(s[2 * 65], s[3 * 65]); o.z = pk2(s[4 * 65], s[5 * 65]); o.w = pk2(s[6 * 65], s[7 * 65]);
        const int drow = (n < 32) ? drow_lo + n : drow_hi + n - 32;
        *(u32x4*)(WT + (size_t)drow * K + k0 + 8 * c) = o; }
    asm volatile("s_waitcnt lgkmcnt(0)" ::: "memory");
    return mx;
}
__device__ __forceinline__ float absmax_item(const float* W, int N, int k0, int n0, const float* gain, int lane) {
    float mx = 0.f;
#pragma unroll
    for (int h = 0; h < 2; ++h) {
        f32x4 v[8];
#pragma unroll
        for (int i = 0; i < 8; ++i) { const int kk = 4 * (8 * h + i) + (lane >> 4); v[i] = *(const f32x4*)(W + (size_t)(k0 + kk) * N + n0 + 4 * (lane & 15)); }
#pragma unroll
        for (int i = 0; i < 8; ++i) { const int kk = 4 * (8 * h + i) + (lane >> 4); const float g = fabsf(gain[k0 + kk]);
            mx = fmaxf(mx, g * fmaxf(fmaxf(fabsf(v[i][0]), fabsf(v[i][1])), fmaxf(fabsf(v[i][2]), fabsf(v[i][3])))); }
    }
#pragma unroll
    for (int o = 32; o > 0; o >>= 1) mx = fmaxf(mx, __shfl_xor(mx, o));
    return mx;
}
__device__ __forceinline__ void transpose_item_i8(const float* W, int N, int k0, int n0, unsigned char* WT8, int K, int drow0, const float* gain, float scale, LAS float* scr, int lane) {
#pragma unroll
    for (int h = 0; h < 2; ++h) {
        f32x4 v[8];
#pragma unroll
        for (int i = 0; i < 8; ++i) { const int kk = 4 * (8 * h + i) + (lane >> 4); v[i] = __builtin_nontemporal_load((const f32x4*)(W + (size_t)(k0 + kk) * N + n0 + 4 * (lane & 15))); }
#pragma unroll
        for (int i = 0; i < 8; ++i) { const int kk = 4 * (8 * h + i) + (lane >> 4); const f32x4 w = v[i] * (gain[k0 + kk] * scale);
            LAS float* d = scr + kk * 65 + 4 * (lane & 15); d[0] = w[0]; d[1] = w[1]; d[2] = w[2]; d[3] = w[3]; }
    }
    asm volatile("s_waitcnt lgkmcnt(0)" ::: "memory");
    const int c = lane & 7;
#pragma unroll
    for (int j = 0; j < 8; ++j) { const int n = (lane >> 3) + 8 * j; const LAS float* s = scr + (8 * c) * 65 + n;
        const unsigned lo = pack_b0(q8(s[0 * 65]), q8(s[1 * 65]), q8(s[2 * 65]), q8(s[3 * 65])), hi = pack_b0(q8(s[4 * 65]), q8(s[5 * 65]), q8(s[6 * 65]), q8(s[7 * 65]));
        *(u32x2*)(WT8 + (size_t)(drow0 + n) * K + k0 + 8 * c) = (u32x2){lo, hi}; }
    asm volatile("s_waitcnt lgkmcnt(0)" ::: "memory");
}
__device__ __forceinline__ void colgroup_i8(const Frame& F, const float* W, int N, int n0, unsigned char* WT8, int drow_lo, int drow_hi, const float* gain, float* cscale) {
    LAS float* scr = (LAS float*)(F.lds + F.wave * 16640);
    LAS float* cmx = (LAS float*)(F.lds + 8 * 16640);
    const int lane = F.lane, wave = F.wave;
    float cm[4] = {0.f, 0.f, 0.f, 0.f};
#pragma unroll 1
    for (int b = 0; b < 2; ++b) { const int k0 = 64 * (2 * wave + b);
#pragma unroll
        for (int h = 0; h < 2; ++h) {
            f32x4 v[8];
#pragma unroll
            for (int i = 0; i < 8; ++i) { const int kk = 4 * (8 * h + i) + (lane >> 4); v[i] = *(const f32x4*)(W + (size_t)(k0 + kk) * N + n0 + 4 * (lane & 15)); }
#pragma unroll
            for (int i = 0; i < 8; ++i) { const int kk = 4 * (8 * h + i) + (lane >> 4); const float g = fabsf(gain[k0 + kk]);
#pragma unroll
                for (int j = 0; j < 4; ++j) cm[j] = fmaxf(cm[j], g * fabsf(v[i][j])); }
        }
    }
#pragma unroll
    for (int j = 0; j < 4; ++j) { cm[j] = fmaxf(cm[j], __shfl_xor(cm[j], 16)); cm[j] = fmaxf(cm[j], __shfl_xor(cm[j], 32)); }
    if (lane < 16) *(LAS f32x4*)(cmx + wave * 64 + 4 * lane) = (f32x4){cm[0], cm[1], cm[2], cm[3]};
    asm volatile("s_waitcnt lgkmcnt(0)" ::: "memory"); __syncthreads();
    f32x4 mxv = *(const LAS f32x4*)(cmx + 4 * (lane & 15));
#pragma unroll
    for (int w = 1; w < 8; ++w) { const f32x4 t = *(const LAS f32x4*)(cmx + w * 64 + 4 * (lane & 15)); mxv = (f32x4){fmaxf(mxv[0], t[0]), fmaxf(mxv[1], t[1]), fmaxf(mxv[2], t[2]), fmaxf(mxv[3], t[3])}; }
    float sc[4];
#pragma unroll
    for (int j = 0; j < 4; ++j) sc[j] = mxv[j] > 0.f ? 127.f / mxv[j] : 0.f;
    if (wave == 0 && lane < 16) {
#pragma unroll
        for (int j = 0; j < 4; ++j) { const int n = 4 * lane + j; cscale[n < 32 ? drow_lo + n : drow_hi + n - 32] = mxv[j] * (1.f / 127.f); } }
#pragma unroll 1
    for (int b = 0; b < 2; ++b) { const int k0 = 64 * (2 * wave + b);
#pragma unroll
        for (int h = 0; h < 2; ++h) {
            f32x4 v[8];
#pragma unroll
            for (int i = 0; i < 8; ++i) { const int kk = 4 * (8 * h + i) + (lane >> 4); v[i] = __builtin_nontemporal_load((const f32x4*)(W + (size_t)(k0 + kk) * N + n0 + 4 * (lane & 15))); }
#pragma unroll
            for (int i = 0; i < 8; ++i) { const int kk = 4 * (8 * h + i) + (lane >> 4); const float g = gain[k0 + kk];
                LAS float* d = scr + kk * 65 + 4 * (lane & 15); d[0] = v[i][0] * (g * sc[0]); d[1] = v[i][1] * (g * sc[1]); d[2] = v[i][2] * (g * sc[2]); d[3] = v[i][3] * (g * sc[3]); }
        }
        asm volatile("s_waitcnt lgkmcnt(0)" ::: "memory");
        const int c = lane & 7;
#pragma unroll
        for (int j = 0; j < 8; ++j) { const int n = (lane >> 3) + 8 * j; const LAS float* s = scr + (8 * c) * 65 + n;
            const unsigned lo = pack_b0(q8(s[0 * 65]), q8(s[1 * 65]), q8(s[2 * 65]), q8(s[3 * 65])), hi = pack_b0(q8(s[4 * 65]), q8(s[5 * 65]), q8(s[6 * 65]), q8(s[7 * 65]));
            *(u32x2*)(WT8 + (size_t)(n < 32 ? drow_lo + n : drow_hi + n - 32) * DM + k0 + 8 * c) = (u32x2){lo, hi}; }
        asm volatile("s_waitcnt lgkmcnt(0)" ::: "memory");
    }
    __syncthreads();
}
__device__ __forceinline__ int inproj_base(int g) {
    if (g < 8) return 64 * g;
    if (g < 10) return 512 + 64 * (g - 8);
    if (g < 12) return 640 + 64 * (g - 10);
    if (g < 20) return 2304 + 64 * (g - 12);
    if (g < 28) return 2816 + 64 * (g - 20);
    if (g < 36) return 3328 + 64 * (g - 28);
    return 768 + 64 * (g - 36);
}
__device__ __forceinline__ void p0_weights(const Frame& F, int l, int part = -1, int w2_wv = -1, int w2_nw = 0) {
    const Params& P = *F.P;
    LAS float* scr = (LAS float*)(F.lds + F.wave * 16640);
    const int gw = F.bid * 8 + F.wave, NGW = F.G * 8;
    unsigned char* ws = P.ws + opaque_zero();
    const float* w_in = P.in[I_WIN] + (size_t)l * DM * INC;
    const float* n1g = P.in[I_N1G] + l * DM; const float* n2g = P.in[I_N2G] + l * DM;
    constexpr int NCG = 44 + 48 + 88;
    if (part != 1) for (int it0 = F.G - 1 - F.bid; it0 < NCG; it0 += F.G) {
        if (it0 < 44) { const int g = it0, d0 = 256 * (g >> 2) + 32 * (g & 3);
            colgroup_i8(F, w_in, INC, inproj_base(g), ws + W_IN, d0, d0 + 128, n1g, (float*)(ws + CS_IN)); continue; }
        const int it = it0 - 44;
        if (it < 48) colgroup_i8(F, w_in, INC, NMAIN + 64 * it, ws + W_IN + (size_t)NMAIN * DM * 2, 64 * it, 64 * it + 32, n1g, (float*)(ws + CS_G));
        else { const int r = it - 48, which = r / 44, c = 64 * (r % 44), d0 = 256 * (c >> 7) + 128 * which + (c & 127);
            colgroup_i8(F, P.in[which ? I_FFW3 : I_FFW1] + (size_t)l * DM * DFF, DFF, c, ws + W_13, d0, d0 + 32, n2g, (float*)(ws + CS_13)); }
    }
    constexpr int N1 = 16 * 16, N2 = 0, N3 = 3 * 128, N4 = 256, N5 = 0, N6 = 44 * 16;
    constexpr int NIT = N1 + N2 + N3 + N4 + N5 + N6;
    const int nfree = (part == 1) ? 0 : F.G - NCG, pstride = nfree > 0 ? nfree * 8 : NGW;
    if (nfree > 0 && F.bid >= nfree) return;
    const int it_lo = (part == 1) ? NIT - N6 : 0, it_hi = (part == 0) ? NIT - N6 : NIT;
    for (int it = it_lo + ((part == 1 && w2_wv >= 0) ? w2_wv : gw); it < it_hi; it += ((part == 1 && w2_wv >= 0) ? w2_nw : pstride)) {
        int r = it;
        if (r < N1) { const int g = 44 + r / 16, kb = r % 16; const int d0 = 256 * (g >> 2) + 32 * (g & 3) - 2816;
            transpose_item(w_in, INC, 64 * kb, inproj_base(g), (bf16_t*)(ws + W_IN + 3 * MiB), DM, d0, d0 + 128, n1g, scr, F.lane); continue; }
        r -= N1;
        r -= N2;
        if (r < N3) { const int w = r / 128, q = r % 128, cb = q / 8, kb = q % 8;
            const float* src = P.in[I_WOA + w] + (size_t)l * 512 * DM;
            transpose_item(src, DM, 64 * kb, 64 * cb, (bf16_t*)(ws + W_OA) + (size_t)w * DM * 512, 512, 64 * cb, 64 * cb + 32, nullptr, scr, F.lane); continue; }
        r -= N3;
        if (r < N4) { const int cb = r / 16, kb = r % 16;
            transpose_item(P.in[I_WOUT] + (size_t)l * DM * DM, DM, 64 * kb, 64 * cb, (bf16_t*)(ws + W_OUT), DM, 64 * cb, 64 * cb + 32, nullptr, scr, F.lane); continue; }
        r -= N4;
        r -= N5;
        { const int cb = r / 44, kb = r % 44;
            transpose_item(P.in[I_FFW2] + (size_t)l * DFF * DM, DM, 64 * kb, 64 * cb, (bf16_t*)(ws + W_2), DFF, 64 * cb, 64 * cb + 32, nullptr, scr, F.lane); }
    }
}
__device__ __forceinline__ void p0_misc(const Frame& F) {
    const Params& P = *F.P;
    unsigned char* ws = P.ws + opaque_zero();
    const int gw = F.bid * 8 + F.wave, NGW = F.G * 8, lane = F.lane;
    const int gt = F.bid * NTHREADS + F.tid, NGT = F.G * NTHREADS;
    float* rowssA = (float*)(ws + WS_ROWSSA);
    const float* x = P.in[I_X]; bf16_t* xb = (bf16_t*)(ws + WS_XB);
    for (int m = gw; m < MTOK; m += NGW) {
        const f32x4* xr = (const f32x4*)(x + (size_t)m * DM) + lane;
        float s = 0.f; f32x4 v[4];
#pragma unroll
        for (int j = 0; j < 4; ++j) { v[j] = __builtin_nontemporal_load(xr + 64 * j); s += v[j][0] * v[j][0] + v[j][1] * v[j][1] + v[j][2] * v[j][2] + v[j][3] * v[j][3]; }
        s = wave_sum(s);
        u32x2* o = (u32x2*)(xb + (size_t)m * DM) + lane;
        float mx = 0.f; u32x2 wv[4];
#pragma unroll
        for (int j = 0; j < 4; ++j) { u32x2 w; w.x = pk2(v[j][0], v[j][1]); w.y = pk2(v[j][2], v[j][3]); o[64 * j] = w; wv[j] = w;
            mx = fmaxf(mx, fmaxf(fmaxf(fabsf(bflo(w.x)), fabsf(bfhi(w.x))), fmaxf(fabsf(bflo(w.y)), fabsf(bfhi(w.y))))); }
        if (lane < 4) rowssA[(size_t)m * 4 + lane] = (lane == 0) ? s : 0.f;
#pragma unroll
        for (int o2 = 32; o2 > 0; o2 >>= 1) mx = fmaxf(mx, __shfl_xor(mx, o2));
        { const float sc = mx > 0.f ? 127.f / mx : 0.f; unsigned* q = (unsigned*)(ws + WS_XB8 + (size_t)m * DM) + lane;
#pragma unroll
          for (int j = 0; j < 4; ++j) q[64 * j] = pack_b0(q8(bflo(wv[j].x) * sc), q8(bfhi(wv[j].x) * sc), q8(bflo(wv[j].y) * sc), q8(bfhi(wv[j].y) * sc));
          if (lane == 0) *(f32x4*)((float*)(ws + CTL_FCTA) + (size_t)m * 4) = (f32x4){rsqrtf(s * (1.f / DM) + RMS_EPS) * mx * (1.f / 127.f), 0.f, 0.f, 0.f}; }
    }
    unsigned* csT = (unsigned*)(ws + CTL_COS);
    for (int i = gt; i < SEQ * 32; i += NGT) { const int pos = i >> 5, k = i & 31;
        const double inv = exp(-(double)k / 32.0 * log(10000.0)); const double ang = (double)pos * inv;
        const _Float16 ch = (_Float16)(float)cos(ang), sh = (_Float16)(float)sin(ang);
        csT[i] = (unsigned)__builtin_bit_cast(unsigned short, ch) | ((unsigned)__builtin_bit_cast(unsigned short, sh) << 16); }
    f32x2* tw = (f32x2*)(ws + CTL_TW);
    for (int i = gt; i < 2048; i += NGT) { float s, c; sincospif(-(float)i * (1.f / 2048.f), &s, &c); tw[i] = (f32x2){c, s}; }
    { unsigned* gp = (unsigned*)(ws + CTL_SIN);
      for (int i = gt; i < DEPTH * 4 * 32; i += NGT) { const int l = i >> 7, ty = (i >> 5) & 3, d = i & 31;
          const float* gsrc = P.in[ty == 0 ? I_QNA : (ty == 1 ? I_KNA : (ty == 2 ? I_QNC : I_KNC))] + l * 64;
          const _Float16 lo = (_Float16)gsrc[d], hi = (_Float16)gsrc[d + 32];
          gp[i] = (unsigned)__builtin_bit_cast(unsigned short, lo) | ((unsigned)__builtin_bit_cast(unsigned short, hi) << 16); } }
    if (gt < DEPTH) { const int l = gt; float a = 0.f, b = 0.f;
        for (int i = 0; i < 64; ++i) { a += P.in[I_LQ1][l * 64 + i] * P.in[I_LK1][l * 64 + i]; b += P.in[I_LQ2][l * 64 + i] * P.in[I_LK2][l * 64 + i]; }
        const float li = 0.8f - 0.6f * expf(-0.3f * (float)l);
        ((float*)(ws + CTL_LAM))[l] = expf(a) - expf(b) + li; }
    float* H2 = (float*)(ws + CTL_H2);
    for (int it = gw; it < DEPTH * SEQ; it += NGW) {
        const int l = it / SEQ, t = it % SEQ;
        const float* w1 = P.in[I_FW1] + l * 33 * 64; const float* w2 = P.in[I_FW2] + l * 64 * 64;
        const int band = (lane & 15) + 1; const int ph = (t * band) & 2047;
        float sv, cv; sincospif((float)ph * (1.f / 1024.f), &sv, &cv);
        float pre = P.in[I_FB1][l * 64 + lane] + ((float)t / (float)(SEQ - 1)) * w1[lane];
#pragma unroll
        for (int k = 0; k < 16; ++k) { pre += __shfl(cv, k) * w1[(1 + k) * 64 + lane]; pre += __shfl(sv, k) * w1[(17 + k) * 64 + lane]; }
        const float h1 = sinf(P.in[I_FF1][l * 64 + lane] * pre);
        float pre2 = P.in[I_FB2][l * 64 + lane];
        for (int j = 0; j < 64; ++j) pre2 += __shfl(h1, j) * w2[j * 64 + lane];
        ((bf16_t*)H2)[(size_t)it * 64 + lane] = f2bf(sinf(P.in[I_FF2][l * 64 + lane] * pre2));
    }
}

__device__ __forceinline__ f32x2 cmul(f32x2 a, f32x2 b) { return (f32x2){a.x * b.x - a.y * b.y, a.x * b.y + a.y * b.x}; }
__device__ __forceinline__ f32x2 cmulc(f32x2 a, f32x2 b) { return (f32x2){a.x * b.x + a.y * b.y, a.y * b.x - a.x * b.y}; }
__device__ __forceinline__ f32x2 mul_mi(f32x2 a) { return (f32x2){a.y, -a.x}; }
__device__ __forceinline__ f32x2 mul_pi(f32x2 a) { return (f32x2){-a.y, a.x}; }
constexpr float RS2 = 0.70710678118654752f;
__device__ __forceinline__ int pidx(int i) { return i + (i >> 3); }
struct Tw3 { f32x2 w1, w2, w3; };
struct TwF { f32x2 w1, s1, w2, s2, w3, s3; };
struct TwI { f32x2 c1, t1, c2, t2, c3, t3; };
__device__ __forceinline__ f32x2 cm2(f32x2 a, f32x2 w, f32x2 s) { const f32x2 t = (f32x2){a.x, a.x} * w; return __builtin_elementwise_fma((f32x2){a.y, a.y}, s, t); }
__device__ __forceinline__ TwF tw_fwd(const Tw3& t) { return TwF{t.w1, (f32x2){-t.w1.y, t.w1.x}, t.w2, (f32x2){-t.w2.y, t.w2.x}, t.w3, (f32x2){-t.w3.y, t.w3.x}}; }
__device__ __forceinline__ TwI tw_inv(const Tw3& t) { return TwI{(f32x2){t.w1.x, -t.w1.y}, (f32x2){t.w1.y, t.w1.x}, (f32x2){t.w2.x, -t.w2.y}, (f32x2){t.w2.y, t.w2.x}, (f32x2){t.w3.x, -t.w3.y}, (f32x2){t.w3.y, t.w3.x}}; }
template <bool UNIT> __device__ __forceinline__ void r8_fwd(f32x2 (&v)[8], const TwF& T) {
    {
        f32x2 d0 = v[0] - v[4], d1 = v[1] - v[5], d2 = v[2] - v[6], d3 = v[3] - v[7];
        v[0] = v[0] + v[4]; v[1] = v[1] + v[5]; v[2] = v[2] + v[6]; v[3] = v[3] + v[7];
        d1 = (f32x2){(d1.x + d1.y) * RS2, (d1.y - d1.x) * RS2};
        d2 = mul_mi(d2);
        d3 = (f32x2){(d3.y - d3.x) * RS2, -(d3.x + d3.y) * RS2};
        if (UNIT) { v[4] = d0; v[5] = d1; v[6] = d2; v[7] = d3; }
        else { v[4] = cm2(d0, T.w1, T.s1); v[5] = cm2(d1, T.w1, T.s1); v[6] = cm2(d2, T.w1, T.s1); v[7] = cm2(d3, T.w1, T.s1); }
    }
#pragma unroll
    for (int q = 0; q < 8; q += 4) {
        const f32x2 d0 = v[q] - v[q + 2], d1 = mul_mi(v[q + 1] - v[q + 3]);
        v[q] = v[q] + v[q + 2]; v[q + 1] = v[q + 1] + v[q + 3];
        if (UNIT) { v[q + 2] = d0; v[q + 3] = d1; } else { v[q + 2] = cm2(d0, T.w2, T.s2); v[q + 3] = cm2(d1, T.w2, T.s2); }
    }
#pragma unroll
    for (int q = 0; q < 8; q += 2) { const f32x2 d = v[q] - v[q + 1]; v[q] = v[q] + v[q + 1]; v[q + 1] = UNIT ? d : cm2(d, T.w3, T.s3); }
}
template <bool UNIT> __device__ __forceinline__ void r8_inv(f32x2 (&v)[8], const TwI& T) {
#pragma unroll
    for (int q = 0; q < 8; q += 2) { const f32x2 b = UNIT ? v[q + 1] : cm2(v[q + 1], T.c3, T.t3), a = v[q]; v[q] = a + b; v[q + 1] = a - b; }
#pragma unroll
    for (int q = 0; q < 8; q += 4) {
        const f32x2 b0 = UNIT ? v[q + 2] : cm2(v[q + 2], T.c2, T.t2), b1 = mul_pi(UNIT ? v[q + 3] : cm2(v[q + 3], T.c2, T.t2)), a0 = v[q], a1 = v[q + 1];
        v[q] = a0 + b0; v[q + 2] = a0 - b0; v[q + 1] = a1 + b1; v[q + 3] = a1 - b1;
    }
    {
        const f32x2 b0 = UNIT ? v[4] : cm2(v[4], T.c1, T.t1); f32x2 b1 = UNIT ? v[5] : cm2(v[5], T.c1, T.t1); const f32x2 b2 = mul_pi(UNIT ? v[6] : cm2(v[6], T.c1, T.t1)); f32x2 b3 = UNIT ? v[7] : cm2(v[7], T.c1, T.t1);
        b1 = (f32x2){(b1.x - b1.y) * RS2, (b1.x + b1.y) * RS2};
        b3 = (f32x2){-(b3.x + b3.y) * RS2, (b3.x - b3.y) * RS2};
        const f32x2 a0 = v[0], a1 = v[1], a2 = v[2], a3 = v[3];
        v[0] = a0 + b0; v[4] = a0 - b0; v[1] = a1 + b1; v[5] = a1 - b1; v[2] = a2 + b2; v[6] = a2 - b2; v[3] = a3 + b3; v[7] = a3 - b3;
    }
}
__device__ __forceinline__ void wave_lds_sync() { asm volatile("s_waitcnt lgkmcnt(0)" ::: "memory"); }
struct FftTw { Tw3 w512, w64, w8; };
__device__ __forceinline__ Tw3 tw3_make(int e) {
    Tw3 t; float s, c;
    sincospif(-(float)e * (1.f / 2048.f), &s, &c); t.w1 = (f32x2){c, s};
    sincospif(-(float)(2 * e) * (1.f / 2048.f), &s, &c); t.w2 = (f32x2){c, s};
    sincospif(-(float)(4 * e) * (1.f / 2048.f), &s, &c); t.w3 = (f32x2){c, s};
    return t;
}
__device__ __forceinline__ FftTw fft_twiddles(int tid) { FftTw t; t.w512 = tw3_make(tid); t.w64 = tw3_make(8 * (tid & 63)); t.w8 = tw3_make(64 * (tid & 7)); return t; }
template <int SP> __device__ __forceinline__ int fft_base(int tid) { return (tid / SP) * 8 * SP + (tid & (SP - 1)); }
template <int SP> __device__ __forceinline__ void fft_ld(const LAS f32x2* X, int tid, f32x2 (&v)[8]) {
    const int base = fft_base<SP>(tid);
#pragma unroll
    for (int j = 0; j < 8; ++j) v[j] = X[pidx(base + j * SP)];
}
template <int SP> __device__ __forceinline__ void fft_st(LAS f32x2* X, int tid, const f32x2 (&v)[8]) {
    const int base = fft_base<SP>(tid);
#pragma unroll
    for (int j = 0; j < 8; ++j) X[pidx(base + j * SP)] = v[j];
}
template <int SP> __device__ __forceinline__ void fft_pass_fwd(LAS f32x2* X, int tid, const Tw3& w) { const TwF T = tw_fwd(w); f32x2 v[8]; fft_ld<SP>(X, tid, v); r8_fwd<false>(v, T); fft_st<SP>(X, tid, v); }
template <int SP> __device__ __forceinline__ void fft_pass_inv(LAS f32x2* X, int tid, const Tw3& w) { const TwI T = tw_inv(w); f32x2 v[8]; fft_ld<SP>(X, tid, v); r8_inv<false>(v, T); fft_st<SP>(X, tid, v); }

constexpr int HY_STG = 0, HY_STG_BYTES = 2 * 2050 * 16, HY_X = 65664, HY_X_BYTES = 4608 * 8, HY_RED = HY_X + HY_X_BYTES;
static_assert(HY_STG_BYTES <= HY_X && HY_X + 2 * HY_X_BYTES <= LDS_BARST, "hyena lds");

constexpr int HM_RS = 192, HM_PLANE = 32 * HM_RS, HM_STG = 0, HM_STG_BYTES = 16 * HM_PLANE;
constexpr int HM_FT = HM_STG_BYTES, HM_FRS = 136, HM_FTBL = 64 * HM_FRS;
constexpr int HM_WT = HM_FT + 3 * HM_FTBL, HM_END = HM_WT + 4096 * 4;
static_assert(HM_END + 128 <= LDS_BARST, "hyena mfma lds");
__device__ __forceinline__ bf16x8 hm_ld_tr(const LAS unsigned char* p) {
    const s16x4 lo4 = __builtin_amdgcn_ds_read_tr16_b64_v4i16((LAS s16x4*)p);
    const s16x4 hi4 = __builtin_amdgcn_ds_read_tr16_b64_v4i16((LAS s16x4*)(p + 4 * HM_RS));
    return (bf16x8){lo4[0], lo4[1], lo4[2], lo4[3], hi4[0], hi4[1], hi4[2], hi4[3]};
}
__device__ __forceinline__ bf16x8 hm_ld2(const LAS unsigned char* p, int off2) {
    const u32x2 a = *(const LAS u32x2*)p, b = *(const LAS u32x2*)(p + off2);
    return __builtin_bit_cast(bf16x8, (u32x4){a.x, a.y, b.x, b.y});
}
__device__ __forceinline__ bf16x8 hm_pack(const f32x16& t, int s) {
    u32x4 w; w.x = pk2(t[8 * s + 0], t[8 * s + 1]); w.y = pk2(t[8 * s + 2], t[8 * s + 3]); w.z = pk2(t[8 * s + 4], t[8 * s + 5]); w.w = pk2(t[8 * s + 6], t[8 * s + 7]);
    return __builtin_bit_cast(bf16x8, w);
}
#define HM_MFMA(a, b, c) __builtin_amdgcn_mfma_f32_32x32x16_bf16(a, b, c, 0, 0, 0)
struct HmF3 { bf16x8 r, i, n; };
__device__ __forceinline__ HmF3 hm_ldf(const LAS unsigned char* fp, int off2) { HmF3 f; f.r = hm_ld2(fp, off2); f.i = hm_ld2(fp + HM_FTBL, off2); f.n = hm_ld2(fp + 2 * HM_FTBL, off2); return f; }
__device__ __forceinline__ void hm_conv_wave(LAS unsigned char* lds, int lane, int ch, const unsigned* H) {
    const int r32 = lane & 31, h = lane >> 5;
    LAS unsigned char* PR = lds + HM_STG + (ch * 2) * HM_PLANE; LAS unsigned char* PI = PR + HM_PLANE;
    const LAS unsigned char* FT = lds + HM_FT; const LAS unsigned* WT = (const LAS unsigned*)(lds + HM_WT);
    f32x16 xr[2], xi[2];
#pragma unroll
    for (int nt = 0; nt < 2; ++nt)
#pragma unroll
        for (int r = 0; r < 16; ++r) { xr[nt][r] = 0.f; xi[nt][r] = 0.f; }
    const int trow0 = 8 * h + ((lane & 15) >> 2), tcol0 = 16 * ((lane >> 4) & 1) + 4 * (lane & 3);
#pragma unroll 1
    for (int c1 = 0; c1 < 2; ++c1) {
        const int k1 = 32 * c1 + r32;
        bf16x8 yrB[4], yiB[4];
        {
            const LAS unsigned char* fb = FT + k1 * HM_FRS + 8 * h * 2;
            bf16x8 aR = hm_ld_tr(PR + trow0 * HM_RS + tcol0 * 2), aI = hm_ld_tr(PI + trow0 * HM_RS + tcol0 * 2);
            HmF3 f = hm_ldf(fb, 8);
#pragma unroll
            for (int rt = 0; rt < 2; ++rt) {
                f32x16 yr, yi;
#pragma unroll
                for (int r = 0; r < 16; ++r) { yr[r] = 0.f; yi[r] = 0.f; }
#pragma unroll
                for (int ks = 0; ks < 2; ++ks) {
                    const int g = 2 * rt + ks;
                    bf16x8 aRn = aR, aIn = aI; HmF3 fn = f;
                    if (g + 1 < 4) { const int rt2 = (g + 1) >> 1, ks2 = (g + 1) & 1;
                        aRn = hm_ld_tr(PR + (16 * ks2 + trow0) * HM_RS + (32 * rt2 + tcol0) * 2); aIn = hm_ld_tr(PI + (16 * ks2 + trow0) * HM_RS + (32 * rt2 + tcol0) * 2);
                        fn = hm_ldf(fb + 16 * ks2 * 2, 8); }
                    yr = HM_MFMA(aR, f.r, yr); yr = HM_MFMA(aI, f.n, yr);
                    yi = HM_MFMA(aR, f.i, yi); yi = HM_MFMA(aI, f.r, yi);
                    asm volatile("" ::: "memory");
                    aR = aRn; aI = aIn; f = fn;
                }
#pragma unroll
                for (int r = 0; r < 16; ++r) {
                    const int n2 = 32 * rt + (r & 3) + 8 * (r >> 2) + 4 * h;
                    const unsigned w = WT[k1 * n2];
                    const float wr = (float)__builtin_bit_cast(_Float16, (unsigned short)(w & 0xffffu)), wi = (float)__builtin_bit_cast(_Float16, (unsigned short)(w >> 16));
                    const float a = yr[r], b = yi[r];
                    yr[r] = a * wr - b * wi; yi[r] = a * wi + b * wr;
                }
#pragma unroll
                for (int s = 0; s < 2; ++s) { yrB[2 * rt + s] = hm_pack(yr, s); yiB[2 * rt + s] = hm_pack(yi, s); }
            }
        }
        bf16x8 zrA[4], ziA[4];
        unsigned hv0[16], hv1[16];
#pragma unroll
        for (int kt = 0; kt < 2; ++kt) {
            f32x16 zr, zi;
#pragma unroll
            for (int r = 0; r < 16; ++r) { zr[r] = 0.f; zi[r] = 0.f; }
            if (kt == 0) {
#pragma unroll
                for (int r = 0; r < 16; ++r) hv0[r] = H[((r & 3) + 8 * (r >> 2) + 4 * h) * 64 + k1]; }
            const LAS unsigned char* fb = FT + (32 * kt + r32) * HM_FRS + 4 * h * 2;
            HmF3 f = hm_ldf(fb, 16);
#pragma unroll
            for (int q = 0; q < 4; ++q) {
                HmF3 fn = f; if (q + 1 < 4) fn = hm_ldf(fb + 16 * (q + 1) * 2, 16);
                zr = HM_MFMA(f.r, yrB[q], zr); zr = HM_MFMA(f.n, yiB[q], zr);
                zi = HM_MFMA(f.i, yrB[q], zi); zi = HM_MFMA(f.r, yiB[q], zi);
                asm volatile("" ::: "memory");
                f = fn;
            }
            if (kt == 0) {
#pragma unroll
                for (int r = 0; r < 16; ++r) hv1[r] = H[(32 + (r & 3) + 8 * (r >> 2) + 4 * h) * 64 + k1]; }
#pragma unroll
            for (int r = 0; r < 16; ++r) {
                const unsigned hw = kt ? hv1[r] : hv0[r];
                const float a = zr[r], b = zi[r], hx = bflo(hw), hy = bfhi(hw);
                zr[r] = a * hx - b * hy; zi[r] = a * hy + b * hx;
            }
#pragma unroll
            for (int s = 0; s < 2; ++s) { zrA[2 * kt + s] = hm_pack(zr, s); ziA[2 * kt + s] = hm_pack(zi, s); }
        }
#pragma unroll
        for (int nt = 0; nt < 2; ++nt) {
            const int n2 = 32 * nt + r32;
            f32x16 vr, vi;
#pragma unroll
            for (int r = 0; r < 16; ++r) { vr[r] = 0.f; vi[r] = 0.f; }
            const LAS unsigned char* fb = FT + n2 * HM_FRS + 4 * h * 2;
            HmF3 f = hm_ldf(fb, 16);
#pragma unroll
            for (int q = 0; q < 4; ++q) {
                HmF3 fn = f; if (q + 1 < 4) fn = hm_ldf(fb + 16 * (q + 1) * 2, 16);
                vr = HM_MFMA(zrA[q], f.r, vr); vr = HM_MFMA(ziA[q], f.i, vr);
                vi = HM_MFMA(ziA[q], f.r, vi); vi = HM_MFMA(zrA[q], f.n, vi);
                asm volatile("" ::: "memory");
                f = fn;
            }
            const LAS unsigned char* f4 = FT + r32 * HM_FRS + (32 * c1 + 4 * h) * 2;
            HmF3 g0 = hm_ldf(f4, 16), g1 = hm_ldf(f4 + 16 * 2, 16);
#pragma unroll
            for (int r = 0; r < 16; ++r) {
                const int kk = 32 * c1 + (r & 3) + 8 * (r >> 2) + 4 * h;
                const unsigned w = WT[kk * n2];
                const float wr = (float)__builtin_bit_cast(_Float16, (unsigned short)(w & 0xffffu)), wi = (float)__builtin_bit_cast(_Float16, (unsigned short)(w >> 16));
                const float a = vr[r], b = vi[r];
                vr[r] = a * wr + b * wi; vi[r] = b * wr - a * wi;
            }
            {
                const bf16x8 vrB = hm_pack(vr, 0), viB = hm_pack(vi, 0);
                xr[nt] = HM_MFMA(g0.r, vrB, xr[nt]); xr[nt] = HM_MFMA(g0.i, viB, xr[nt]);
                xi[nt] = HM_MFMA(g0.r, viB, xi[nt]); xi[nt] = HM_MFMA(g0.n, vrB, xi[nt]);
            }
            {
                const bf16x8 vrB = hm_pack(vr, 1), viB = hm_pack(vi, 1);
                xr[nt] = HM_MFMA(g1.r, vrB, xr[nt]); xr[nt] = HM_MFMA(g1.i, viB, xr[nt]);
                xi[nt] = HM_MFMA(g1.r, viB, xi[nt]); xi[nt] = HM_MFMA(g1.n, vrB, xi[nt]);
            }
            asm volatile("" ::: "memory");
        }
    }
    asm volatile("s_waitcnt lgkmcnt(0)" ::: "memory");
#pragma unroll
    for (int nt = 0; nt < 2; ++nt)
#pragma unroll
        for (int r = 0; r < 16; ++r) {
            const int n1 = (r & 3) + 8 * (r >> 2) + 4 * h, off = n1 * HM_RS + (32 * nt + r32) * 2;
            *(LAS unsigned short*)(PR + off) = f2bf(xr[nt][r]); *(LAS unsigned short*)(PI + off) = f2bf(xi[nt][r]);
        }
}
__device__ __forceinline__ void hm_init_tables(LAS unsigned char* lds, int tid) {
    for (int i = tid; i < 4096; i += NTHREADS) {
        const int a = i >> 6, b = i & 63; float s, c; sincospif(-(float)((a * b) & 63) * (1.f / 32.f), &s, &c);
        LAS unsigned short* fp = (LAS unsigned short*)(lds + HM_FT + a * HM_FRS + b * 2);
        fp[0] = f2bf(c); fp[HM_FTBL / 2] = f2bf(s); fp[HM_FTBL] = f2bf(-s);
        float s2, c2; sincospif(-(float)i * (1.f / 2048.f), &s2, &c2);
        const _Float16 ch_ = (_Float16)c2, sh_ = (_Float16)s2;
        ((LAS unsigned*)(lds + HM_WT))[i] = (unsigned)__builtin_bit_cast(unsigned short, ch_) | ((unsigned)__builtin_bit_cast(unsigned short, sh_) << 16);
    }
}
__device__ __forceinline__ void hm_spec_wave(const LAS unsigned char* lds, int lane, int cc, int c1, float scale, float dd, unsigned* dst) {
    const int r32 = lane & 31, h = lane >> 5, k1 = 32 * c1 + r32;
    const LAS unsigned char* PR = lds + HM_STG + cc * (64 * HM_RS);
    const LAS unsigned char* FT = lds + HM_FT; const LAS unsigned* WT = (const LAS unsigned*)(lds + HM_WT);
    const int trow0 = 8 * h + ((lane & 15) >> 2), tcol0 = 16 * ((lane >> 4) & 1) + 4 * (lane & 3);
    bf16x8 yrB[4], yiB[4];
#pragma unroll
    for (int rt = 0; rt < 2; ++rt) {
        f32x16 yr, yi;
#pragma unroll
        for (int r = 0; r < 16; ++r) { yr[r] = 0.f; yi[r] = 0.f; }
#pragma unroll
        for (int ks = 0; ks < 4; ++ks) {
            const bf16x8 aR = hm_ld_tr(PR + (16 * ks + trow0) * HM_RS + (32 * rt + tcol0) * 2);
            const LAS unsigned char* fp = FT + k1 * HM_FRS + (16 * ks + 8 * h) * 2;
            const bf16x8 bFr = hm_ld2(fp, 8), bFi = hm_ld2(fp + HM_FTBL, 8);
            yr = HM_MFMA(aR, bFr, yr); yi = HM_MFMA(aR, bFi, yi);
            asm volatile("" ::: "memory");
        }
#pragma unroll
        for (int r = 0; r < 16; ++r) {
            const int n2 = 32 * rt + (r & 3) + 8 * (r >> 2) + 4 * h;
            const unsigned w = WT[k1 * n2];
            const float wr = (float)__builtin_bit_cast(_Float16, (unsigned short)(w & 0xffffu)), wi = (float)__builtin_bit_cast(_Float16, (unsigned short)(w >> 16));
            const float a = yr[r], b = yi[r];
            yr[r] = a * wr - b * wi; yi[r] = a * wi + b * wr;
        }
#pragma unroll
        for (int s = 0; s < 2; ++s) { yrB[2 * rt + s] = hm_pack(yr, s); yiB[2 * rt + s] = hm_pack(yi, s); }
    }
#pragma unroll
    for (int kt = 0; kt < 2; ++kt) {
        f32x16 zr, zi;
#pragma unroll
        for (int r = 0; r < 16; ++r) { zr[r] = 0.f; zi[r] = 0.f; }
#pragma unroll
        for (int q = 0; q < 4; ++q) {
            const HmF3 f = hm_ldf(FT + (32 * kt + r32) * HM_FRS + (16 * q + 4 * h) * 2, 16);
            zr = HM_MFMA(f.r, yrB[q], zr); zr = HM_MFMA(f.n, yiB[q], zr);
            zi = HM_MFMA(f.i, yrB[q], zi); zi = HM_MFMA(f.r, yiB[q], zi);
            asm volatile("" ::: "memory");
        }
#pragma unroll
        for (int r = 0; r < 16; ++r) {
            const int k2 = 32 * kt + (r & 3) + 8 * (r >> 2) + 4 * h;
            dst[k2 * 64 + k1] = pk2(zr[r] * scale + dd, zi[r] * scale);
        }
    }
}
constexpr int HM_W3L = HM_END + 128;
static_assert(HM_W3L + 32 * HM_FRS <= LDS_BARST, "spectra lds");
__device__ __forceinline__ void spectra_phase(const Frame& F, int l) {
    const Params& P = *F.P; unsigned char* ws = P.ws + opaque_zero(); const int tid = F.tid, lane = F.lane, r32 = lane & 31, h = lane >> 5;
    LAS unsigned char* lds = F.lds; LAS float* red = (LAS float*)(lds + HM_END);
    hm_init_tables(lds, tid);
    const bf16_t* H2B = (const bf16_t*)(ws + CTL_H2) + (size_t)l * SEQ * 64;
    const float* w3 = P.in[I_FW3] + (size_t)l * 64 * 2048;
    unsigned* spec = (unsigned*)(ws + WS_S);
    const float min_decay = logf(0.01f) / 1.5f, max_decay = logf(0.01f) / 0.3f;
    for (int it = F.bid; it < 256; it += F.G) {
        const int o = it >> 7, c0 = (it & 127) * 4;
        { const int row = tid >> 6, j = tid & 63;
          *(LAS unsigned short*)(lds + HM_W3L + row * HM_FRS + j * 2) = f2bf(w3[(size_t)j * 2048 + (o * 2 + (row >> 2)) * 512 + c0 + (row & 3)]);
#pragma unroll
          for (int k = 0; k < 3; ++k) { const int e = tid + 512 * k; *(LAS unsigned short*)(lds + HM_W3L + (8 + (e >> 6)) * HM_FRS + (e & 63) * 2) = 0; } }
        __syncthreads();
        bf16x8 wA[4];
#pragma unroll
        for (int ks = 0; ks < 4; ++ks) wA[ks] = hm_ld2(lds + HM_W3L + r32 * HM_FRS + (16 * ks + 8 * h) * 2, 8);
        float dl[4];
#pragma unroll
        for (int cc = 0; cc < 4; ++cc) dl[cc] = fabsf(min_decay + (max_decay - min_decay) * ((float)(c0 + cc) / 511.f));
        float ss[4] = {0.f, 0.f, 0.f, 0.f};
#pragma unroll 2
        for (int tt = F.wave; tt < 64; tt += 8) {
            const int t = 32 * tt + r32;
            const bf16_t* hp = H2B + (size_t)t * 64 + 8 * h;
            f32x16 d;
#pragma unroll
            for (int r = 0; r < 16; ++r) d[r] = 0.f;
            bf16x8 hb[4];
#pragma unroll
            for (int ks = 0; ks < 4; ++ks) hb[ks] = *(const bf16x8*)(hp + 16 * ks);
#pragma unroll
            for (int ks = 0; ks < 4; ++ks) d = HM_MFMA(wA[ks], hb[ks], d);
            const float tn = (float)t / (float)(SEQ - 1);
#pragma unroll
            for (int cc = 0; cc < 4; ++cc) {
                float v = d[cc] * expf(-tn * dl[cc]);
                const float other = __shfl_xor(v, 32);
                LAS unsigned char* PR = lds + HM_STG + cc * (64 * HM_RS);
                int n;
                if (t == 0) { if (h == 0) { v += other; n = 0; } else { v = 0.f; n = 2048; } }
                else n = h ? 4096 - t : t;
                *(LAS unsigned short*)(PR + (n >> 6) * HM_RS + (n & 63) * 2) = f2bf(v);
                ss[cc] += v * v;
            }
        }
#pragma unroll
        for (int cc = 0; cc < 4; ++cc) ss[cc] = wave_sum(ss[cc]);
        if (lane == 0) *(LAS f32x4*)(red + F.wave * 4) = (f32x4){ss[0], ss[1], ss[2], ss[3]};
        __syncthreads();
        {
            const int cc = F.wave & 3, c = c0 + cc;
            float tot = 0.f;
#pragma unroll
            for (int w = 0; w < 8; ++w) tot += red[w * 4 + cc];
            const float scale = rsqrtf(tot + RMS_EPS) * (1.f / 4096.f);
            const float dd = P.in[I_HYD][(l * 2 + o) * 512 + c] * (1.f / 4096.f);
            hm_spec_wave(lds, lane, cc, F.wave >> 2, scale, dd, spec + (size_t)(o * 512 + c) * 4096);
        }
        __syncthreads();
    }
}

__device__ __forceinline__ int hm_addr(int ch, int pl, int t) { return ((ch * 2 + pl) * 32 + (t >> 6)) * HM_RS + (t & 63) * 2; }
template <int MODE> __device__ __forceinline__ void hm_elem_pass(const Frame& F, LAS unsigned char* lds, const bf16_t* HY, int b0, int coff, const float* cw, const float* cb, bf16_t* outp, int c0) {
    const int tid = F.tid, b = tid >> 8, t0 = (tid & 255) * 8;
    const bf16_t* rp = HY + ((size_t)(coff >> 3) * MTOK + (size_t)(b0 + b) * SEQ + t0) * 8;
    u32x4 x[10];
    const u32x4 z4 = {0u, 0u, 0u, 0u};
    x[0] = (t0 > 0) ? *(const u32x4*)(rp - 8) : z4;
#pragma unroll
    for (int i = 0; i < 8; ++i) x[1 + i] = *(const u32x4*)(rp + 8 * i);
    x[9] = (t0 + 8 < SEQ) ? *(const u32x4*)(rp + 64) : z4;
    u32x4 res[8];
#pragma unroll
    for (int kp = 0; kp < 4; ++kp) {
        const float wl0 = cw[coff + 2 * kp], wl1 = cw[1536 + coff + 2 * kp], wl2 = cw[2 * 1536 + coff + 2 * kp], bl = cb[coff + 2 * kp];
        const float wh0 = cw[coff + 2 * kp + 1], wh1 = cw[1536 + coff + 2 * kp + 1], wh2 = cw[2 * 1536 + coff + 2 * kp + 1], bh = cb[coff + 2 * kp + 1];
        float lo[8], hi[8];
#pragma unroll
        for (int i = 0; i < 8; ++i) {
            lo[i] = bflo(x[i][kp]) * wl0 + bflo(x[i + 1][kp]) * wl1 + bflo(x[i + 2][kp]) * wl2 + bl;
            hi[i] = bfhi(x[i][kp]) * wh0 + bfhi(x[i + 1][kp]) * wh1 + bfhi(x[i + 2][kp]) * wh2 + bh;
        }
        if (MODE != 0) {
            const u32x4 pl = *(const LAS u32x4*)(lds + HM_STG + hm_addr(2 * kp, b, t0)), ph = *(const LAS u32x4*)(lds + HM_STG + hm_addr(2 * kp + 1, b, t0));
#pragma unroll
            for (int i = 0; i < 4; ++i) { lo[2 * i] *= bflo(pl[i]); lo[2 * i + 1] *= bfhi(pl[i]); hi[2 * i] *= bflo(ph[i]); hi[2 * i + 1] *= bfhi(ph[i]); }
        }
        res[2 * kp] = (u32x4){pk2(lo[0], lo[1]), pk2(lo[2], lo[3]), pk2(lo[4], lo[5]), pk2(lo[6], lo[7])};
        res[2 * kp + 1] = (u32x4){pk2(hi[0], hi[1]), pk2(hi[2], hi[3]), pk2(hi[4], hi[5]), pk2(hi[6], hi[7])};
    }
    if (MODE == 2) {
#pragma unroll
        for (int i = 0; i < 8; ++i) {
            u32x4 w;
#pragma unroll
            for (int kp = 0; kp < 4; ++kp) {
                const unsigned a = res[2 * kp][i >> 1], c = res[2 * kp + 1][i >> 1];
                w[kp] = (i & 1) ? ((a >> 16) | (c & 0xffff0000u)) : ((a & 0xffffu) | (c << 16));
            }
            *(u32x4*)(outp + ((size_t)(b0 + b) * SEQ + t0 + i) * 512 + c0) = w;
        }
    } else {
#pragma unroll
        for (int k = 0; k < 8; ++k) *(LAS u32x4*)(lds + HM_STG + hm_addr(k, b, t0)) = res[k];
    }
    __syncthreads();
}
__device__ __forceinline__ void gate_rows_i8(const Frame& F, int wv, int nw, size_t rowss_off) {
    const Params& P = *F.P; unsigned char* ws = P.ws + opaque_zero(); const int lane = F.lane;
    const float* rowss = (const float*)(ws + rowss_off); float* fct = (float*)(ws + CTL_FCTA);
    for (int m0 = wv; m0 < MTOK; m0 += 4 * nw) {
        u32x4 v[4][2];
#pragma unroll
        for (int r = 0; r < 4; ++r) { const int m = m0 + r * nw; if (m < MTOK) { const u32x4* xr = (const u32x4*)(ws + WS_XB + (size_t)m * DM * 2) + lane; v[r][0] = xr[0]; v[r][1] = xr[64]; } }
#pragma unroll
        for (int r = 0; r < 4; ++r) { const int m = m0 + r * nw; if (m < MTOK) {
            float f[16];
#pragma unroll
            for (int h = 0; h < 2; ++h) { const u32x4 w = v[r][h]; f[8 * h + 0] = bflo(w.x); f[8 * h + 1] = bfhi(w.x); f[8 * h + 2] = bflo(w.y); f[8 * h + 3] = bfhi(w.y);
                f[8 * h + 4] = bflo(w.z); f[8 * h + 5] = bfhi(w.z); f[8 * h + 6] = bflo(w.w); f[8 * h + 7] = bfhi(w.w); }
            float mx = 0.f;
#pragma unroll
            for (int e = 0; e < 16; ++e) mx = fmaxf(mx, fabsf(f[e]));
#pragma unroll
            for (int o = 32; o > 0; o >>= 1) mx = fmaxf(mx, __shfl_xor(mx, o));
            const float sc = mx > 0.f ? 127.f / mx : 0.f;
            u32x2* o8 = (u32x2*)(ws + WS_XB8 + (size_t)m * DM) + lane;
#pragma unroll
            for (int h = 0; h < 2; ++h)
                o8[64 * h] = (u32x2){pack_b0(q8(f[8 * h] * sc), q8(f[8 * h + 1] * sc), q8(f[8 * h + 2] * sc), q8(f[8 * h + 3] * sc)), pack_b0(q8(f[8 * h + 4] * sc), q8(f[8 * h + 5] * sc), q8(f[8 * h + 6] * sc), q8(f[8 * h + 7] * sc))};
            if (lane == 0) { const f32x4 q = *(const f32x4*)(rowss + (size_t)m * 4);
                *(f32x4*)(fct + (size_t)m * 4) = (f32x4){rsqrtf(((q[0] + q[1]) + (q[2] + q[3])) * (1.f / DM) + RMS_EPS) * mx * (1.f / 127.f), 0.f, 0.f, 0.f}; }
        } }
    }
}
__device__ __forceinline__ void p5_prep(const Frame& F, int l) {
    gate_rows_i8(F, F.bid * 8 + F.wave, F.G * 8, WS_ROWSSB);
}
__device__ __forceinline__ void hyena_phase(const Frame& F, int l) {
    const Params& P = *F.P; unsigned char* ws = P.ws + opaque_zero(); const int tid = F.tid;
    LAS unsigned char* lds = F.lds;
    hm_init_tables(lds, tid);
    const bf16_t* HY = (const bf16_t*)(ws + G_HY); bf16_t* OB = (bf16_t*)(ws + WS_OB);
    const unsigned* spec = (const unsigned*)(ws + WS_S);
    const float* cw = P.in[I_CONVW] + (size_t)l * 3 * 1536; const float* cb = P.in[I_CONVB] + (size_t)l * 1536;
    for (int it = F.bid; it < 256; it += F.G) {
        const int combo = (it & 7) * 4 + (it >> 6), bp = combo >> 3, cg = (combo & 7) * 8 + ((it >> 3) & 7), b0 = 2 * bp, c0 = 8 * cg;
        hm_elem_pass<0>(F, lds, HY, b0, c0, cw, cb, nullptr, c0);
        hm_conv_wave(lds, F.lane, F.wave, spec + (size_t)(c0 + F.wave) * 4096);
        __syncthreads();
        hm_elem_pass<1>(F, lds, HY, b0, 512 + c0, cw, cb, nullptr, c0);
        hm_conv_wave(lds, F.lane, F.wave, spec + (size_t)(512 + c0 + F.wave) * 4096);
        __syncthreads();
        hm_elem_pass<2>(F, lds, HY, b0, 1024 + c0, cw, cb, OB, c0);
    }
}

__device__ __forceinline__ float hmax32(float v) { const unsigned b = __builtin_bit_cast(unsigned, v); auto r = __builtin_amdgcn_permlane32_swap(b, b, false, false); return fmaxf(__builtin_bit_cast(float, (unsigned)r[0]), __builtin_bit_cast(float, (unsigned)r[1])); }
__device__ __forceinline__ float hsum32(float v) { const unsigned b = __builtin_bit_cast(unsigned, v); auto r = __builtin_amdgcn_permlane32_swap(b, b, false, false); return __builtin_bit_cast(float, (unsigned)r[0]) + __builtin_bit_cast(float, (unsigned)r[1]); }
template <int KW, int DV, bool WINDOW>
__device__ __forceinline__ void attn_core(LAS unsigned char* lds, int tid, const bf16_t* Qg, int ldq, const bf16_t* Kb, int ldk, const bf16_t* Vb, int ldv,
                                          int q0, int t_lo, int t_hi, float m_init, float l_init, int kcol, f32x16 (&o)[DV / 32], float& m_out, float& l_out) {
    constexpr int KSTR = (KW + 8) * 2, VSTR = (DV == 128) ? 320 : 192, KCH = KW / 8, VCH = DV / 8, NK = 64 * KCH / NTHREADS, NV = 64 * VCH / NTHREADS;
    constexpr int KBUF = 64 * KSTR, VBUF = 64 * VSTR, VOFF = 2 * KBUF;
    const int lane = tid & 63, wave = tid >> 6, w4 = wave & 3, r32 = lane & 31, h = lane >> 5;
    const int qrow = q0 + 32 * w4 + r32;
    bf16x8 qf[4];
#pragma unroll
    for (int ds = 0; ds < 4; ++ds) qf[ds] = *(const bf16x8*)(Qg + (size_t)qrow * ldq + 16 * ds + 8 * h);
#pragma unroll
    for (int db = 0; db < DV / 32; ++db)
#pragma unroll
        for (int r = 0; r < 16; ++r) o[db][r] = 0.f;
    float m = m_init, l = l_init;
    u32x4 kreg[NK], vreg[NV];
    auto kload = [&](int t) {
#pragma unroll
        for (int i = 0; i < NK; ++i) { const int c = tid + NTHREADS * i, row = c / KCH, ch = c % KCH; kreg[i] = *(const u32x4*)(Kb + (size_t)(64 * t + row) * ldk + ch * 8); }
    };
    auto vload = [&](int t) {
#pragma unroll
        for (int i = 0; i < NV; ++i) { const int c = tid + NTHREADS * i, row = c / VCH, ch = c % VCH; vreg[i] = *(const u32x4*)(Vb + (size_t)(64 * t + row) * ldv + ch * 8); }
    };
    auto kstore = [&](int buf) {
#pragma unroll
        for (int i = 0; i < NK; ++i) { const int c = tid + NTHREADS * i, row = c / KCH, ch = c % KCH; *(LAS u32x4*)(lds + buf * KBUF + row * KSTR + ch * 16) = kreg[i]; }
    };
    auto vstore = [&](int buf) {
#pragma unroll
        for (int i = 0; i < NV; ++i) { const int c = tid + NTHREADS * i, row = c / VCH, ch = c % VCH; *(LAS u32x4*)(lds + VOFF + buf * VBUF + row * VSTR + ch * 16) = vreg[i]; }
    };
    auto qk = [&](int buf, f32x16& S0, f32x16& S1) {
#pragma unroll
        for (int r = 0; r < 16; ++r) { S0[r] = 0.f; S1[r] = 0.f; }
        const LAS unsigned char* kb = lds + buf * KBUF + r32 * KSTR + (kcol + 8 * h) * 2;
#pragma unroll
        for (int ds = 0; ds < 4; ++ds) {
            const bf16x8 k0 = *(const LAS bf16x8*)(kb + ds * 32);
            const bf16x8 k1 = *(const LAS bf16x8*)(kb + 32 * KSTR + ds * 32);
            S0 = __builtin_amdgcn_mfma_f32_32x32x16_bf16(k0, qf[ds], S0, 0, 0, 0);
            S1 = __builtin_amdgcn_mfma_f32_32x32x16_bf16(k1, qf[ds], S1, 0, 0, 0);
        }
    };
    kload(t_lo); vload(t_lo); kstore(0); vstore(0);
    if (t_lo < t_hi) kload(t_lo + 1);
    __syncthreads();
    f32x16 Sa0, Sa1, Sb0, Sb1;
    qk(0, Sa0, Sa1);
    if (t_lo < t_hi) kstore(1);
    __syncthreads();
    auto step = [&](int t, f32x16& S0, f32x16& S1, f32x16& N0, f32x16& N1) {
        const int i = t - t_lo, vcur = i & 1, knext = (i + 1) & 1;
        if (t + 2 <= t_hi) kload(t + 2);
        if (t + 1 <= t_hi) { vload(t + 1); qk(knext, N0, N1); }
        if (WINDOW) {
            const int kbase = 64 * t + 4 * h - qrow;
#pragma unroll
            for (int r = 0; r < 16; ++r) {
                const int d0 = kbase + (r & 3) + 8 * (r >> 2), d1 = d0 + 32;
                if (d0 > 128 || d0 < -128) S0[r] = -1e30f;
                if (d1 > 128 || d1 < -128) S1[r] = -1e30f;
            }
        }
        float mx0 = fmaxf(fmaxf(S0[0], S0[1]), S0[2]), mx1 = fmaxf(fmaxf(S1[0], S1[1]), S1[2]);
#pragma unroll
        for (int r = 3; r < 15; r += 2) { mx0 = fmaxf(fmaxf(mx0, S0[r]), S0[r + 1]); mx1 = fmaxf(fmaxf(mx1, S1[r]), S1[r + 1]); }
        float mx = fmaxf(fmaxf(mx0, S0[15]), fmaxf(mx1, S1[15]));
        mx = hmax32(mx);
        if (__any(mx > m + 6.0f)) {
            const float mnew = fmaxf(m, mx);
            const float alpha = __builtin_amdgcn_exp2f(m - mnew);
            m = mnew; l *= alpha;
#pragma unroll
            for (int db = 0; db < DV / 32; ++db)
#pragma unroll
                for (int r = 0; r < 16; ++r) o[db][r] *= alpha;
        }
        float ps0 = 0.f, ps1 = 0.f, ps2 = 0.f, ps3 = 0.f;
#pragma unroll
        for (int r = 0; r < 16; r += 2) {
            S0[r] = __builtin_amdgcn_exp2f(S0[r] - m); S0[r + 1] = __builtin_amdgcn_exp2f(S0[r + 1] - m); S1[r] = __builtin_amdgcn_exp2f(S1[r] - m); S1[r + 1] = __builtin_amdgcn_exp2f(S1[r + 1] - m);
            ps0 += S0[r]; ps1 += S0[r + 1]; ps2 += S1[r]; ps3 += S1[r + 1];
        }
        l += (ps0 + ps1) + (ps2 + ps3);
        bf16x8 pf[2][2];
#pragma unroll
        for (int s = 0; s < 2; ++s) {
            u32x4 w0, w1;
            w0.x = pk2(S0[8 * s + 0], S0[8 * s + 1]); w0.y = pk2(S0[8 * s + 2], S0[8 * s + 3]); w0.z = pk2(S0[8 * s + 4], S0[8 * s + 5]); w0.w = pk2(S0[8 * s + 6], S0[8 * s + 7]);
            w1.x = pk2(S1[8 * s + 0], S1[8 * s + 1]); w1.y = pk2(S1[8 * s + 2], S1[8 * s + 3]); w1.z = pk2(S1[8 * s + 4], S1[8 * s + 5]); w1.w = pk2(S1[8 * s + 6], S1[8 * s + 7]);
            pf[0][s] = __builtin_bit_cast(bf16x8, w0); pf[1][s] = __builtin_bit_cast(bf16x8, w1);
        }
        const LAS unsigned char* vb = lds + VOFF + vcur * VBUF + (4 * h + ((lane & 15) >> 2)) * VSTR + (16 * ((lane >> 4) & 1) + 4 * (lane & 3)) * 2;
#pragma unroll
        for (int kh = 0; kh < 2; ++kh)
#pragma unroll
            for (int s = 0; s < 2; ++s)
#pragma unroll
                for (int db = 0; db < DV / 32; ++db) {
                    const LAS unsigned char* p = vb + (32 * kh + 16 * s) * VSTR + db * 64;
                    const s16x4 lo4 = __builtin_amdgcn_ds_read_tr16_b64_v4i16((LAS s16x4*)p);
                    const s16x4 hi4 = __builtin_amdgcn_ds_read_tr16_b64_v4i16((LAS s16x4*)(p + 8 * VSTR));
                    const bf16x8 vf = {lo4[0], lo4[1], lo4[2], lo4[3], hi4[0], hi4[1], hi4[2], hi4[3]};
                    o[db] = __builtin_amdgcn_mfma_f32_32x32x16_bf16(vf, pf[kh][s], o[db], 0, 0, 0);
                }
        if (t + 2 <= t_hi) kstore(i & 1);
        if (t + 1 <= t_hi) vstore((i + 1) & 1);
        __syncthreads();
    };
    int t = t_lo;
    for (; t + 1 <= t_hi; t += 2) { step(t, Sa0, Sa1, Sb0, Sb1); step(t + 1, Sb0, Sb1, Sa0, Sa1); }
    if (t <= t_hi) step(t, Sa0, Sa1, Sb0, Sb1);
    m_out = m; l_out = l;
}

constexpr int ATT_CMB = 75776;
template <int WHICH> __device__ __forceinline__ void attn_phase(const Frame& F, int l) {
    const Params& P = *F.P; unsigned char* ws = P.ws + opaque_zero(); const int tid = F.tid, lane = F.lane, wave = F.wave, g = wave >> 2, w4 = wave & 3, r32 = lane & 31, h = lane >> 5;
    if constexpr (WHICH == 0) {
        const bf16_t* QC = (const bf16_t*)(ws + WS_QC); const bf16_t* KC = (const bf16_t*)(ws + G_KC); const bf16_t* VC = (const bf16_t*)(ws + G_VC); bf16_t* OC = (bf16_t*)(ws + WS_QC);
        const float lam = ((const float*)(ws + CTL_LAM))[l];
        const float lam_init = 0.8f - 0.6f * expf(-0.3f * (float)l);
        const float* subln = P.in[I_SUBLN] + l * 128;
        for (int u0 = F.bid, rnd = 0; u0 < 512; u0 += F.G, ++rnd) {
            int u = u0;
            if (F.G == 256) { const int x = F.bid & 7, j = F.bid >> 3, bh = 4 * x + 2 * rnd + (j >> 4); u = bh * 16 + (j & 15); }
            const int b = u >> 6, head = (u >> 4) & 3, qblk = u & 15, q0 = qblk * 128;
            const size_t rb = (size_t)b * SEQ;
            f32x16 o[4]; float m, lsum;
            attn_core<128, 128, false>(F.lds, tid, QC + rb * 512 + head * 128 + g * 64, 512, KC + rb * 512 + head * 128, 512, VC + rb * 512 + head * 128, 512,
                                       q0, 0, 31, -1e30f, 0.f, g * 64, o, m, lsum);
            lsum = hsum32(lsum);
            const float inv = 1.f / lsum;
            LAS f32x4* cmb = (LAS f32x4*)(F.lds + ATT_CMB);
            if (g == 1) {
#pragma unroll
                for (int db = 0; db < 4; ++db)
#pragma unroll
                    for (int rq = 0; rq < 4; ++rq) cmb[((w4 * 16 + db * 4 + rq) * 64) + lane] = (f32x4){o[db][4 * rq] * inv, o[db][4 * rq + 1] * inv, o[db][4 * rq + 2] * inv, o[db][4 * rq + 3] * inv};
            }
            __syncthreads();
            if (g == 0 && !F.dry) {
                float ss = 0.f;
#pragma unroll
                for (int db = 0; db < 4; ++db)
#pragma unroll
                    for (int rq = 0; rq < 4; ++rq) {
                        const f32x4 o2 = cmb[((w4 * 16 + db * 4 + rq) * 64) + lane];
#pragma unroll
                        for (int i = 0; i < 4; ++i) { const float v = o[db][4 * rq + i] * inv - lam * o2[i]; o[db][4 * rq + i] = v; ss += v * v; }
                    }
                ss = hsum32(ss);
                const float rn = rsqrtf(ss * (1.f / 128.f) + RMS_EPS) * (1.f - lam_init);
                const int qrow = q0 + 32 * w4 + r32;
                bf16_t* op = OC + (rb + qrow) * 512 + head * 128;
#pragma unroll
                for (int db = 0; db < 4; ++db)
#pragma unroll
                    for (int rp = 0; rp < 2; ++rp) {
                        u32x2 w[2];
#pragma unroll
                        for (int k = 0; k < 2; ++k) { const int rq = 2 * rp + k, d = 32 * db + 8 * rq + 4 * h; const f32x4 sg = *(const f32x4*)(subln + d);
                            w[k].x = pk2(o[db][4 * rq] * rn * sg[0], o[db][4 * rq + 1] * rn * sg[1]); w[k].y = pk2(o[db][4 * rq + 2] * rn * sg[2], o[db][4 * rq + 3] * rn * sg[3]); }
                        { auto r = __builtin_amdgcn_permlane32_swap(w[0].x, w[1].x, false, false); w[0].x = r[0]; w[1].x = r[1]; }
                        { auto r = __builtin_amdgcn_permlane32_swap(w[0].y, w[1].y, false, false); w[0].y = r[0]; w[1].y = r[1]; }
                        *(u32x4*)(op + 32 * db + 16 * rp + 8 * h) = (u32x4){w[0].x, w[0].y, w[1].x, w[1].y};
                    }
            }
        }
    }
    if constexpr (WHICH == 1) {
        const bf16_t* QA = (const bf16_t*)(ws + WS_QA); const bf16_t* KA = (const bf16_t*)(ws + G_KA); const bf16_t* VA = (const bf16_t*)(ws + G_VA); bf16_t* OA = (bf16_t*)(ws + WS_QA);
        const float* sink = P.in[I_SINK] + l * 8;
        for (int u = F.bid; u < 512; u += F.G) {
            const int b = u >> 6, kvh = (u >> 5) & 1, qblk = (u >> 1) & 15, hp = u & 1, q0 = qblk * 128;
            const int qh = kvh * 4 + hp * 2 + g;
            const size_t rb = (size_t)b * SEQ;
            int t_lo = (q0 - 128) / 64; if (t_lo < 0) t_lo = 0;
            int t_hi = (q0 + 255) / 64; if (t_hi > 31) t_hi = 31;
            f32x16 o[2]; float m, lsum;
            attn_core<64, 64, true>(F.lds, tid, QA + rb * 512 + qh * 64, 512, KA + rb * 128 + kvh * 64, 128, VA + rb * 128 + kvh * 64, 128,
                                    q0, t_lo, t_hi, sink[qh] * LOG2E, (h == 0) ? 1.f : 0.f, 0, o, m, lsum);
            lsum = hsum32(lsum);
            const float inv = 1.f / lsum;
            const int qrow = q0 + 32 * w4 + r32;
            bf16_t* op = OA + (rb + qrow) * 512 + qh * 64;
            if (!F.dry)
#pragma unroll
            for (int db = 0; db < 2; ++db)
#pragma unroll
                for (int rp = 0; rp < 2; ++rp) {
                    u32x2 w[2];
#pragma unroll
                    for (int k = 0; k < 2; ++k) { const int rq = 2 * rp + k;
                        w[k].x = pk2(o[db][4 * rq] * inv, o[db][4 * rq + 1] * inv); w[k].y = pk2(o[db][4 * rq + 2] * inv, o[db][4 * rq + 3] * inv); }
                    { auto r = __builtin_amdgcn_permlane32_swap(w[0].x, w[1].x, false, false); w[0].x = r[0]; w[1].x = r[1]; }
                    { auto r = __builtin_amdgcn_permlane32_swap(w[0].y, w[1].y, false, false); w[0].y = r[0]; w[1].y = r[1]; }
                    *(u32x4*)(op + 32 * db + 16 * rp + 8 * h) = (u32x4){w[0].x, w[0].y, w[1].x, w[1].y};
                }
        }
    }
}

constexpr int NIN8 = 2816, NIN16 = NMAIN - NIN8;
constexpr size_t W_IN16 = W_IN + 3 * MiB;
__device__ __forceinline__ void p1_inproj(const Frame& F, int l) {
    const Params& P = *F.P; unsigned char* ws = P.ws + opaque_zero();
    {
        pg8::Gemm g{(const bf16_t*)(ws + WS_XB), (const bf16_t*)(ws + W_IN16), MTOK, NIN16, DM, 0, 0};
        pg8::StaticOrder S; S.init(MTOK, NIN16, F.G, F.bid);
        EpiInProj<false> E{nullptr, nullptr, (const float*)(ws + WS_ROWSSA), nullptr, NIN8 / 256, (const unsigned*)(ws + CTL_COS), (const unsigned*)(ws + CTL_SIN) + l * 128,
                    (bf16_t*)(ws + WS_QA), (bf16_t*)(ws + G_KA), (bf16_t*)(ws + G_VA), (bf16_t*)(ws + WS_QC), (bf16_t*)(ws + G_KC), (bf16_t*)(ws + G_VC), (bf16_t*)(ws + G_HY)};
        pg8::Acc acc;
        pg8::gemm_phase<EpiInProj<false>, pg8::StaticOrder, true, true, true>(F.lds, F.tid, g, S, E, acc);
    }
}
__device__ __forceinline__ void p1_inproj8(const Frame& F, int l, bool w2_tail = false) {
    const Params& P = *F.P; unsigned char* ws = P.ws + opaque_zero();
    {
        pg8::Gemm g{(const bf16_t*)(ws + WS_XB8), (const bf16_t*)(ws + W_IN), MTOK, NIN8, DM, 0, 0};
        pg8::StaticOrder S; S.init(MTOK, NIN8, F.G, F.bid);
        EpiInProj<true> E{nullptr, nullptr, (const float*)(ws + CTL_FCTA), (const float*)(ws + CS_IN), 0, (const unsigned*)(ws + CTL_COS), (const unsigned*)(ws + CTL_SIN) + l * 128,
                    (bf16_t*)(ws + WS_QA), (bf16_t*)(ws + G_KA), (bf16_t*)(ws + G_VA), (bf16_t*)(ws + WS_QC), (bf16_t*)(ws + G_KC), (bf16_t*)(ws + G_VC), (bf16_t*)(ws + G_HY)};
        pg8::Acc acc;
        pg8::gemm_phase<EpiInProj<true>, pg8::StaticOrder, true, true, true, false, true>(F.lds, F.tid, g, S, E, acc);
    }
    if (w2_tail) {
        const int U = (MTOK / 256) * (NIN8 / 256), R = (U + F.G - 1) / F.G; int ns = R * F.G - U, si = F.bid - (F.G - ns);
        if (ns == 0) { ns = F.G; si = F.bid; }
        __syncthreads();
        if (si >= 0) p0_weights(F, l, 1, si * 8 + F.wave, ns * 8);
    }
}
__device__ __forceinline__ void p3_merge(const Frame& F, int l) {
    const Params& P = *F.P; unsigned char* ws = P.ws + opaque_zero();
    pg8::ChainOrder3 S; S.S.init(MTOK, DM, F.G, F.bid);
    {
        pg8::Gemm g{(const bf16_t*)(ws + WS_XB8), (const bf16_t*)(ws + W_IN + (size_t)NMAIN * DM * 2), MTOK, DM, DM, 0, (size_t)DM * DM};
        EpiGate E{nullptr, nullptr, F.tid, (const float*)(ws + CTL_FCTA), (const float*)(ws + CS_G), (u32x4*)(ws + WS_G)};
        pg8::Acc acc;
        pg8::gemm_phase<EpiGate, pg8::ChainOrder3, true, true, true, false, true>(F.lds, F.tid, g, S, E, acc);
    }
    {
        pg8::Gemm g{(const bf16_t*)(ws + WS_QA), (const bf16_t*)(ws + W_OA), MTOK, DM, 512, (size_t)16 * MiB, (size_t)DM * 512 * 2};
        EpiMerge E{F.tid, (const u32x4*)(ws + WS_G), (bf16_t*)(ws + WS_S)};
        pg8::Acc acc;
        pg8::gemm_phase<EpiMerge, pg8::ChainOrder3, true, true, true>(F.lds, F.tid, g, S, E, acc);
    }
}
__device__ __forceinline__ void p4_wout(const Frame& F, int l) {
    const Params& P = *F.P; unsigned char* ws = P.ws + opaque_zero();
    pg8::Gemm g{(const bf16_t*)(ws + WS_S), (const bf16_t*)(ws + W_OUT), MTOK, DM, DM, 0, 0};
    pg8::StaticOrder S; S.init(MTOK, DM, F.G, F.bid);
    const bool fuse = FUSE_XQ(F);
    EpiResid<false> E{(bf16_t*)(ws + WS_XB), P.out, (float*)(ws + WS_ROWSSB), F.dry, (LAS float*)(F.lds + pg8::STAGE_BYTES), F.tid,
                      fuse ? ws + WS_XB8 : nullptr, (float*)(ws + CTL_FCTA), (unsigned long long*)(ws + WS_XSLOT), (unsigned*)(ws + CTL_BAR) + CTLW_XQCNT, (unsigned*)(ws + CTL_BAR), 16u * (unsigned)(2 * l + 1)};
    pg8::Acc acc;
    pg8::gemm_phase<EpiResid<false>, pg8::StaticOrder, true, true, true>(F.lds, F.tid, g, S, E, acc);
}
__device__ __forceinline__ void p5_ffn_up(const Frame& F, int l) {
    const Params& P = *F.P; unsigned char* ws = P.ws + opaque_zero();
    pg8::Gemm g{(const bf16_t*)(ws + WS_XB8), (const bf16_t*)(ws + W_13), MTOK, 2 * DFF, DM, 0, 0};
    pg8::TailSplitOrder S; S.init(MTOK, 2 * DFF, F.G, F.bid);
    EpiSwiGLU E{nullptr, nullptr, (const float*)(ws + CTL_FCTA), (const float*)(ws + CS_13), (bf16_t*)(ws + WS_G), F.dry && (P.pad == 12)};
    pg8::Acc acc;
    pg8::gemm_phase<EpiSwiGLU, pg8::TailSplitOrder, true, true, true, true, true>(F.lds, F.tid, g, S, E, acc);
}
template <int L> __device__ __forceinline__ void p6_ffn_down(const Frame& F) {
    const Params& P = *F.P; unsigned char* ws = P.ws + opaque_zero();
    pg8::Gemm g{(const bf16_t*)(ws + WS_G), (const bf16_t*)(ws + W_2), MTOK, DM, DFF, 0, 0};
    pg8::StaticOrder S; S.init(MTOK, DM, F.G, F.bid);
    constexpr bool FINAL = (L + 1 >= DEPTH);
    const bool fuse = FUSE_XQ(F);
    EpiResid<FINAL> E{(bf16_t*)(ws + WS_XB), P.out, (float*)(ws + WS_ROWSSA), F.dry, (LAS float*)(F.lds + pg8::STAGE_BYTES), F.tid,
                      fuse ? ws + WS_XB8 : nullptr, (float*)(ws + CTL_FCTA), (unsigned long long*)(ws + WS_XSLOT), (unsigned*)(ws + CTL_BAR) + CTLW_XQCNT, (unsigned*)(ws + CTL_BAR), 16u * (unsigned)(2 * L + 2)};
    pg8::Acc acc;
    pg8::gemm_phase<EpiResid<FINAL>, pg8::StaticOrder, true, true, true>(F.lds, F.tid, g, S, E, acc);
}

constexpr int PH_PER_LAYER = 8, NPHASE = PH_PER_LAYER * DEPTH;
#define PH_IN(k) (P.lo <= (k) && (k) < P.hi)
#define PH_FRAME() do { int t_ = threadIdx.x; asm volatile("" : "+v"(t_)); F.tid = t_; F.lane = t_ & 63; F.wave = __builtin_amdgcn_readfirstlane(t_ >> 6); \
                        int b_ = blockIdx.x; asm volatile("" : "+s"(b_)); F.bid = b_; } while (0)
#define PH_SEAM(k) do { if (PH_IN(k) && PH_IN((k) + 1)) { if (P.coop) { xcd_barrier(xbar); if (P.pad == 11) xcd_barrier(xbar); } } __syncthreads(); } while (0)
#define PH_RUN(code, call) do { const int nrep_ = (P.pad == (code)) ? 2 : 1; for (int rep_ = 0; rep_ < nrep_; ++rep_) { PH_FRAME(); F.dry = (rep_ + 1 < nrep_); call; __syncthreads(); } } while (0)
template <int L> __device__ __forceinline__ void run_layer(Frame& F, const Params& P, cg::grid_group& grid, const XcdBarrier& xbar) {
    constexpr int B = PH_PER_LAYER * L;
    const bool split = P.coop && FUSE_XQ(F) && P.lo == 0 && P.hi == NPHASE;
    if (L > 0 && split) {
        PH_RUN(1, p0_weights(F, L, 0));
        PH_RUN(2, spectra_phase(F, L));
        xcd_barrier(xbar); __syncthreads();
        PH_RUN(3, p1_inproj(F, L)); PH_RUN(17, p1_inproj8(F, L, true));
    } else {
        if (PH_IN(B + 0)) { PH_RUN(1, (p0_weights(F, L, split ? 0 : -1), (L == 0 ? p0_misc(F) : (void)0))); }
        PH_SEAM(B + 0);
        if (PH_IN(B + 1)) {
            if (!FUSE_XQ(F)) { PH_RUN(16, gate_rows_i8(F, F.bid * 8 + F.wave, F.G * 8, WS_ROWSSA)); if (P.coop) xcd_barrier(xbar); __syncthreads(); }
            PH_RUN(2, spectra_phase(F, L)); PH_RUN(3, p1_inproj(F, L)); PH_RUN(17, p1_inproj8(F, L, split)); }
    }
    PH_SEAM(B + 1);
    if (PH_IN(B + 2)) { PH_RUN(4, hyena_phase(F, L)); PH_RUN(5, attn_phase<0>(F, L)); PH_RUN(6, attn_phase<1>(F, L)); }
    PH_SEAM(B + 2);
    if (PH_IN(B + 3)) { PH_RUN(7, p3_merge(F, L)); }
    PH_SEAM(B + 3);
    if (PH_IN(B + 4)) { PH_RUN(8, p4_wout(F, L)); }
    PH_SEAM(B + 4);
    if (!FUSE_XQ(F)) { if (PH_IN(B + 5)) { PH_RUN(14, p5_prep(F, L)); } PH_SEAM(B + 5); }
    if (PH_IN(B + 6)) { PH_RUN((P.pad == 12 ? 12 : 9), p5_ffn_up(F, L)); }
    PH_SEAM(B + 6);
    if (PH_IN(B + 7)) { PH_RUN(10, p6_ffn_down<L>(F)); }
    if (L + 1 < DEPTH && split) { __syncthreads(); }
    else PH_SEAM(B + 7);
}
__global__ void __launch_bounds__(NTHREADS, 2) mega_fwd(Params P) {
    extern __shared__ __attribute__((aligned(16))) unsigned char lds_raw[];
    cg::grid_group grid = cg::this_grid();
    Frame F;
    F.lds = (LAS unsigned char*)lds_raw;
    F.G = gridDim.x; F.P = &P;
    volatile LAS unsigned* bst = (volatile LAS unsigned*)(F.lds + LDS_BARST);
    if (threadIdx.x < 4) bst[threadIdx.x] = 0u;
    __syncthreads();
    XcdBarrier xbar; xbar.bar = (unsigned*)(P.ws + CTL_BAR); xbar.x = 0; xbar.st = bst;
    if (P.coop) xbar = xcd_barrier_post((unsigned*)(P.ws + CTL_BAR), bst);
    if (P.coop == 2) grid.sync();
    run_layer<0>(F, P, grid, xbar);
    run_layer<1>(F, P, grid, xbar);
}

#ifndef PROBE_CODE
#define PROBE_CODE 0
#endif
#ifndef N_LAUNCH_MODE
#define N_LAUNCH_MODE 1
#endif
extern "C" void kernel_launch(void* const* d_in, const int* in_sizes, int n_in, void* d_out, int out_size, void* d_ws, size_t ws_size, hipStream_t stream) {
    static int grid = 0;
    if (grid == 0) {
        int dev = 0, cus = 0, per_cu = 0;
        if (hipGetDevice(&dev) != hipSuccess || hipDeviceGetAttribute(&cus, hipDeviceAttributeMultiprocessorCount, dev) != hipSuccess) { fprintf(stderr, "kernel_launch: device query failed\n"); grid = -1; return; }
        if (hipFuncSetAttribute((const void*)mega_fwd, hipFuncAttributeMaxDynamicSharedMemorySize, LDS_BYTES) != hipSuccess) { fprintf(stderr, "kernel_launch: hipFuncSetAttribute failed\n"); grid = -1; return; }
        if (hipOccupancyMaxActiveBlocksPerMultiprocessor(&per_cu, (const void*)mega_fwd, NTHREADS, LDS_BYTES) != hipSuccess || per_cu < 1) { fprintf(stderr, "kernel_launch: occupancy query failed (%d)\n", per_cu); per_cu = 1; }
        (void)hipGetLastError();
        if (per_cu > 1) per_cu = 1;
        grid = cus * per_cu;
        if (n_in != 31 || ws_size < WS_END) fprintf(stderr, "kernel_launch: unexpected n_in %d / ws_size %zu (need %zu)\n", n_in, ws_size, (size_t)WS_END);
    }
    if (grid < 0) return;
    Params p{};
    for (int i = 0; i < 31; ++i) p.in[i] = (const float*)d_in[i];
    p.out = (float*)d_out; p.ws = (unsigned char*)d_ws;
#if N_LAUNCH_MODE == 1
    p.lo = 0; p.hi = NPHASE; p.coop = 1; p.pad = PROBE_CODE;
    if (hipMemsetAsync((char*)d_ws + CTL_BAR, 0, CTL_BAR_BYTES, stream) != hipSuccess) { fprintf(stderr, "kernel_launch: memset of barrier words failed\n"); return; }
    void* args[] = {&p};
    hipError_t e = hipLaunchCooperativeKernel((const void*)mega_fwd, dim3(grid), dim3(NTHREADS), args, LDS_BYTES, stream);
    if (e != hipSuccess) fprintf(stderr, "cooperative launch failed: %s (grid %d)\n", hipGetErrorString(e), grid);
#else
    for (int ph = 0; ph < NPHASE; ++ph) {
        p.lo = ph; p.hi = ph + 1; p.coop = 0;
        hipLaunchKernelGGL(mega_fwd, dim3(grid), dim3(NTHREADS), LDS_BYTES, stream, p);
    }
#endif
}
```
